# Optimizing an MI355X kernel written in HIP

```python
import math
import jax, jax.numpy as jnp
from jax import lax
import numpy as np

D_MODEL = 2048
BATCH = 4
SEQ = 4096
DEPTH = 2

GRID_W = 64
CTX_LEN = 256

ATT_HEADS = 8
ATT_KV_HEADS = 2
HEAD_DIM = 128
WINDOW = 128
ATT_BLOCK = 128
ROPE_BASE = 10000.0
SSM_WIDTH = 512
SSM_GROUP = 16
SSM_GROUPS = SSM_WIDTH // SSM_GROUP
SSM_STATE = 64
GLA_HEADS = 4
GLA_DK = 64
GLA_DV = 128
GLA_RANK = 16
GLA_TAU = 16.0
GLA_CHUNK = 64
N_EXPERTS = 16
EXPERT_FF = 2048
CAPACITY_FACTOR = 2
N_MOD = 6
ALPHA = (2 * DEPTH) ** 0.25
BETA = (8 * DEPTH) ** -0.25
LN_EPS = 1e-6
NEG_INF = -1e30

ATT_Q_W = ATT_HEADS * HEAD_DIM
ATT_KV_W = ATT_KV_HEADS * HEAD_DIM
GLA_QK_W = GLA_HEADS * GLA_DK
GLA_V_W = GLA_HEADS * GLA_DV
IN_SIZES = (ATT_Q_W, ATT_KV_W, ATT_KV_W, SSM_WIDTH, GLA_QK_W, GLA_QK_W, GLA_V_W, GLA_V_W, 2 * GLA_RANK)
IN_SPLITS = tuple(int(s) for s in np.cumsum(IN_SIZES)[:-1])
N_IN = sum(IN_SIZES)
MIX_WIDTH = ATT_Q_W + SSM_WIDTH + GLA_V_W

kernel_name = 'hybrid_s5_swa_gla_ec_moe_diffusion_trunk'


def layer_norm(x, g=None, b=None):
    xf = x.astype(jnp.float32)
    mu = jnp.mean(xf, axis=-1, keepdims=True)
    var = jnp.mean(jnp.square(xf - mu), axis=-1, keepdims=True)
    y = (xf - mu) * lax.rsqrt(var + LN_EPS)
    if g is not None:
        y = y * g + b
    return y.astype(x.dtype)


def rope_rotate(x, ang):
    m = x.shape[-1] // 2
    x1, x2 = x[..., :m], x[..., m:]
    cos = jnp.cos(ang)[:, None, :]
    sin = jnp.sin(ang)[:, None, :]
    return jnp.concatenate([x1 * cos - x2 * sin, x2 * cos + x1 * sin], axis=-1)


def axial_rope(x, rows, cols):
    half = x.shape[-1] // 2
    nf = half // 2
    inv = ROPE_BASE ** (-jnp.arange(nf, dtype=jnp.float32) / nf)
    ang_r = rows.astype(jnp.float32)[:, None] * inv
    ang_c = cols.astype(jnp.float32)[:, None] * inv
    xf = x.astype(jnp.float32)
    out = jnp.concatenate([rope_rotate(xf[..., :half], ang_r), rope_rotate(xf[..., half:], ang_c)], axis=-1)
    return out.astype(x.dtype)


def window_attention(q, k, v, kc, vc, sink):
    Bt, L, Hq, Dh = q.shape
    Hkv = k.shape[2]
    G = Hq // Hkv
    W = ATT_BLOCK
    nb = L // W
    Lc = kc.shape[1]
    qb = (q * (Dh ** -0.5)).reshape(Bt, nb, W, Hkv, G, Dh)

    def band(t):
        tp = jnp.pad(t, ((0, 0), (W, W), (0, 0), (0, 0))).reshape(Bt, nb + 2, W, Hkv, Dh)
        return jnp.concatenate([tp[:, :-2], tp[:, 1:-1], tp[:, 2:]], axis=2)

    kw, vw = band(k), band(v)
    s_loc = jnp.einsum('bnqhgd,bnkhd->bnhgqk', qb, kw).astype(jnp.float32)
    qi = jnp.arange(W)
    kj = jnp.arange(3 * W)
    rel = qi[:, None] + W - kj[None, :]
    key_pos = jnp.arange(nb)[:, None] * W - W + kj[None, :]
    valid = (jnp.abs(rel) <= WINDOW)[None] & ((key_pos >= 0) & (key_pos < L))[:, None, :]
    s_loc = jnp.where(valid[None, :, None, None], s_loc, NEG_INF)
    s_ctx = jnp.einsum('bnqhgd,bchd->bnhgqc', qb, kc).astype(jnp.float32)
    s_sink = jnp.broadcast_to(sink.astype(jnp.float32).reshape(Hkv, G)[None, None, :, :, None, None],
                              s_ctx.shape[:-1] + (1,))
    p = jax.nn.softmax(jnp.concatenate([s_loc, s_ctx, s_sink], axis=-1), axis=-1)
    o = (jnp.einsum('bnhgqk,bnkhd->bnqhgd', p[..., :3 * W].astype(vw.dtype), vw)
         + jnp.einsum('bnhgqc,bchd->bnqhgd', p[..., 3 * W:3 * W + Lc].astype(vc.dtype), vc))
    return o.reshape(Bt, L, Hq * Dh)


def ctx_attention(qc, kc, vc, sink):
    Bt, Lc, Hq, Dh = qc.shape
    Hkv = kc.shape[2]
    G = Hq // Hkv
    qg = (qc * (Dh ** -0.5)).reshape(Bt, Lc, Hkv, G, Dh)
    s = jnp.einsum('bqhgd,bkhd->bhgqk', qg, kc).astype(jnp.float32)
    s_sink = jnp.broadcast_to(sink.astype(jnp.float32).reshape(Hkv, G)[None, :, :, None, None], s.shape[:-1] + (1,))
    p = jax.nn.softmax(jnp.concatenate([s, s_sink], axis=-1), axis=-1)[..., :Lc]
    o = jnp.einsum('bhgqk,bkhd->bqhgd', p.astype(vc.dtype), vc)
    return o.reshape(Bt, Lc, Hq * Dh)


def _linrec_combine(left, right):
    a1, b1 = left
    a2, b2 = right
    return a1 * a2, a2 * b1 + b2


def s5_scan(u, lam_re, lam_im, log_dt, b_re, b_im, c_re, c_im, h0, reverse, readout):
    L = u.shape[1]
    lam = lax.complex(lam_re.astype(jnp.float32), lam_im.astype(jnp.float32))
    lam_dt = lam * jnp.exp(log_dt.astype(jnp.float32))[:, None]
    lam_bar = jnp.exp(lam_dt)
    b_bar = ((lam_bar - 1.0) / lam)[..., None] * lax.complex(b_re.astype(jnp.float32), b_im.astype(jnp.float32))
    bu = jnp.einsum('blgh,gph->blgp', u.astype(jnp.float32).astype(jnp.complex64), b_bar)
    a = jnp.broadcast_to(lam_bar, bu.shape)
    _, h = lax.associative_scan(_linrec_combine, (a, bu), axis=1, reverse=reverse)
    if h0 is not None:
        steps = jnp.arange(1, L + 1, dtype=jnp.float32)
        if reverse:
            steps = steps[::-1]
        h = h + jnp.exp(lam_dt[None] * steps[:, None, None])[None] * h0[:, None]
    h_last = h[:, 0] if reverse else h[:, -1]
    if not readout:
        return None, h_last
    c_mat = lax.complex(c_re.astype(jnp.float32), c_im.astype(jnp.float32))
    y = jnp.real(jnp.einsum('blgp,ghp->blgh', h, c_mat))
    return y, h_last


def s5_readout(y, u, p):
    Bt, L = y.shape[:2]
    z = jax.nn.gelu(y.reshape(Bt, L, SSM_WIDTH) + p['ssm_d'] * u.astype(jnp.float32))
    return z * jax.nn.sigmoid(z @ p['ssm_w_glu'] + p['ssm_b_glu'])


def s5_mixer(u, uc, p, need_ctx):
    Bt, L, _ = u.shape
    Lc = uc.shape[1]
    ug = u.astype(jnp.float32).reshape(Bt, L, SSM_GROUPS, SSM_GROUP)
    ucg = uc.astype(jnp.float32).reshape(Bt, Lc, SSM_GROUPS, SSM_GROUP)

    def dir_args(d):
        return (p['ssm_lam_re'][d], p['ssm_lam_im'][d], p['ssm_log_dt'][d], p['ssm_b_re'][d],
                p['ssm_b_im'][d], p['ssm_c_re'][d], p['ssm_c_im'][d])

    yc_f, hc_f = s5_scan(ucg, *dir_args(0), None, False, need_ctx)
    yc_b, hc_b = s5_scan(ucg, *dir_args(1), None, True, need_ctx)
    y_f, _ = s5_scan(ug, *dir_args(0), hc_f, False, True)
    y_b, _ = s5_scan(ug, *dir_args(1), hc_b, True, True)
    out = s5_readout(y_f + y_b, u, p)
    out_c = s5_readout(yc_f + yc_b, uc, p) if need_ctx else None
    return out, out_c


def gla_chunked(q, k, v, g, s0):
    Bt, L, H, K = q.shape
    V = v.shape[-1]
    T = GLA_CHUNK
    n = L // T
    qc = q.reshape(Bt, n, T, H, K)
    kc = k.reshape(Bt, n, T, H, K)
    vc = v.reshape(Bt, n, T, H, V)
    b = jnp.cumsum(g.reshape(Bt, n, T, H, K), axis=2)
    b_last = b[:, :, -1]
    q_in = qc * jnp.exp(b)
    attn = jnp.einsum('bnthk,bnshk->bnhts', q_in, kc * jnp.exp(-b))
    attn = jnp.where(jnp.tril(jnp.ones((T, T), dtype=bool)), attn, 0.0)
    o = jnp.einsum('bnhts,bnshv->bnthv', attn, vc)
    upd = jnp.einsum('bnshk,bnshv->bnhkv', kc * jnp.exp(b_last[:, :, None] - b), vc)
    decay = jnp.exp(b_last)
    if s0 is None:
        s0 = jnp.zeros((Bt, H, K, V), jnp.float32)

    def step(s, inp):
        dec, du = inp
        return dec[..., None] * s + du, s

    s_fin, s_prev = lax.scan(step, s0, (jnp.moveaxis(decay, 1, 0), jnp.moveaxis(upd, 1, 0)))
    o = o + jnp.einsum('bnthk,nbhkv->bnthv', q_in, s_prev)
    return o.reshape(Bt, L, H, V), s_fin


def gla_scan(q, k, v, g, s0, reverse):
    if not reverse:
        return gla_chunked(q, k, v, g, s0)
    fl = lambda t: jnp.flip(t, axis=1)
    o, s = gla_chunked(fl(q), fl(k), fl(v), fl(g), s0)
    return fl(o), s


def gla_prepare(q, k, v, z, p):
    Bt, L = q.shape[:2]
    qh = q.astype(jnp.float32).reshape(Bt, L, GLA_HEADS, GLA_DK) * (GLA_DK ** -0.5)
    kh = k.astype(jnp.float32).reshape(Bt, L, GLA_HEADS, GLA_DK)
    vh = v.astype(jnp.float32).reshape(Bt, L, GLA_HEADS, GLA_DV)
    zf = z.astype(jnp.float32)
    gs = [(jax.nn.log_sigmoid(zf[..., d * GLA_RANK:(d + 1) * GLA_RANK] @ p['gla_w_gate'][d] + p['gla_b_gate'][d])
           / GLA_TAU).reshape(Bt, L, GLA_HEADS, GLA_DK) for d in range(2)]
    return qh, kh, vh, gs


def gla_readout(o, r, p):
    Bt, L = o.shape[:2]
    o = o * lax.rsqrt(jnp.mean(jnp.square(o), axis=-1, keepdims=True) + LN_EPS) * p['gla_norm_g']
    return o.reshape(Bt, L, GLA_V_W) * jax.nn.silu(r.astype(jnp.float32))


def gla_mixer(q, k, v, r, z, qc_, kc_, vc_, rc, zc, p, need_ctx):
    qh, kh, vh, gs = gla_prepare(q, k, v, z, p)
    qch, kch, vch, gcs = gla_prepare(qc_, kc_, vc_, zc, p)
    oc_f, sc_f = gla_scan(qch, kch, vch, gcs[0], None, False)
    oc_b, sc_b = gla_scan(qch, kch, vch, gcs[1], None, True)
    o_f, _ = gla_scan(qh, kh, vh, gs[0], sc_f, False)
    o_b, _ = gla_scan(qh, kh, vh, gs[1], sc_b, True)
    out = gla_readout(o_f + o_b, r, p)
    out_c = gla_readout(oc_f + oc_b, rc, p) if need_ctx else None
    return out, out_c


def mixer_block(h, hc, p, rows, cols, need_ctx):
    Bt, L, _ = h.shape
    Lc = hc.shape[1]
    aq, ak, av, su, gq, gk, gv, gr, gz = jnp.split(h @ p['w_in'], IN_SPLITS, axis=-1)
    caq, cak, cav, csu, cgq, cgk, cgv, cgr, cgz = jnp.split(hc @ p['w_in'], IN_SPLITS, axis=-1)
    q = axial_rope(aq.reshape(Bt, L, ATT_HEADS, HEAD_DIM), rows, cols)
    k = axial_rope(ak.reshape(Bt, L, ATT_KV_HEADS, HEAD_DIM), rows, cols)
    v = av.reshape(Bt, L, ATT_KV_HEADS, HEAD_DIM)
    kc = cak.reshape(Bt, Lc, ATT_KV_HEADS, HEAD_DIM)
    vc = cav.reshape(Bt, Lc, ATT_KV_HEADS, HEAD_DIM)
    att = window_attention(q, k, v, kc, vc, p['attn_sink'])
    ssm, ssm_c = s5_mixer(su, csu, p, need_ctx)
    gla, gla_c = gla_mixer(gq, gk, gv, gr, gz, cgq, cgk, cgv, cgr, cgz, p, need_ctx)
    mix = jnp.concatenate([att.astype(h.dtype), ssm.astype(h.dtype), gla.astype(h.dtype)], axis=-1)
    if not need_ctx:
        return mix, None
    att_c = ctx_attention(caq.reshape(Bt, Lc, ATT_HEADS, HEAD_DIM), kc, vc, p['attn_sink'])
    mix_c = jnp.concatenate([att_c.astype(hc.dtype), ssm_c.astype(hc.dtype), gla_c.astype(hc.dtype)], axis=-1)
    return mix, mix_c


def expert_choice_ffn(h, router, w_gate, w_up, w_down):
    Bt, N, _ = h.shape
    cap = CAPACITY_FACTOR * N // N_EXPERTS
    aff = jax.nn.softmax(jnp.einsum('bnd,de->bne', h, router).astype(jnp.float32), axis=-1)
    g, idx = lax.top_k(jnp.swapaxes(aff, 1, 2), cap)
    bidx = jnp.arange(Bt)[:, None, None]
    xe = h[bidx, idx]
    hid = jax.nn.silu(jnp.einsum('becd,edf->becf', xe, w_gate)) * jnp.einsum('becd,edf->becf', xe, w_up)
    ye = jnp.einsum('becf,efd->becd', hid, w_down) * g[..., None].astype(h.dtype)
    return jnp.zeros_like(h).at[bidx, idx].add(ye)


def trunk_layer(x, xc, mod, mod_c, p, rows, cols, need_ctx):
    sh1, sc1, gt1, sh2, sc2, gt2 = jnp.split(mod, N_MOD, axis=-1)
    csh1, csc1, cgt1, csh2, csc2, cgt2 = jnp.split(mod_c, N_MOD, axis=-1)
    h = layer_norm(x) * (1.0 + sc1) + sh1
    hc = layer_norm(xc) * (1.0 + csc1) + csh1
    mix, mix_c = mixer_block(h, hc, p, rows, cols, need_ctx)
    x = layer_norm(ALPHA * x + gt1 * (mix @ p['w_out']), p['ln1_g'], p['ln1_b'])
    h2 = layer_norm(x) * (1.0 + sc2) + sh2
    ffn = expert_choice_ffn(h2, p['router'], p['exp_w_gate'], p['exp_w_up'], p['exp_w_down'])
    x = layer_norm(ALPHA * x + gt2 * ffn, p['ln2_g'], p['ln2_b'])
    if not need_ctx:
        return x, None
    xc = layer_norm(ALPHA * xc + cgt1 * (mix_c @ p['w_out']), p['ln1_g'], p['ln1_b'])
    hc2 = layer_norm(xc) * (1.0 + csc2) + csh2
    ffn_c = expert_choice_ffn(hc2, p['router'], p['exp_w_gate'], p['exp_w_up'], p['exp_w_down'])
    xc = layer_norm(ALPHA * xc + cgt2 * ffn_c, p['ln2_g'], p['ln2_b'])
    return x, xc


def setup_inputs(seed: int = 0) -> dict:
    key = jax.random.key(seed)
    ks = jax.random.split(key, 32)
    f32 = jnp.float32
    D = D_MODEL
    G, P, H = SSM_GROUPS, SSM_STATE, SSM_GROUP

    def nrm(k, shape, s):
        return jax.random.normal(k, shape, f32) * s

    lam_im_base = jnp.pi * jnp.arange(P, dtype=f32)
    return {
        'x': nrm(ks[0], (BATCH, SEQ, D), 1.0),
        'c': nrm(ks[1], (BATCH, D), 1.0),
        'ctx': nrm(ks[2], (BATCH, CTX_LEN, D), 1.0),
        'c_ctx': nrm(ks[3], (D,), 1.0),
        'w_ada': nrm(ks[4], (DEPTH, D, N_MOD * D), 0.5 * D ** -0.5),
        'b_ada': nrm(ks[5], (DEPTH, N_MOD * D), 0.01),
        'w_in': nrm(ks[6], (DEPTH, D, N_IN), D ** -0.5),
        'attn_sink': nrm(ks[7], (DEPTH, ATT_HEADS), 0.5),
        'ssm_lam_re': -0.5 + nrm(ks[8], (DEPTH, 2, G, P), 0.01),
        'ssm_lam_im': lam_im_base + nrm(ks[9], (DEPTH, 2, G, P), 0.01),
        'ssm_log_dt': jax.random.uniform(ks[10], (DEPTH, 2, G), f32, math.log(1e-3), math.log(1e-1)),
        'ssm_b_re': nrm(ks[11], (DEPTH, 2, G, P, H), (2 * H) ** -0.5),
        'ssm_b_im': nrm(ks[12], (DEPTH, 2, G, P, H), (2 * H) ** -0.5),
        'ssm_c_re': nrm(ks[13], (DEPTH, 2, G, H, P), P ** -0.5),
        'ssm_c_im': nrm(ks[14], (DEPTH, 2, G, H, P), P ** -0.5),
        'ssm_d': nrm(ks[15], (DEPTH, SSM_WIDTH), 1.0),
        'ssm_w_glu': nrm(ks[16], (DEPTH, SSM_WIDTH, SSM_WIDTH), SSM_WIDTH ** -0.5),
        'ssm_b_glu': nrm(ks[17], (DEPTH, SSM_WIDTH), 0.01),
        'gla_w_gate': nrm(ks[18], (DEPTH, 2, GLA_RANK, GLA_QK_W), GLA_RANK ** -0.5),
        'gla_b_gate': nrm(ks[19], (DEPTH, 2, GLA_QK_W), 0.1),
        'gla_norm_g': 1.0 + nrm(ks[20], (DEPTH, GLA_DV), 0.01),
        'w_out': nrm(ks[21], (DEPTH, MIX_WIDTH, D), BETA * MIX_WIDTH ** -0.5),
        'ln1_g': 1.0 + nrm(ks[22], (DEPTH, D), 0.01),
        'ln1_b': nrm(ks[23], (DEPTH, D), 0.01),
        'ln2_g': 1.0 + nrm(ks[24], (DEPTH, D), 0.01),
        'ln2_b': nrm(ks[25], (DEPTH, D), 0.01),
        'router': nrm(ks[26], (DEPTH, D, N_EXPERTS), D ** -0.5),
        'exp_w_gate': nrm(ks[27], (DEPTH, N_EXPERTS, D, EXPERT_FF), D ** -0.5),
        'exp_w_up': nrm(ks[28], (DEPTH, N_EXPERTS, D, EXPERT_FF), D ** -0.5),
        'exp_w_down': nrm(ks[29], (DEPTH, N_EXPERTS, EXPERT_FF, D), BETA * EXPERT_FF ** -0.5),
    }


def reference(x, c, ctx, c_ctx, w_ada, b_ada, w_in, attn_sink, ssm_lam_re, ssm_lam_im, ssm_log_dt,
              ssm_b_re, ssm_b_im, ssm_c_re, ssm_c_im, ssm_d, ssm_w_glu, ssm_b_glu, gla_w_gate,
              gla_b_gate, gla_norm_g, w_out, ln1_g, ln1_b, ln2_g, ln2_b, router, exp_w_gate,
              exp_w_up, exp_w_down):
    L = x.shape[1]
    ROWS = L // GRID_W
    rows = jnp.repeat(jnp.arange(ROWS), GRID_W)
    cols = jnp.tile(jnp.arange(GRID_W), ROWS)
    xc = ctx
    for l in range(DEPTH):
        need_ctx = l < DEPTH - 1
        p = {
            'w_in': w_in[l], 'attn_sink': attn_sink[l],
            'ssm_lam_re': ssm_lam_re[l], 'ssm_lam_im': ssm_lam_im[l], 'ssm_log_dt': ssm_log_dt[l],
            'ssm_b_re': ssm_b_re[l], 'ssm_b_im': ssm_b_im[l], 'ssm_c_re': ssm_c_re[l], 'ssm_c_im': ssm_c_im[l],
            'ssm_d': ssm_d[l], 'ssm_w_glu': ssm_w_glu[l], 'ssm_b_glu': ssm_b_glu[l],
            'gla_w_gate': gla_w_gate[l], 'gla_b_gate': gla_b_gate[l], 'gla_norm_g': gla_norm_g[l],
            'w_out': w_out[l], 'ln1_g': ln1_g[l], 'ln1_b': ln1_b[l], 'ln2_g': ln2_g[l], 'ln2_b': ln2_b[l],
            'router': router[l], 'exp_w_gate': exp_w_gate[l], 'exp_w_up': exp_w_up[l], 'exp_w_down': exp_w_down[l],
        }
        mod = (jax.nn.silu(c) @ w_ada[l] + b_ada[l])[:, None, :]
        mod_c = (jax.nn.silu(c_ctx) @ w_ada[l] + b_ada[l])[None, None, :]
        x, xc = trunk_layer(x, xc, mod, mod_c, p, rows, cols, need_ctx)
    return x
```

```cpp
#include <hip/hip_runtime.h>
#ifndef PROBE_SUB
#define PROBE_SUB 0
#endif
#include <cstdio>
#include <cstdint>

#define LAS __attribute__((address_space(3)))
typedef unsigned short bf16_t;
typedef short bf16x8 __attribute__((ext_vector_type(8)));
typedef short s16x4 __attribute__((ext_vector_type(4)));
typedef float f32x4 __attribute__((ext_vector_type(4)));
typedef float f32x2 __attribute__((ext_vector_type(2)));
typedef unsigned u32x4 __attribute__((ext_vector_type(4)));
typedef unsigned u32x2 __attribute__((ext_vector_type(2)));

constexpr int NB = 4, SEQ = 4096, CTXL = 256, DM = 2048;
constexpr int NLAT = NB * SEQ, NCTX = NB * CTXL, MT = NLAT + NCTX;
constexpr int NIN = 3616, NINP = 3840;
constexpr int C_Q = 0, C_K = 1024, C_V = 1280, C_SU = 1536, C_GQ = 2048, C_GK = 2304, C_GV = 2560, C_GR = 3072, C_GZ = 3584;
constexpr int NE = 16, ER = 2304;
constexpr float ALPHA = 1.41421356237309515f;
constexpr float LN_EPS = 1e-6f;
constexpr int NTHR = 512;
constexpr int LDS_BYTES = 163840;
constexpr int LDS_BAR_OFF = 163840 - 64;

constexpr size_t al256(size_t x) { return (x + 255) & ~(size_t)255; }
constexpr size_t WS_CTL = 0, CTL_BYTES = 1u << 20;
constexpr size_t WS_MODP = WS_CTL + CTL_BYTES;
constexpr size_t WS_MOD = WS_MODP + (size_t)2 * 32 * 5 * 12288 * 4;
constexpr size_t WS_ROPE = WS_MOD + (size_t)2 * 5 * 12288 * 4;
constexpr size_t WS_LAMT = WS_ROPE + 64 * 32 * 8;
constexpr size_t WS_WIN = al256(WS_LAMT + 2 * 32 * 2 * 64 * 8);
constexpr size_t WS_WOUT = WS_WIN + (size_t)2 * NINP * DM * 2;
constexpr size_t WS_WGLU = WS_WOUT + (size_t)2 * DM * DM * 2;
constexpr size_t WS_WGU = WS_WGLU + (size_t)2 * 512 * 512 * 2;
constexpr size_t WS_X2B = WS_WGU;
constexpr size_t WS_WDN = WS_WGU + (size_t)2 * NE * 4096 * DM * 2;
constexpr size_t WS_S5A = WS_WDN + (size_t)2 * NE * 2048 * DM * 2;
constexpr size_t WS_S5C = WS_S5A + (size_t)2 * 32 * 256 * 512 * 2;
constexpr size_t WS_X1 = WS_S5C + (size_t)2 * 32 * 512 * 768 * 2;
constexpr size_t WS_X2C = WS_X1 + (size_t)MT * DM * 4;
constexpr size_t WS_H = WS_X2C + (size_t)NCTX * DM * 4;
constexpr size_t WS_R1 = WS_H + (size_t)MT * DM * 2;
constexpr size_t R_BYTES = (size_t)NE * ER * DM * 2;
constexpr size_t WS_R2 = WS_R1 + R_BYTES;
constexpr size_t WS_R3 = WS_R2 + R_BYTES;
constexpr size_t R3_BYTES = (size_t)MT * DM * 2 + (size_t)MT * 512 * 2 + (size_t)32 * 68 * 8192 * 4;
constexpr size_t WS_SU = WS_R3 + R3_BYTES;
constexpr size_t WS_AFF = WS_SU + (size_t)32 * MT * 16 * 2;
constexpr size_t WS_TOKSLOT = WS_AFF + (size_t)MT * 16 * 4;
constexpr size_t WS_SELTOK = WS_TOKSLOT + (size_t)MT * 16 * 4;
constexpr size_t WS_S5S = WS_SELTOK + (size_t)NE * ER * 4;
constexpr size_t WS_S5IN = WS_S5S + (size_t)544 * 32 * 256 * 4;
constexpr size_t WS_GDEC = WS_S5IN + (size_t)544 * 32 * 256 * 2;
constexpr size_t WS_GST = WS_GDEC + (size_t)32 * 68 * 64 * 4;
constexpr size_t WS_GQIN = WS_GST + (size_t)32 * 68 * 8192 * 2;
constexpr size_t WS_GKP = WS_GQIN + (size_t)32 * 68 * 4096 * 2;
constexpr size_t WS_VT = WS_GKP + (size_t)32 * 68 * 4096 * 2;
constexpr size_t WS_END = WS_VT + (size_t)NE * 9 * 4096;
static_assert(R3_BYTES >= R_BYTES, "YE must fit in R3");
static_assert((size_t)MT * NINP * 2 <= R_BYTES && (size_t)MT * DM * 4 <= R_BYTES, "PROJ / Y fit");
static_assert(WS_END < (size_t)2000 * 1000 * 1000, "workspace budget");

__device__ __forceinline__ unsigned cvt_pk_bf16(float lo, float hi) { unsigned r; asm volatile("v_cvt_pk_bf16_f32 %0, %1, %2" : "=v"(r) : "v"(lo), "v"(hi)); return r; }
typedef _Float16 h2_t __attribute__((ext_vector_type(2)));
__device__ __forceinline__ unsigned cvt_pk_f16(float lo, float hi) { h2_t h; h.x = (_Float16)lo; h.y = (_Float16)hi; return __builtin_bit_cast(unsigned, h); }
__device__ __forceinline__ bf16_t f2bf(float x) { return (bf16_t)(cvt_pk_bf16(x, 0.f) & 0xffffu); }
__device__ __forceinline__ float bf2f(bf16_t b) { return __uint_as_float(((unsigned)b) << 16); }
__device__ __forceinline__ float bflo(unsigned w) { return __uint_as_float(w << 16); }
__device__ __forceinline__ float bfhi(unsigned w) { return __uint_as_float(w & 0xffff0000u); }
template <int O>
__device__ __forceinline__ float shx(float v) {
    const int x = __float_as_int(v);
    if constexpr (O == 1) return __int_as_float(__builtin_amdgcn_update_dpp(0, x, 0xB1, 0xF, 0xF, true));
    else if constexpr (O == 2) return __int_as_float(__builtin_amdgcn_update_dpp(0, x, 0x4E, 0xF, 0xF, true));
    else if constexpr (O == 4) { const int t = __builtin_amdgcn_update_dpp(0, x, 0x1B, 0xF, 0xF, true); return __int_as_float(__builtin_amdgcn_update_dpp(0, t, 0x141, 0xF, 0xF, true)); }
    else if constexpr (O == 8) return __int_as_float(__builtin_amdgcn_update_dpp(0, x, 0x128, 0xF, 0xF, true));
    else { const unsigned lane_ = __builtin_amdgcn_mbcnt_hi(~0u, __builtin_amdgcn_mbcnt_lo(~0u, 0u));
        if constexpr (O == 16) { const auto r = __builtin_amdgcn_permlane16_swap((unsigned)x, (unsigned)x, false, false); return __int_as_float((int)((lane_ & 16u) ? r[0] : r[1])); }
        else { static_assert(O == 32, "shx: power-of-two offsets below 64"); const auto r = __builtin_amdgcn_permlane32_swap((unsigned)x, (unsigned)x, false, false); return __int_as_float((int)((lane_ & 32u) ? r[0] : r[1])); } }
}
__device__ __forceinline__ float wave_sum_dpp(float x) {
    x += __int_as_float(__builtin_amdgcn_update_dpp(0, __float_as_int(x), 0xB1, 0xF, 0xF, true));
    x += __int_as_float(__builtin_amdgcn_update_dpp(0, __float_as_int(x), 0x4E, 0xF, 0xF, true));
    x += __int_as_float(__builtin_amdgcn_update_dpp(0, __float_as_int(x), 0x141, 0xF, 0xF, true));
    x += __int_as_float(__builtin_amdgcn_update_dpp(0, __float_as_int(x), 0x140, 0xF, 0xF, true));
    const int xi = __float_as_int(x);
    return __int_as_float(__builtin_amdgcn_readlane(xi, 0)) + __int_as_float(__builtin_amdgcn_readlane(xi, 16)) + __int_as_float(__builtin_amdgcn_readlane(xi, 32)) + __int_as_float(__builtin_amdgcn_readlane(xi, 48));
}
__device__ __forceinline__ float wave_sum(float v) { return wave_sum_dpp(v); }
__device__ __forceinline__ float wave_max(float v) { v = fmaxf(v, shx<1>(v)); v = fmaxf(v, shx<2>(v)); v = fmaxf(v, shx<4>(v)); v = fmaxf(v, shx<8>(v)); v = fmaxf(v, shx<16>(v)); return fmaxf(v, shx<32>(v)); }
__device__ __forceinline__ float sigmoidf_(float x) { return 1.0f / (1.0f + __expf(-x)); }
__device__ __forceinline__ float siluf_(float x) { return x / (1.0f + __expf(-x)); }
__device__ __forceinline__ float gelu_tanh(float x) { const float u = 0.7978845608028654f * (x + 0.044715f * x * x * x); const float e = __expf(-2.0f * fabsf(u)); const float t = (1.0f - e) / (1.0f + e); return 0.5f * x * (1.0f + (u < 0.f ? -t : t)); }
__device__ __forceinline__ float logsigmoidf_(float x) { return fminf(x, 0.f) - __logf(1.0f + __expf(-fabsf(x))); }
__device__ __forceinline__ s16x4 tr_read(unsigned lds_addr) { s16x4 r; asm volatile("ds_read_b64_tr_b16 %0, %1\n\ts_waitcnt lgkmcnt(0)" : "=&v"(r) : "v"(lds_addr) : "memory"); return r; }
__device__ __forceinline__ bf16x8 tr_read2(unsigned a0, unsigned a1) { s16x4 r0, r1; asm volatile("ds_read_b64_tr_b16 %0, %2\n\tds_read_b64_tr_b16 %1, %3\n\ts_waitcnt lgkmcnt(0)" : "=&v"(r0), "=&v"(r1) : "v"(a0), "v"(a1) : "memory");
    bf16x8 o; o[0] = r0[0]; o[1] = r0[1]; o[2] = r0[2]; o[3] = r0[3]; o[4] = r1[0]; o[5] = r1[1]; o[6] = r1[2]; o[7] = r1[3]; return o; }
__device__ __forceinline__ unsigned lds_addr_of(const LAS void* p) { return (unsigned)(uintptr_t)p; }
#define MFMA16(a, b, c) __builtin_amdgcn_mfma_f32_16x16x32_bf16((a), (b), (c), 0, 0, 0)
namespace pg8 {
#define PG8_LAS __attribute__((address_space(3)))
constexpr int BM = 256, BK = 64, HALF = 128, HTB = HALF * BK * 2  , STAGE_BYTES = 8 * HTB, NXCD = 8, WGM = 8;

__host__ __device__ __forceinline__ int lds_byte(int r, int c) { const int st = (r >> 4) * 2 + (c >> 5), rr = r & 15, cc = c & 31, ob = rr * 64 + cc * 2; return st * 1024 + (ob ^ (((ob >> 9) & 1) << 5)); }
__host__ __device__ __forceinline__ void stage_rc(int b, int& R, int& C) { const int st = b / 1024, sb = b % 1024, swz = sb ^ (((sb >> 9) & 1) << 5); R = (st >> 1) * 16 + swz / 64; C = (st & 1) * 32 + (swz % 64) / 2; }
__host__ __device__ __forceinline__ int perm32(int rho) { const int n = rho >> 4, i = rho & 15; return 8 * (i >> 2) + 4 * n + (i & 3); }

struct Unit { int pm, pn, pb, e, fl; };
struct Gemm { const bf16_t* A; const bf16_t* Bt; int M, N, K; };

struct StaticOrder {
    int nM, nN, nwg, G, c;
    __host__ __device__ void init(int M, int N, int G_, int c_) { nM = M / BM; nN = N / BM; nwg = nM * nN; G = G_; c = c_; }
    __host__ __device__ bool next(int i, Unit& u) const {
        const long L = (long)i * G + c; if (L >= nwg) return false;
        int wgid = (int)L; { const int q = nwg / NXCD, r = nwg % NXCD, xcd = wgid % NXCD, off = wgid / NXCD; wgid = (xcd < r ? xcd * (q + 1) : r * (q + 1) + (xcd - r) * q) + off; }
        const int nig = WGM * nN, gid = wgid / nig, fm = gid * WGM, gsz = (nM - fm) < WGM ? (nM - fm) : WGM;
        u.pm = fm + ((wgid % nig) % gsz); u.pn = (wgid % nig) / gsz; u.pb = u.pn; u.e = 0; u.fl = 0; return true;
    }
    __device__ __forceinline__ void a_ready(const Unit&) const {}
    __device__ __forceinline__ void done(const Unit&) const {}
    __device__ __forceinline__ void after_unit(int, int) const {}
    __device__ __forceinline__ void finish(int, int) const {}
};
template <class Epi, class Sched, int AGRP = 0  >
__device__ __forceinline__ void gemm_phase(PG8_LAS unsigned char* lds, const Gemm g, const Sched& S, const Epi& E, const int tid) {
    const int wid = __builtin_amdgcn_readfirstlane(tid >> 6), lane = tid & 63, wr = wid >> 2, wc = wid & 3, fr = lane & 15, fq = lane >> 4;
    const int K = g.K, nt = K / BK;
    unsigned voffA[2], voffB[2];
#pragma unroll
    for (int i = 0; i < 2; ++i) { int R, C; stage_rc(tid * 16 + i * 8192, R, C); const int Rb = Epi::PERM ? ((R & ~31) + perm32(R & 31)) : R;
        voffA[i] = AGRP ? (unsigned)((C >> 4) * AGRP * 16 + R * 16 + (C & 15)) * 2u : (unsigned)(R * K + C) * 2u; voffB[i] = (unsigned)(Rb * K + C) * 2u; }
    const size_t kstepB = (size_t)(BK * 2), hstepB = (size_t)HALF * K * 2, tstepB = 2 * hstepB;
    const size_t kstepA = AGRP ? (size_t)4 * AGRP * 32 : kstepB, hstepA = AGRP ? (size_t)HALF * 32 : hstepB, tstepA = 2 * hstepA;
    const unsigned ldsw = (unsigned)wid * 1024u;
    const int aoff = lds_byte(wr * 64 + fr, fq * 8), boff = lds_byte(wc * 32 + fr, fq * 8);
#define PG8_SA(b, h) (((b) * 2 + (h)) * HTB)
#define PG8_SB(b, h) ((4 + (b) * 2 + (h)) * HTB)
#define PG8_STAGE(bufoff, gbase, voff) do { _Pragma("unroll") for (int _i = 0; _i < 2; ++_i) \
        __builtin_amdgcn_global_load_lds((const unsigned*)((const char*)(gbase) + (voff)[_i]), (PG8_LAS unsigned*)(lds + (bufoff) + ldsw + _i * 8192), 16, 0, 0); } while (0)
#define PG8_LDA(dst, b, h) do { _Pragma("unroll") for (int m = 0; m < 4; ++m) _Pragma("unroll") for (int k = 0; k < 2; ++k) dst[m][k] = *(const PG8_LAS bf16x8*)(lds + PG8_SA(b, h) + aoff + m * 2048 + k * 1024); } while (0)
#define PG8_LDB(dst, b, h) do { _Pragma("unroll") for (int n = 0; n < 2; ++n) _Pragma("unroll") for (int k = 0; k < 2; ++k) dst[n][k] = *(const PG8_LAS bf16x8*)(lds + PG8_SB(b, h) + boff + n * 2048 + k * 1024); } while (0)
#define PG8_MMA(ai, bj, At, Bt) do { __builtin_amdgcn_s_setprio(1); _Pragma("unroll") for (int m = 0; m < 4; ++m) _Pragma("unroll") for (int n = 0; n < 2; ++n) _Pragma("unroll") for (int k = 0; k < 2; ++k) \
        acc[ai][bj][m][n] = __builtin_amdgcn_mfma_f32_16x16x32_bf16(Bt[n][k], At[m][k], acc[ai][bj][m][n], 0, 0, 0); __builtin_amdgcn_s_setprio(0); } while (0)
#define PG8_WAIT_V(n) asm volatile("s_waitcnt vmcnt(" #n ")" ::: "memory")
#define PG8_WAIT_L(n) asm volatile("s_waitcnt lgkmcnt(" #n ")" ::: "memory")
#define PG8_BAR __builtin_amdgcn_s_barrier()
#define PG8_SCHED __builtin_amdgcn_sched_barrier(0)
    Unit cur, nxt; int ui = 0;
#define PG8_UNI(u) do { (u).pm = __builtin_amdgcn_readfirstlane((u).pm); (u).pn = __builtin_amdgcn_readfirstlane((u).pn); (u).pb = __builtin_amdgcn_readfirstlane((u).pb); (u).e = __builtin_amdgcn_readfirstlane((u).e); (u).fl = __builtin_amdgcn_readfirstlane((u).fl); } while (0)
    if (!S.next(0, cur)) { S.finish(-1, tid); return; } PG8_UNI(cur);
    f32x4 acc[2][2][4][2];
#pragma unroll
    for (int a = 0; a < 2; ++a)
#pragma unroll
        for (int b = 0; b < 2; ++b)
#pragma unroll
            for (int m = 0; m < 4; ++m)
#pragma unroll
                for (int n = 0; n < 2; ++n) acc[a][b][m][n] = (f32x4){0.f, 0.f, 0.f, 0.f};
    bf16x8 At[4][2], B0[2][2], B1[2][2];
    const char* cA = (const char*)g.A + (size_t)cur.pm * tstepA; const char* cB = (const char*)g.Bt + (size_t)cur.pb * tstepB;
    S.a_ready(cur);
    PG8_STAGE(PG8_SB(0, 0), cB, voffB); PG8_STAGE(PG8_SA(0, 0), cA, voffA); PG8_STAGE(PG8_SB(0, 1), cB + hstepB, voffB); PG8_STAGE(PG8_SA(0, 1), cA + hstepA, voffA);
    if (wr == 1) PG8_BAR;
    PG8_WAIT_V(4); PG8_BAR;
    PG8_STAGE(PG8_SB(1, 0), cB + kstepB, voffB); PG8_STAGE(PG8_SA(1, 0), cA + kstepA, voffA); PG8_STAGE(PG8_SB(1, 1), cB + hstepB + kstepB, voffB);
    PG8_WAIT_V(6); PG8_BAR;
    for (;;) {
        const bool has_next = S.next(ui + 1, nxt); PG8_UNI(nxt);
        const char* nA = has_next ? (const char*)g.A + (size_t)nxt.pm * tstepA : cA; const char* nB = has_next ? (const char*)g.Bt + (size_t)nxt.pb * tstepB : cB;
        for (int t = 0; t < nt; t += 2) {
            const bool last = (t == nt - 2);
            const char* a1 = cA + (size_t)(t + 1) * kstepA;
            const char* a2 = last ? nA : cA + (size_t)(t + 2) * kstepA; const char* b2 = last ? nB : cB + (size_t)(t + 2) * kstepB;
            const char* a3 = a2 + kstepA; const char* b3 = b2 + kstepB;
            if (last && has_next) S.a_ready(nxt);
            PG8_LDB(B0, 0, 0); PG8_SCHED; PG8_LDA(At, 0, 0); PG8_STAGE(PG8_SA(1, 1), a1 + hstepA, voffA);
            PG8_WAIT_L(8); PG8_BAR; PG8_WAIT_L(0); PG8_MMA(0, 0, At, B0); PG8_BAR; PG8_SCHED;
            PG8_LDB(B1, 0, 1); PG8_STAGE(PG8_SB(0, 0), b2, voffB);
            PG8_BAR; PG8_WAIT_L(0); PG8_MMA(0, 1, At, B1); PG8_BAR;
            PG8_LDA(At, 0, 1); PG8_STAGE(PG8_SA(0, 0), a2, voffA);
            PG8_BAR; PG8_WAIT_L(0); PG8_MMA(1, 0, At, B0); PG8_BAR; PG8_SCHED;
            PG8_STAGE(PG8_SB(0, 1), b2 + hstepB, voffB);
            PG8_WAIT_V(6); PG8_BAR; PG8_MMA(1, 1, At, B1); PG8_BAR;
            PG8_LDB(B0, 1, 0); PG8_SCHED; PG8_LDA(At, 1, 0); PG8_STAGE(PG8_SA(0, 1), a2 + hstepA, voffA);
            PG8_WAIT_L(8); PG8_BAR; PG8_WAIT_L(0); PG8_MMA(0, 0, At, B0); PG8_BAR; PG8_SCHED;
            PG8_LDB(B1, 1, 1); PG8_STAGE(PG8_SB(1, 0), b3, voffB);
            PG8_BAR; PG8_WAIT_L(0); PG8_MMA(0, 1, At, B1); PG8_BAR;
            PG8_LDA(At, 1, 1); PG8_STAGE(PG8_SA(1, 0), a3, voffA);
            PG8_BAR; PG8_WAIT_L(0); PG8_MMA(1, 0, At, B0); PG8_BAR; PG8_SCHED;
            PG8_STAGE(PG8_SB(1, 1), b3 + hstepB, voffB);
            PG8_WAIT_V(6); PG8_BAR; PG8_MMA(1, 1, At, B1); PG8_BAR;
        }
        if constexpr (!Epi::AFTER_DRAIN) { for (int r_ = 0; r_ < (PROBE_SUB == 9 ? 2 : 1); ++r_) E(acc, cur, wr, wc, fr, fq); S.done(cur); S.after_unit(ui, tid); }
        if (!has_next) break;
#pragma unroll
        for (int a = 0; a < 2; ++a)
#pragma unroll
            for (int b = 0; b < 2; ++b)
#pragma unroll
                for (int m = 0; m < 4; ++m)
#pragma unroll
                    for (int n = 0; n < 2; ++n) acc[a][b][m][n] = (f32x4){0.f, 0.f, 0.f, 0.f};
        cur = nxt; cA = nA; cB = nB; ++ui;
    }
    S.finish(ui, tid);
    PG8_WAIT_V(0);
    if (wr == 0) PG8_BAR;
    PG8_BAR;
    if constexpr (Epi::AFTER_DRAIN) { E.fused(acc, cur, wr, wc, fr, fq, lds, wid, lane); S.done(cur); }
#undef PG8_SA
#undef PG8_SB
#undef PG8_STAGE
#undef PG8_LDA
#undef PG8_LDB
#undef PG8_MMA
#undef PG8_WAIT_V
#undef PG8_WAIT_L
#undef PG8_BAR
#undef PG8_SCHED
#undef PG8_UNI
}
template <class Epi>
__device__ __forceinline__ void gemm_quarter(PG8_LAS unsigned char* lds, const Gemm g, const int pm, const int pn, const int mh, const int nh, const Epi& E, const int tid) {
    const int wid = __builtin_amdgcn_readfirstlane(tid >> 6), lane = tid & 63, wr = wid >> 2, wc = wid & 3, fr = lane & 15, fq = lane >> 4;
    const int K = g.K, nt = K / BK;
    unsigned voffA[2], voffB[2];
#pragma unroll
    for (int i = 0; i < 2; ++i) { int R, C; stage_rc(tid * 16 + i * 8192, R, C); const int Rb = Epi::PERM ? ((R & ~31) + perm32(R & 31)) : R; voffA[i] = (unsigned)(R * K + C) * 2u; voffB[i] = (unsigned)(Rb * K + C) * 2u; }
    const char* cA = (const char*)g.A + ((size_t)pm * BM + (size_t)mh * HALF) * K * 2; const char* cB = (const char*)g.Bt + ((size_t)pn * BM + (size_t)nh * HALF) * K * 2;
    const unsigned ldsw = (unsigned)wid * 1024u;
    const int aoff = lds_byte(wr * 64 + fr, fq * 8), boff = lds_byte(wc * 32 + fr, fq * 8);
#define PQ_SA(b) (((b) * 2) * HTB)
#define PQ_SB(b) ((4 + (b) * 2) * HTB)
#define PQ_STAGE(bufoff, gbase, voff) do { _Pragma("unroll") for (int _i = 0; _i < 2; ++_i) \
        __builtin_amdgcn_global_load_lds((const unsigned*)((const char*)(gbase) + (voff)[_i]), (PG8_LAS unsigned*)(lds + (bufoff) + ldsw + _i * 8192), 16, 0, 0); } while (0)
    f32x4 acc[2][2][4][2];
#pragma unroll
    for (int a = 0; a < 2; ++a)
#pragma unroll
        for (int b = 0; b < 2; ++b)
#pragma unroll
            for (int m = 0; m < 4; ++m)
#pragma unroll
                for (int n = 0; n < 2; ++n) acc[a][b][m][n] = (f32x4){0.f, 0.f, 0.f, 0.f};
    PQ_STAGE(PQ_SA(0), cA, voffA); PQ_STAGE(PQ_SB(0), cB, voffB);
    for (int t = 0; t < nt; ++t) { const int b = t & 1;
        if (t + 1 < nt) { PQ_STAGE(PQ_SA(b ^ 1), cA + (size_t)(t + 1) * (BK * 2), voffA); PQ_STAGE(PQ_SB(b ^ 1), cB + (size_t)(t + 1) * (BK * 2), voffB); asm volatile("s_waitcnt vmcnt(4)" ::: "memory"); }
        else asm volatile("s_waitcnt vmcnt(0)" ::: "memory");
        __builtin_amdgcn_s_barrier();
        bf16x8 At[4][2], B0[2][2];
#pragma unroll
        for (int m = 0; m < 4; ++m)
#pragma unroll
            for (int k = 0; k < 2; ++k) At[m][k] = *(const PG8_LAS bf16x8*)(lds + (b ? PQ_SA(1) : PQ_SA(0)) + aoff + m * 2048 + k * 1024);
#pragma unroll
        for (int n = 0; n < 2; ++n)
#pragma unroll
            for (int k = 0; k < 2; ++k) B0[n][k] = *(const PG8_LAS bf16x8*)(lds + (b ? PQ_SB(1) : PQ_SB(0)) + boff + n * 2048 + k * 1024);
        asm volatile("s_waitcnt lgkmcnt(0)" ::: "memory");
#pragma unroll
        for (int m = 0; m < 4; ++m)
#pragma unroll
            for (int n = 0; n < 2; ++n)
#pragma unroll
                for (int k = 0; k < 2; ++k) acc[0][0][m][n] = __builtin_amdgcn_mfma_f32_16x16x32_bf16(B0[n][k], At[m][k], acc[0][0][m][n], 0, 0, 0);
        __builtin_amdgcn_s_barrier();
    }
    Unit u; u.pm = pm; u.pn = pn; u.pb = pn; u.e = 0; u.fl = 1 | 2 | (mh ? 8 : 0) | (nh ? 16 : 0);
    E(acc, u, wr, wc, fr, fq);
#undef PQ_SA
#undef PQ_SB
#undef PQ_STAGE
}
}
namespace pg8 {
struct GemmF { const bf16_t* A; const float* Bf0; const float* Bf1; size_t estride; int ncstep; int ldb; int K; bf16_t* img; const unsigned* vt = nullptr; };
__device__ __forceinline__ int g8swz(int k) { return (k & 1) | (((k >> 1) & 1) << 3) | (((k >> 3) & 1) << 4); }
template <class Epi, class Sched, int VAR = 0, bool IMG = false, bool GATH = false  >
__device__ __forceinline__ void gemm_phase_fb(PG8_LAS unsigned char* lds, const GemmF g, const Sched& S, const Epi& E, const int tid) {
    static_assert(Epi::PERM && !Epi::AFTER_DRAIN, "f32-B body: 2-byte-output epilogues only");
    const int wid = __builtin_amdgcn_readfirstlane(tid >> 6), lane = tid & 63, wr = wid >> 2, wc = wid & 3, fr = lane & 15, fq = lane >> 4;
    const int K = g.K, nt = K / BK;
    unsigned voffA0; { int R, C; stage_rc(tid * 16, R, C); voffA0 = (unsigned)(R * K + C) * 2u; }
    const unsigned kstepA = (unsigned)(BK * 2), hstepA = (unsigned)HALF * K * 2, tstepA = 2 * hstepA;
    const unsigned kstepB = (unsigned)BK * (unsigned)g.ldb * 4u;
    const unsigned ldsw = (unsigned)wid * 1024u;
    const int aoff = lds_byte(wr * 64 + fr, fq * 8);
    const int kr = tid >> 5, c4 = tid & 31;
    const unsigned voffBf = (unsigned)(kr * g.ldb + c4 * 4) * 4u; const unsigned jstepB = 16u * (unsigned)g.ldb * 4u;
    u32x4 rs0, rs1;
    { const unsigned long long p0 = (unsigned long long)(uintptr_t)g.Bf0, p1 = (unsigned long long)(uintptr_t)g.Bf1;
      rs0.x = __builtin_amdgcn_readfirstlane((unsigned)p0); rs0.y = __builtin_amdgcn_readfirstlane((unsigned)(p0 >> 32) & 0xffffu); rs0.z = 0x7fffffffu; rs0.w = 0x00020000u;
      rs1.x = __builtin_amdgcn_readfirstlane((unsigned)p1); rs1.y = __builtin_amdgcn_readfirstlane((unsigned)(p1 >> 32) & 0xffffu); rs1.z = 0x7fffffffu; rs1.w = 0x00020000u; }
    const __amdgpu_buffer_rsrc_t rsA = __builtin_amdgcn_make_buffer_rsrc((void*)g.A, 0, 0x7fffffff, 0x00020000);
    const __amdgpu_buffer_rsrc_t rsI = __builtin_amdgcn_make_buffer_rsrc((void*)g.img, 0, 0x7fffffff, 0x00020000);
    const unsigned istepI = (unsigned)(K / BK) * 32768u;
    const unsigned woffB = (unsigned)(kr * 256 + 8 * (c4 ^ g8swz(kr)));
    u32x2 vt = {0u, 0u}, vn = {0u, 0u}; unsigned c2 = 0; u32x4 rsV = {0u, 0u, 0u, 0u};
    if constexpr (GATH) { int R, C; stage_rc(tid * 16, R, C); c2 = (unsigned)C * 2u; const unsigned long long pv = (unsigned long long)(uintptr_t)g.vt;
        rsV.x = __builtin_amdgcn_readfirstlane((unsigned)pv); rsV.y = __builtin_amdgcn_readfirstlane((unsigned)(pv >> 32) & 0xffffu); rsV.z = 0x7fffffffu; rsV.w = 0x00020000u; }
    const unsigned lds0 = (unsigned)(uintptr_t)lds;
    unsigned btb0; { const int q = fr >> 2, p = fr & 3, krow = 8 * fq + q; btb0 = lds0 + (unsigned)(krow * 256 + 8 * ((8 * wc + 2 * p) ^ g8swz(krow))); }
#define PG8_SA(b, h) (((b) * 2 + (h)) * HTB)
#define PG8_SB(b, h) ((4 + (b) * 2 + (h)) * HTB)
#define PG8_STAGEA(b, h, base) do { if constexpr (GATH) { const unsigned _p = (h) ? vt.y : vt.x; \
        __builtin_amdgcn_raw_ptr_buffer_load_lds(rsA, (PG8_LAS void*)(lds + PG8_SA(b, h) + ldsw), 16, ((_p & 0xffffu) << 12) + c2, (base), 0, 0); \
        __builtin_amdgcn_raw_ptr_buffer_load_lds(rsA, (PG8_LAS void*)(lds + PG8_SA(b, h) + ldsw + 8192), 16, ((_p >> 16) << 12) + c2, (base), 0, 0); } else { _Pragma("unroll") for (int _i = 0; _i < 2; ++_i) \
        __builtin_amdgcn_raw_ptr_buffer_load_lds(rsA, (PG8_LAS void*)(lds + PG8_SA(b, h) + ldsw + _i * 8192), 16, voffA0, (base) + (unsigned)(h) * hstepA + (unsigned)_i * 128u * (unsigned)K, 0, 0); } } while (0)
#define PG8_BISSUE(R, rs, soff) do { if constexpr (VAR == 2 || VAR == 3 || VAR == 4) break; _Pragma("unroll") for (int _j = 0; _j < 4; ++_j) { const unsigned _so = (VAR == 5) ? (unsigned)__builtin_amdgcn_readfirstlane(_j * jstepB) : (unsigned)__builtin_amdgcn_readfirstlane((soff) + _j * jstepB); \
        asm volatile("buffer_load_dwordx4 %0, %1, %2, %3 offen" : "=v"(R[_j]) : "v"(voffBf), "s"(rs), "s"(_so) : "memory"); } } while (0)
#define PG8_RPIN(R) asm volatile("" : "+v"(R[0]), "+v"(R[1]), "+v"(R[2]), "+v"(R[3]))
#define PG8_BCOMMIT(R, bufoff, imgoff) do { if constexpr (VAR == 1 || VAR == 3 || VAR == 4) break; _Pragma("unroll") for (int _j = 0; _j < 4; ++_j) { u32x2 _w; _w.x = cvt_pk_bf16(R[_j][0], R[_j][1]); _w.y = cvt_pk_bf16(R[_j][2], R[_j][3]); \
        *(PG8_LAS u32x2*)(lds + (bufoff) + woffB + _j * 4096) = _w; \
        if constexpr (IMG) __builtin_amdgcn_raw_buffer_store_b64(_w, rsI, woffB, (unsigned)__builtin_amdgcn_readfirstlane((int)((imgoff) + _j * 4096)), 0); } } while (0)
#define PG8_WAIT_VC() do { if constexpr (IMG) asm volatile("s_waitcnt vmcnt(10)" ::: "memory"); else asm volatile("s_waitcnt vmcnt(6)" ::: "memory"); } while (0)
#define PG8_LDA(dst, b, h) do { _Pragma("unroll") for (int m = 0; m < 4; ++m) _Pragma("unroll") for (int k = 0; k < 2; ++k) dst[m][k] = *(const PG8_LAS bf16x8*)(lds + PG8_SA(b, h) + aoff + m * 2048 + k * 1024); } while (0)
#define PG8_LDBT(dst, b, h) do { if constexpr (VAR == 4) break; const unsigned _a0 = btb0 + PG8_SB(b, h), _a1 = (btb0 ^ 8u) + PG8_SB(b, h); s16x4 _r0, _r1, _r2, _r3, _r4, _r5, _r6, _r7; \
        asm volatile("ds_read_b64_tr_b16 %0, %8\n\tds_read_b64_tr_b16 %1, %8 offset:1024\n\tds_read_b64_tr_b16 %2, %8 offset:8192\n\tds_read_b64_tr_b16 %3, %8 offset:9216\n\t" \
                     "ds_read_b64_tr_b16 %4, %9\n\tds_read_b64_tr_b16 %5, %9 offset:1024\n\tds_read_b64_tr_b16 %6, %9 offset:8192\n\tds_read_b64_tr_b16 %7, %9 offset:9216" \
                     : "=&v"(_r0), "=&v"(_r1), "=&v"(_r2), "=&v"(_r3), "=&v"(_r4), "=&v"(_r5), "=&v"(_r6), "=&v"(_r7) : "v"(_a0), "v"(_a1) : "memory"); \
        dst[0][0] = (bf16x8){_r0[0], _r0[1], _r0[2], _r0[3], _r1[0], _r1[1], _r1[2], _r1[3]}; dst[0][1] = (bf16x8){_r2[0], _r2[1], _r2[2], _r2[3], _r3[0], _r3[1], _r3[2], _r3[3]}; \
        dst[1][0] = (bf16x8){_r4[0], _r4[1], _r4[2], _r4[3], _r5[0], _r5[1], _r5[2], _r5[3]}; dst[1][1] = (bf16x8){_r6[0], _r6[1], _r6[2], _r6[3], _r7[0], _r7[1], _r7[2], _r7[3]}; } while (0)
#define PG8_BPIN(Bt) asm volatile("" : "+v"(Bt[0][0]), "+v"(Bt[0][1]), "+v"(Bt[1][0]), "+v"(Bt[1][1]))
#define PG8_MMA(ai, bj, At, Bt) do { __builtin_amdgcn_s_setprio(1); _Pragma("unroll") for (int m = 0; m < 4; ++m) _Pragma("unroll") for (int n = 0; n < 2; ++n) _Pragma("unroll") for (int k = 0; k < 2; ++k) \
        acc[ai][bj][m][n] = __builtin_amdgcn_mfma_f32_16x16x32_bf16(Bt[n][k], At[m][k], acc[ai][bj][m][n], 0, 0, 0); __builtin_amdgcn_s_setprio(0); } while (0)
#define PG8_WAIT_V(n) asm volatile("s_waitcnt vmcnt(" #n ")" ::: "memory")
#define PG8_WAIT_L(n) asm volatile("s_waitcnt lgkmcnt(" #n ")" ::: "memory")
#define PG8_BAR __builtin_amdgcn_s_barrier()
#define PG8_SCHED __builtin_amdgcn_sched_barrier(0)
#define PG8_BOFF(u) ((unsigned)__builtin_amdgcn_readfirstlane((int)(((size_t)(u).e * g.estride + (size_t)(u).pn * g.ncstep) * 4)))
    Unit cur, nxt; int ui = 0;
#define PG8_UNI(u) do { (u).pm = __builtin_amdgcn_readfirstlane((u).pm); (u).pn = __builtin_amdgcn_readfirstlane((u).pn); (u).pb = __builtin_amdgcn_readfirstlane((u).pb); (u).e = __builtin_amdgcn_readfirstlane((u).e); (u).fl = __builtin_amdgcn_readfirstlane((u).fl); } while (0)
    if (!S.next(0, cur)) { S.finish(-1, tid); return; } PG8_UNI(cur);
    f32x4 acc[2][2][4][2];
#pragma unroll
    for (int a = 0; a < 2; ++a)
#pragma unroll
        for (int b = 0; b < 2; ++b)
#pragma unroll
            for (int m = 0; m < 4; ++m)
#pragma unroll
                for (int n = 0; n < 2; ++n) acc[a][b][m][n] = (f32x4){0.f, 0.f, 0.f, 0.f};
    bf16x8 At[4][2], B0[2][2], B1[2][2];
    f32x4 bp[4], bq[4];
    unsigned cA = GATH ? 0u : (unsigned)cur.pm * tstepA, cB = PG8_BOFF(cur), cI = (unsigned)cur.pb * istepI;
    if constexpr (GATH) { vt = *(const u32x2*)((const char*)g.vt + (size_t)cur.pm * 4096 + woffB); vn = vt; }
    S.a_ready(cur);
    PG8_BISSUE(bq, rs0, cB); PG8_STAGEA(0, 0, cA); PG8_BISSUE(bp, rs1, cB); PG8_STAGEA(0, 1, cA);
    if (wr == 1) PG8_BAR;
    PG8_WAIT_V(6); PG8_RPIN(bq); PG8_BCOMMIT(bq, PG8_SB(0, 0), cI); PG8_WAIT_L(0); PG8_BAR;
    PG8_BISSUE(bq, rs0, cB + kstepB); PG8_STAGEA(1, 0, cA + kstepA);
    PG8_WAIT_VC(); PG8_RPIN(bp); PG8_BCOMMIT(bp, PG8_SB(0, 1), cI + 16384u);
    PG8_BISSUE(bp, rs1, cB + kstepB);
    PG8_WAIT_VC(); PG8_RPIN(bq); PG8_BCOMMIT(bq, PG8_SB(1, 0), cI + 32768u);
    PG8_BISSUE(bq, rs0, cB + 2 * kstepB);
    PG8_WAIT_L(0); PG8_BAR;
    for (;;) {
        const bool has_next = S.next(ui + 1, nxt); PG8_UNI(nxt);
        const unsigned nA = GATH ? 0u : (has_next ? (unsigned)nxt.pm * tstepA : cA);
        const unsigned nV = (unsigned)__builtin_amdgcn_readfirstlane((has_next ? nxt.pm : cur.pm) * 4096);
        const unsigned nB = has_next ? PG8_BOFF(nxt) : cB; const unsigned nI = has_next ? (unsigned)nxt.pb * istepI : cI;
        for (int t = 0; t < nt; t += 2) {
            const bool last = (t == nt - 2);
            const unsigned a1 = cA + (unsigned)(t + 1) * kstepA, a2 = last ? nA : cA + (unsigned)(t + 2) * kstepA, a3 = a2 + kstepA;
            const unsigned b2 = last ? nB : cB + (unsigned)(t + 2) * kstepB, b3 = b2 + kstepB;
            const unsigned i2 = last ? nI : cI + (unsigned)(t + 2) * 32768u, i3 = i2 + 32768u;
            const unsigned b4 = (t + 4 < nt) ? cB + (unsigned)(t + 4) * kstepB : nB + (unsigned)(t + 4 - nt) * kstepB;
            if (last && has_next) S.a_ready(nxt);
            PG8_LDBT(B0, 0, 0); PG8_SCHED; PG8_LDA(At, 0, 0); PG8_STAGEA(1, 1, a1); if constexpr (GATH) { vt.x = last ? vn.x : vt.x; vt.y = last ? vn.y : vt.y; }
            PG8_WAIT_L(8); PG8_BAR; PG8_WAIT_L(0); PG8_BPIN(B0); PG8_MMA(0, 0, At, B0); PG8_BAR; PG8_SCHED;
            PG8_LDBT(B1, 0, 1); PG8_WAIT_VC(); PG8_RPIN(bp); if constexpr (GATH) asm volatile("buffer_load_dwordx2 %0, %1, %2, %3 offen" : "=v"(vn) : "v"(woffB), "s"(rsV), "s"(nV) : "memory");
            PG8_BCOMMIT(bp, PG8_SB(1, 1), cI + (unsigned)(t + 1) * 32768u + 16384u); PG8_BISSUE(bp, rs1, b2);
            PG8_BAR; PG8_WAIT_L(0); PG8_BPIN(B1); PG8_MMA(0, 1, At, B1); PG8_BAR;
            PG8_LDA(At, 0, 1); PG8_STAGEA(0, 0, a2);
            PG8_BAR; PG8_WAIT_L(0); PG8_MMA(1, 0, At, B0); PG8_BAR; PG8_SCHED;
            PG8_WAIT_VC(); PG8_RPIN(bq); PG8_BCOMMIT(bq, PG8_SB(0, 0), i2); PG8_BISSUE(bq, rs0, b3);
            PG8_BAR; PG8_MMA(1, 1, At, B1); PG8_BAR;
            PG8_LDBT(B0, 1, 0); PG8_SCHED; PG8_LDA(At, 1, 0); PG8_STAGEA(0, 1, a2);
            PG8_WAIT_L(8); PG8_BAR; PG8_WAIT_L(0); PG8_BPIN(B0); PG8_MMA(0, 0, At, B0); PG8_BAR; PG8_SCHED;
            PG8_LDBT(B1, 1, 1); PG8_WAIT_VC(); PG8_RPIN(bp); PG8_BCOMMIT(bp, PG8_SB(0, 1), i2 + 16384u); PG8_BISSUE(bp, rs1, b3);
            PG8_BAR; PG8_WAIT_L(0); PG8_BPIN(B1); PG8_MMA(0, 1, At, B1); PG8_BAR;
            PG8_LDA(At, 1, 1); PG8_STAGEA(1, 0, a3);
            PG8_BAR; PG8_WAIT_L(0); PG8_MMA(1, 0, At, B0); PG8_BAR; PG8_SCHED;
            PG8_WAIT_VC(); PG8_RPIN(bq); PG8_BCOMMIT(bq, PG8_SB(1, 0), i3); PG8_BISSUE(bq, rs0, b4);
            PG8_BAR; PG8_MMA(1, 1, At, B1); PG8_BAR;
        }
        { int fr_ = fr, fq_ = fq; asm volatile("" : "+v"(fr_), "+v"(fq_));
          for (int r_ = 0; r_ < (PROBE_SUB == 8 ? 2 : 1); ++r_) E(acc, cur, wr, wc, fr_, fq_); }
        S.done(cur);
        if (!has_next) break;
#pragma unroll
        for (int a = 0; a < 2; ++a)
#pragma unroll
            for (int b = 0; b < 2; ++b)
#pragma unroll
                for (int m = 0; m < 4; ++m)
#pragma unroll
                    for (int n = 0; n < 2; ++n) acc[a][b][m][n] = (f32x4){0.f, 0.f, 0.f, 0.f};
        cur = nxt; cA = nA; cB = nB; cI = nI; ++ui;
    }
    PG8_WAIT_V(0); PG8_WAIT_L(0);
    asm volatile("" :: "v"(bp[0]), "v"(bp[1]), "v"(bp[2]), "v"(bp[3]), "v"(bq[0]), "v"(bq[1]), "v"(bq[2]), "v"(bq[3]));
    if (wr == 0) PG8_BAR;
    PG8_BAR;
#undef PG8_SA
#undef PG8_SB
#undef PG8_STAGEA
#undef PG8_BISSUE
#undef PG8_BCOMMIT
#undef PG8_RPIN
#undef PG8_WAIT_VC
#undef PG8_LDA
#undef PG8_LDBT
#undef PG8_BPIN
#undef PG8_MMA
#undef PG8_WAIT_V
#undef PG8_WAIT_L
#undef PG8_BAR
#undef PG8_SCHED
#undef PG8_UNI
#undef PG8_BOFF
}
}
namespace pg8 {
struct GroupedOrder {
    int nE, nMt, nNt, ERT, G, c, mt0;
    __device__ __forceinline__ bool next(int i, Unit& u) const {
        const int nwg = nE * nMt * nNt; const long L = (long)i * G + c; if (L >= nwg) return false;
        int wgid = (int)L; { const int q = nwg / NXCD, r = nwg % NXCD, xcd = wgid % NXCD, off = wgid / NXCD; wgid = (xcd < r ? xcd * (q + 1) : r * (q + 1) + (xcd - r) * q) + off; }
        const int per = nMt * nNt, e = wgid / per, rem = wgid % per, mt = rem % nMt, nt = rem / nMt;
        u.e = e; u.pm = e * ERT + mt0 + mt; u.pn = nt; u.pb = e * nNt + nt; u.fl = 0; return true;
    }
    __device__ __forceinline__ void a_ready(const Unit&) const {}
    __device__ __forceinline__ void done(const Unit&) const {}
    __device__ __forceinline__ void after_unit(int, int) const {}
    __device__ __forceinline__ void finish(int, int) const {}
};
struct OutOrder0 {
    StaticOrder S0; int G, c, split;
    __device__ __forceinline__ bool next(int i, Unit& u) const {
        const long L = (long)i * G + c; if (!split || L < 512) return S0.next(i, u);
        const int h = (int)L - 512; if (h >= 64) return false;
        u.pm = 64 + (h >> 4); u.pn = (h >> 1) & 7; u.pb = u.pn; u.e = 0; u.fl = (h & 1) ? 4 : 2; return true;
    }
    __device__ __forceinline__ void a_ready(const Unit&) const {}
    __device__ __forceinline__ void done(const Unit&) const {}
    __device__ __forceinline__ void after_unit(int, int) const {}
    __device__ __forceinline__ void finish(int, int) const {}
};

__device__ __forceinline__ int g8swz_(int k) { return (k & 1) | (((k >> 1) & 1) << 3) | (((k >> 3) & 1) << 4); }
struct ConvJob {
    const float* W0; const float* W1; size_t estride; int ncstep, ldb, nNt; bf16_t* img; int q0, q1, slot;
    __device__ __forceinline__ void run(int tid) const {
        const int kr = tid >> 5, c4 = tid & 31; const unsigned woff = (unsigned)(kr * 256 + 8 * (c4 ^ g8swz_(kr)));
        for (int q = q0; q < q1; q += 2) {
            f32x4 v[2][2][4];
#pragma unroll
            for (int u = 0; u < 2; ++u) { const int qq = (q + u < q1) ? q + u : q; const int pb = qq >> 5, kt = qq & 31, e = pb / nNt, nt = pb % nNt;
#pragma unroll
                for (int h = 0; h < 2; ++h) { const float* src = (h ? W1 : W0) + (size_t)e * estride + (size_t)nt * ncstep + (size_t)(kt * 64 + kr) * ldb + 4 * c4;
#pragma unroll
                    for (int j = 0; j < 4; ++j) v[u][h][j] = *(const f32x4*)(src + (size_t)(16 * j) * ldb); } }
#pragma unroll
            for (int u = 0; u < 2; ++u) { if (q + u >= q1) break; const int qq = q + u; const int pb = qq >> 5, kt = qq & 31;
                unsigned char* dst = (unsigned char*)img + (size_t)pb * 1048576 + (size_t)kt * 32768 + woff;
#pragma unroll
                for (int h = 0; h < 2; ++h)
#pragma unroll
                    for (int j = 0; j < 4; ++j) { u32x2 w; w.x = cvt_pk_bf16(v[u][h][j][0], v[u][h][j][1]); w.y = cvt_pk_bf16(v[u][h][j][2], v[u][h][j][3]); *(u32x2*)(dst + h * 16384 + j * 4096) = w; } }
        }
        asm volatile("s_waitcnt vmcnt(0)" ::: "memory");
    }
};
struct StaticOrderConv : StaticOrder { ConvJob job;
    __device__ __forceinline__ void after_unit(int ui, int tid) const { if (ui == job.slot) job.run(tid); }
    __device__ __forceinline__ void finish(int last, int tid) const { if (last < job.slot) job.run(tid); } };
struct GroupedOrderConv : GroupedOrder { ConvJob job;
    __device__ __forceinline__ void after_unit(int ui, int tid) const { if (ui == job.slot) job.run(tid); }
    __device__ __forceinline__ void finish(int last, int tid) const { if (last < job.slot) job.run(tid); } };
struct EpiProj {
    static constexpr bool PERM = true, AFTER_DRAIN = false;
    bf16_t* proj; bf16_t* su; const float* rope;
    __device__ __forceinline__ void operator()(const f32x4 (&acc)[2][2][4][2], const Unit& u, int wr, int wc, int fr, int fq) const {
        const int row0 = u.pm * BM + wr * 64 + fr; const int colt = u.pn * BM;
        const bool do_rope = (u.pn < 5) && (u.pm < 64);
        const bool is_su = (u.pn == 6) || (u.pn == 7);
#pragma unroll
        for (int ai = 0; ai < 2; ++ai)
#pragma unroll
            for (int m = 0; m < 4; ++m) {
                const int row = row0 + ai * HALF + m * 16;
#pragma unroll
                for (int bj = 0; bj < 2; ++bj) {
                    const int col = colt + bj * HALF + wc * 32 + 8 * fq;
                    f32x4 v0 = acc[ai][bj][m][0], v1 = acc[ai][bj][m][1];
                    if (do_rope) {
                        const int jj = col & 127, t = row & 4095; const int pos = (jj < 64) ? (t >> 6) : (t & 63); const int i0 = (jj & 63) >> 1;
                        const f32x4 cs0 = *(const f32x4*)(rope + (pos * 32 + i0) * 2), cs1 = *(const f32x4*)(rope + (pos * 32 + i0 + 2) * 2);
                        f32x4 o0, o1;
                        o0[0] = v0[0] * cs0[0] - v0[1] * cs0[1]; o0[1] = v0[1] * cs0[0] + v0[0] * cs0[1];
                        o0[2] = v0[2] * cs0[2] - v0[3] * cs0[3]; o0[3] = v0[3] * cs0[2] + v0[2] * cs0[3];
                        o1[0] = v1[0] * cs1[0] - v1[1] * cs1[1]; o1[1] = v1[1] * cs1[0] + v1[0] * cs1[1];
                        o1[2] = v1[2] * cs1[2] - v1[3] * cs1[3]; o1[3] = v1[3] * cs1[2] + v1[2] * cs1[3];
                        v0 = o0; v1 = o1;
                    }
                    u32x4 w; w.x = cvt_pk_bf16(v0[0], v0[1]); w.y = cvt_pk_bf16(v0[2], v0[3]); w.z = cvt_pk_bf16(v1[0], v1[1]); w.w = cvt_pk_bf16(v1[2], v1[3]);
                    if (is_su) { const int g = (col - C_SU) >> 4, h0 = col & 15; *(u32x4*)(su + ((size_t)g * MT + row) * 16 + h0) = w; }
                    else *(u32x4*)(proj + (size_t)row * NINP + col) = w;
                }
            }
    }
};
struct EpiGlu {
    static constexpr bool PERM = true, AFTER_DRAIN = false;
    const bf16_t* z; const float* bias; bf16_t* mix;
    __device__ __forceinline__ void operator()(const f32x4 (&acc)[2][2][4][2], const Unit& u, int wr, int wc, int fr, int fq) const {
        const int row0 = u.pm * BM + wr * 64 + fr; const int colt = u.pn * BM;
#pragma unroll
        for (int ai = 0; ai < 2; ++ai)
#pragma unroll
            for (int m = 0; m < 4; ++m) {
                const int row = row0 + ai * HALF + m * 16;
#pragma unroll
                for (int bj = 0; bj < 2; ++bj) {
                    const int col = colt + bj * HALF + wc * 32 + 8 * fq;
                    const f32x4 b0 = *(const f32x4*)(bias + col), b1 = *(const f32x4*)(bias + col + 4);
                    const u32x4 zz = *(const u32x4*)(z + ((size_t)(col >> 4) * MT + row) * 16 + (col & 15));
                    const f32x4 v0 = acc[ai][bj][m][0] + b0, v1 = acc[ai][bj][m][1] + b1;
                    float o[8];
                    o[0] = bflo(zz.x) * sigmoidf_(v0[0]); o[1] = bfhi(zz.x) * sigmoidf_(v0[1]); o[2] = bflo(zz.y) * sigmoidf_(v0[2]); o[3] = bfhi(zz.y) * sigmoidf_(v0[3]);
                    o[4] = bflo(zz.z) * sigmoidf_(v1[0]); o[5] = bfhi(zz.z) * sigmoidf_(v1[1]); o[6] = bflo(zz.w) * sigmoidf_(v1[2]); o[7] = bfhi(zz.w) * sigmoidf_(v1[3]);
                    u32x4 w; w.x = cvt_pk_bf16(o[0], o[1]); w.y = cvt_pk_bf16(o[2], o[3]); w.z = cvt_pk_bf16(o[4], o[5]); w.w = cvt_pk_bf16(o[6], o[7]);
                    *(u32x4*)(mix + (size_t)row * DM + 1024 + col) = w;
                }
            }
    }
};
struct EpiF32 {
    static constexpr bool PERM = false, AFTER_DRAIN = false;
    float* C; int ldc;
    __device__ __forceinline__ void operator()(const f32x4 (&acc)[2][2][4][2], const Unit& u, int wr, int wc, int fr, int fq) const {
        const int row0 = u.pm * BM + wr * 64 + fr, col0 = u.pn * BM + wc * 32 + 4 * fq;
#pragma unroll
        for (int ai = 0; ai < 2; ++ai)
#pragma unroll
            for (int m = 0; m < 4; ++m) { float* rowp = C + (size_t)(row0 + ai * HALF + m * 16) * ldc + col0;
#pragma unroll
                for (int bj = 0; bj < 2; ++bj)
#pragma unroll
                    for (int n = 0; n < 2; ++n) *(f32x4*)(rowp + bj * HALF + n * 16) = acc[ai][bj][m][n]; }
    }
};
struct EpiGateUp {
    static constexpr bool PERM = true, AFTER_DRAIN = false;
    bf16_t* hid;
    __device__ __forceinline__ void operator()(const f32x4 (&acc)[2][2][4][2], const Unit& u, int wr, int wc, int fr, int fq) const {
        const int row0 = u.pm * BM + wr * 64 + fr; const int col = u.pn * HALF + wc * 32 + 8 * fq;
#pragma unroll
        for (int ai = 0; ai < 2; ++ai) { if (ai == 1 && (u.fl & 1)) continue;
#pragma unroll
            for (int m = 0; m < 4; ++m) {
                const int row = row0 + ai * HALF + m * 16;
                const f32x4 g0 = acc[ai][0][m][0], g1 = acc[ai][0][m][1], u0 = acc[ai][1][m][0], u1 = acc[ai][1][m][1];
                u32x4 w; w.x = cvt_pk_bf16(siluf_(g0[0]) * u0[0], siluf_(g0[1]) * u0[1]); w.y = cvt_pk_bf16(siluf_(g0[2]) * u0[2], siluf_(g0[3]) * u0[3]);
                w.z = cvt_pk_bf16(siluf_(g1[0]) * u1[0], siluf_(g1[1]) * u1[1]); w.w = cvt_pk_bf16(siluf_(g1[2]) * u1[2], siluf_(g1[3]) * u1[3]);
                *(u32x4*)(hid + (size_t)row * DM + col) = w;
            } }
    }
};
struct EpiBf16 {
    static constexpr bool PERM = true, AFTER_DRAIN = false;
    bf16_t* O; int ldc;
    __device__ __forceinline__ void operator()(const f32x4 (&acc)[2][2][4][2], const Unit& u, int wr, int wc, int fr, int fq) const {
        const int row0 = u.pm * BM + wr * 64 + fr + ((u.fl & 8) ? HALF : 0); const int colt = u.pn * BM + ((u.fl & 16) ? HALF : 0);
#pragma unroll
        for (int ai = 0; ai < 2; ++ai) { if (ai == 1 && (u.fl & 1)) continue;
#pragma unroll
            for (int m = 0; m < 4; ++m) {
                bf16_t* rowp = O + (size_t)(row0 + ai * HALF + m * 16) * ldc + colt + wc * 32 + 8 * fq;
#pragma unroll
                for (int bj = 0; bj < 2; ++bj) { if ((bj == 1 && (u.fl & 2)) || (bj == 0 && (u.fl & 4))) continue; const f32x4 v0 = acc[ai][bj][m][0], v1 = acc[ai][bj][m][1];
                    u32x4 w; w.x = cvt_pk_bf16(v0[0], v0[1]); w.y = cvt_pk_bf16(v0[2], v0[3]); w.z = cvt_pk_bf16(v1[0], v1[1]); w.w = cvt_pk_bf16(v1[2], v1[3]);
                    *(u32x4*)(rowp + bj * HALF) = w; }
            } }
    }
};
}
struct Args { const float* in[30]; float* out; unsigned char* ws; int ph_lo, ph_hi; };
struct Frame {
    const float* const* in; float* out; unsigned char* ws; LAS unsigned char* lds; int tid, lane, wave, G, bid;
};
#define WSP(T, off) ((T*)(F.ws + (off)))

__device__ __forceinline__ int rope_perm(int o) { return (o < 64) ? (2 * (o & 31) + (o >> 5)) : (64 + 2 * ((o - 64) & 31) + ((o - 64) >> 5)); }
struct TileDesc { const float* src; bf16_t* dst; int ldn, nvalid, K, n0, k0, mode, ebase; };
__device__ __forceinline__ void tile_decode(const Frame& F, int q, TileDesc& d) {
    const int l = q / 752; q %= 752;
    if (q < 480) { d.src = F.in[6] + (size_t)l * DM * NIN; d.ldn = NIN; d.nvalid = NIN; d.K = DM; d.n0 = (q >> 3) * 64; d.k0 = (q & 7) * 256; d.dst = WSP(bf16_t, WS_WIN) + (size_t)l * NINP * DM; d.mode = 1; d.ebase = 0; }
    else if (q < 736) { q -= 480; d.src = F.in[21] + (size_t)l * DM * DM; d.ldn = DM; d.nvalid = DM; d.K = DM; d.n0 = (q >> 3) * 64; d.k0 = (q & 7) * 256; d.dst = WSP(bf16_t, WS_WOUT) + (size_t)l * DM * DM; d.mode = 0; d.ebase = 0; }
    else { q -= 736; d.src = F.in[16] + (size_t)l * 512 * 512; d.ldn = 512; d.nvalid = 512; d.K = 512; d.n0 = (q >> 1) * 64; d.k0 = (q & 1) * 256; d.dst = WSP(bf16_t, WS_WGLU) + (size_t)l * 512 * 512; d.mode = 0; d.ebase = 0; }
}
__device__ __forceinline__ void tile_load(const Frame& F, const TileDesc& d, f32x4 (&v)[8]) {
    const int kk = F.tid >> 4, n4 = (F.tid & 15) * 4;
#pragma unroll
    for (int i = 0; i < 8; ++i) { v[i] = (f32x4){0.f, 0.f, 0.f, 0.f}; if (d.n0 + n4 < d.nvalid) v[i] = *(const f32x4*)(d.src + (size_t)(d.k0 + kk + 32 * i) * d.ldn + d.n0 + n4); }
}
__device__ __forceinline__ void tile_to_lds(const Frame& F, const f32x4 (&v)[8]) {
    LAS float* tile = (LAS float*)F.lds; const int kk = F.tid >> 4, n4 = (F.tid & 15) * 4;
#pragma unroll
    for (int i = 0; i < 8; ++i) { const int k = kk + 32 * i; tile[k * 65 + n4 + 0] = v[i][0]; tile[k * 65 + n4 + 1] = v[i][1]; tile[k * 65 + n4 + 2] = v[i][2]; tile[k * 65 + n4 + 3] = v[i][3]; }
}
__device__ __forceinline__ void tile_store(const Frame& F, const TileDesc& d) {
    LAS float* tile = (LAS float*)F.lds; const int t = F.tid; const int n = t >> 3; const int ng = d.n0 + n; int drow;
    if (d.mode == 0) drow = ng;
    else if (d.mode == 1) { if (ng < 1280) drow = (ng & ~127) + rope_perm(ng & 127); else drow = ng; }
    else drow = d.ebase + (ng >> 7) * 256 + (ng & 127);
#pragma unroll
    for (int q = 0; q < 4; ++q) { const int k8 = (t & 7) * 8 + 64 * q; float v[8];
#pragma unroll
        for (int jj = 0; jj < 8; ++jj) v[jj] = tile[(k8 + jj) * 65 + n];
        u32x4 w; w.x = cvt_pk_bf16(v[0], v[1]); w.y = cvt_pk_bf16(v[2], v[3]); w.z = cvt_pk_bf16(v[4], v[5]); w.w = cvt_pk_bf16(v[6], v[7]);
        *(u32x4*)(d.dst + (size_t)drow * d.K + d.k0 + k8) = w; }
}
__device__ __forceinline__ void mod_partial(const Frame& F, int item) {
    const int l = item / 192, rem = item % 192, ks = rem / 6, cb = rem % 6;
    LAS float* sv = (LAS float*)F.lds;
    if (F.tid < 320) { const int r = F.tid >> 6, k = F.tid & 63; const float c = (r < 4) ? F.in[1][r * DM + ks * 64 + k] : F.in[3][ks * 64 + k]; sv[F.tid] = siluf_(c); }
    __syncthreads();
    const int col = cb * 2048 + F.tid * 4;
    const float* w = F.in[4] + (size_t)l * DM * 12288 + (size_t)(ks * 64) * 12288 + col;
    f32x4 a0 = {0, 0, 0, 0}, a1 = a0, a2 = a0, a3 = a0, a4 = a0;
#pragma unroll 4
    for (int k = 0; k < 64; ++k) { const f32x4 wv = *(const f32x4*)(w + (size_t)k * 12288);
        a0 += wv * sv[k]; a1 += wv * sv[64 + k]; a2 += wv * sv[128 + k]; a3 += wv * sv[192 + k]; a4 += wv * sv[256 + k]; }
    float* p = WSP(float, WS_MODP) + ((size_t)(l * 32 + ks) * 5) * 12288 + col;
    *(f32x4*)(p) = a0; *(f32x4*)(p + 12288) = a1; *(f32x4*)(p + 2 * 12288) = a2; *(f32x4*)(p + 3 * 12288) = a3; *(f32x4*)(p + 4 * 12288) = a4;
    __syncthreads();
}
__device__ __forceinline__ void rope_table(const Frame& F) {
    float* rp = WSP(float, WS_ROPE);
    for (int e = F.tid; e < 2048; e += NTHR) { const int pos = e >> 5, i = e & 31; const float inv = powf(10000.0f, -(float)i / 32.0f); const float ang = (float)pos * inv;
        rp[e * 2] = cosf(ang); rp[e * 2 + 1] = sinf(ang); }
}
__device__ __forceinline__ void s5_weights(const Frame& F, int l, int g, int hq) {
    LAS f32x2* pw = (LAS f32x2*)F.lds;
    LAS f32x2* bb = pw + 2 * 33 * 64;
    LAS f32x2* cc = bb + 2 * 64 * 16;
    LAS f32x2* cf = cc + 2 * 16 * 64;
    LAS float* Kt = (LAS float*)(cf + 128);
    const int t = F.tid;
    if (t < 128) { const int d = t >> 6, p = t & 63; const size_t ix = ((size_t)(l * 2 + d) * 32 + g) * 64 + p;
        const float lre = F.in[8][ix], lim = F.in[9][ix]; const float dt = expf(F.in[10][(l * 2 + d) * 32 + g]);
        const float ar = lre * dt, ai = lim * dt; const float mag = expf(ar); const float c = cosf(ai), s = sinf(ai); const f32x2 lb = {mag * c, mag * s};
        const float sh = sinf(0.5f * ai); const float nx = expm1f(ar) * c - 2.0f * sh * sh, ny = mag * s;
        const float den = lre * lre + lim * lim; cf[t] = (f32x2){(nx * lre + ny * lim) / den, (ny * lre - nx * lim) / den};
        f32x2 cur = {1.f, 0.f}; pw[(d * 33 + 0) * 64 + p] = cur;
        for (int k = 1; k <= 32; ++k) { const f32x2 nx2 = {cur.x * lb.x - cur.y * lb.y, cur.x * lb.y + cur.y * lb.x}; cur = nx2; pw[(d * 33 + k) * 64 + p] = cur; }
        if (hq == 0) WSP(f32x2, WS_LAMT)[((size_t)(l * 32 + g) * 2 + d) * 64 + p] = cur; }
    for (int e = t; e < 2048; e += NTHR) { const int d = e >> 10, h = (e >> 6) & 15, p = e & 63;
        const size_t ic = (((size_t)(l * 2 + d) * 32 + g) * 16 + h) * 64 + p; cc[(d * 16 + h) * 64 + p] = (f32x2){F.in[13][ic], F.in[14][ic]}; }
    __syncthreads();
    for (int e = t; e < 2048; e += NTHR) { const int d = e >> 10, p = (e >> 4) & 63, h = e & 15;
        const size_t ib = (((size_t)(l * 2 + d) * 32 + g) * 64 + p) * 16 + h; const float br = F.in[11][ib], bi = F.in[12][ib]; const f32x2 c = cf[d * 64 + p];
        bb[(d * 64 + p) * 16 + h] = (f32x2){c.x * br - c.y * bi, c.x * bi + c.y * br}; }
    __syncthreads();
    for (int e = t; e < 4096; e += NTHR) { const int d = e >> 11, j = (e >> 6) & 31, hp = 4 * hq + ((e >> 4) & 3), h = e & 15; float acc = 0.f;
#pragma unroll 4
        for (int p = 0; p < 64; ++p) { const f32x2 c = cc[(d * 16 + hp) * 64 + p], w = pw[(d * 33 + j) * 64 + p], b = bb[(d * 64 + p) * 16 + h];
            const float tx = c.x * w.x - c.y * w.y, ty = c.x * w.y + c.y * w.x; acc += tx * b.x - ty * b.y; }
        Kt[((d * 32 + j) * 16 + hp) * 16 + h] = acc; }
    __syncthreads();
    bf16_t* Wa = WSP(bf16_t, WS_S5A) + (size_t)(l * 32 + g) * 256 * 512;
    for (int e = hq * 16384 + t; e < (hq + 1) * 16384; e += NTHR) { const int p2 = e * 2, j = p2 & 7, lane = (p2 >> 3) & 63, f = p2 >> 9, ntile = f >> 4, ks = f & 15; const int n = ntile * 16 + (lane & 15), k2 = ks * 32 + (lane >> 4) * 8 + j;
        const int d = n >> 7, p = (n >> 1) & 63, c = n & 1; const int s = k2 >> 4, h = k2 & 15;
        const f32x2 w = pw[(d * 33 + (d == 0 ? 31 - s : s)) * 64 + p]; const f32x2 b0 = bb[(d * 64 + p) * 16 + h], b1 = bb[(d * 64 + p) * 16 + h + 1];
        const float v0 = c == 0 ? (w.x * b0.x - w.y * b0.y) : (w.x * b0.y + w.y * b0.x), v1 = c == 0 ? (w.x * b1.x - w.y * b1.y) : (w.x * b1.y + w.y * b1.x);
        *(unsigned*)(Wa + p2) = cvt_pk_bf16(v0, v1); }
    bf16_t* Wc = WSP(bf16_t, WS_S5C) + (size_t)(l * 32 + g) * 512 * 768;
    for (int e = t; e < 768 * 64; e += NTHR) { const int jp = e & 3, il = (e >> 2) & 3, g4 = (e >> 4) & 3, f = e >> 6; const int lane = g4 * 16 + 4 * hq + il, j = 2 * jp, p2 = (f * 64 + lane) * 8 + j, ntile = f / 24, ks = f % 24;
        const int n = ntile * 16 + (lane & 15), k2 = ks * 32 + g4 * 8 + j;
        const int tt = n >> 4, hp = n & 15; float v0, v1;
        if (k2 < 512) { const int s = k2 >> 4, h = k2 & 15; v0 = 0.f; v1 = 0.f;
            if (s <= tt) { v0 += Kt[((0 * 32 + (tt - s)) * 16 + hp) * 16 + h]; v1 += Kt[((0 * 32 + (tt - s)) * 16 + hp) * 16 + h + 1]; }
            if (s >= tt) { v0 += Kt[((1 * 32 + (s - tt)) * 16 + hp) * 16 + h]; v1 += Kt[((1 * 32 + (s - tt)) * 16 + hp) * 16 + h + 1]; } }
        else { const int d = (k2 - 512) >> 7, p = ((k2 - 512) >> 1) & 63; const f32x2 c = cc[(d * 16 + hp) * 64 + p], w = pw[(d * 33 + (d == 0 ? tt + 1 : 32 - tt)) * 64 + p];
            v0 = c.x * w.x - c.y * w.y; v1 = -(c.x * w.y + c.y * w.x); }
        *(unsigned*)(Wc + p2) = cvt_pk_bf16(v0, v1); }
    __syncthreads();
}
__device__ __forceinline__ void phase_prologue(const Frame& F) {
    int it = F.bid;
    for (; it < 256; it += F.G) s5_weights(F, it >> 7, (it >> 2) & 31, it & 3);
    for (; it < 256 + 384; it += F.G) mod_partial(F, it - 256);
    if (it == 640) { rope_table(F); it += F.G; }
    const int NT_ALL = 2 * 752;
    int q = it - 641;
    if (q < NT_ALL) {
        TileDesc d0, d1; f32x4 v0[8], v1[8];
        tile_decode(F, q, d0); tile_load(F, d0, v0);
        bool has1 = (q + F.G) < NT_ALL; d1 = d0; if (has1) { tile_decode(F, q + F.G, d1); tile_load(F, d1, v1); }
        for (;;) {
            tile_to_lds(F, v0); __syncthreads();
            const TileDesc c0 = d0; const bool has2 = (q + 2 * F.G) < NT_ALL;
            if (has2) { tile_decode(F, q + 2 * F.G, d0); tile_load(F, d0, v0); }
            tile_store(F, c0); __syncthreads();
            if (!has1) break;
            tile_to_lds(F, v1); __syncthreads();
            const TileDesc c1 = d1; const bool has3 = (q + 3 * F.G) < NT_ALL;
            if (has3) { tile_decode(F, q + 3 * F.G, d1); tile_load(F, d1, v1); }
            tile_store(F, c1); __syncthreads();
            if (!has2) break;
            q += 2 * F.G; has1 = has3;
        }
    }
}
__device__ __forceinline__ void phase_mod_reduce(const Frame& F) {
    for (int e = F.bid * NTHR + F.tid; e < 2 * 5 * 12288; e += F.G * NTHR) { const int l = e / 61440, rem = e % 61440, col = rem % 12288;
        float s = F.in[5][l * 12288 + col]; const float* p = WSP(float, WS_MODP) + (size_t)l * 32 * 61440 + rem;
        float pv[32];
#pragma unroll
        for (int ks = 0; ks < 32; ++ks) pv[ks] = p[(size_t)ks * 61440];
#pragma unroll
        for (int ks = 0; ks < 32; ++ks) s += pv[ks];
        WSP(float, WS_MOD)[e] = s; }
}
__device__ __forceinline__ void row_stats(const float (&v)[32], float& mu, float& rstd) {
    float s = 0.f;
#pragma unroll
    for (int i = 0; i < 32; ++i) s += v[i];
    mu = wave_sum(s) * (1.0f / 2048.0f); float q = 0.f;
#pragma unroll
    for (int i = 0; i < 32; ++i) { const float d = v[i] - mu; q += d * d; }
    rstd = rsqrtf(wave_sum(q) * (1.0f / 2048.0f) + LN_EPS);
}
__device__ __forceinline__ void load_row32(const float* p, int lane, float (&v)[32]) {
#pragma unroll
    for (int i = 0; i < 8; ++i) { const f32x4 t = *(const f32x4*)(p + (i * 64 + lane) * 4); v[i * 4] = t[0]; v[i * 4 + 1] = t[1]; v[i * 4 + 2] = t[2]; v[i * 4 + 3] = t[3]; }
}
__device__ __forceinline__ void mod_store_bf16(const float (&v)[32], float mu, float rstd, const float* sh, const float* sc, bf16_t* dst, int lane) {
#pragma unroll
    for (int i = 0; i < 8; ++i) { const int c = (i * 64 + lane) * 4; const f32x4 a = *(const f32x4*)(sc + c), b = *(const f32x4*)(sh + c);
        const float o0 = (v[i * 4] - mu) * rstd * (1.f + a[0]) + b[0], o1 = (v[i * 4 + 1] - mu) * rstd * (1.f + a[1]) + b[1], o2 = (v[i * 4 + 2] - mu) * rstd * (1.f + a[2]) + b[2], o3 = (v[i * 4 + 3] - mu) * rstd * (1.f + a[3]) + b[3];
        u32x2 w; w.x = cvt_pk_bf16(o0, o1); w.y = cvt_pk_bf16(o2, o3); *(u32x2*)(dst + c) = w; }
}
#define ROWMAP_NTRIP(nrows) (F.G == 256 ? ((nrows) > NLAT ? 9 : 8) : ((nrows) + F.G * 8 - 1) / (F.G * 8))
#define ROWMAP_ROW(k, nrows) (F.G == 256 ? ((k) < 8 ? F.bid * 64 + (k) * 8 + F.wave : (F.wave < 4 ? NLAT + F.bid * 4 + F.wave : -1)) : ((F.bid * 8 + F.wave + (k) * F.G * 8) < (nrows) ? (F.bid * 8 + F.wave + (k) * F.G * 8) : -1))
#define ROWMAP_BATCH(k) (F.G == 256 ? ((k) < 8 ? (F.bid >> 6) : 4) : ((F.bid * 8 + (k) * F.G * 8) < NLAT ? ((F.bid * 8 + (k) * F.G * 8) >> 12) : 4))
__device__ __forceinline__ void phase_ln1_first(const Frame& F) {
    const float* mod = WSP(float, WS_MOD);
    LAS float* Vsh = (LAS float*)F.lds; LAS float* Vsc = Vsh + 2048; int bcur = -1;
    const int ntrip = ROWMAP_NTRIP(MT);
    for (int k = 0; k < ntrip; ++k) { const int row = ROWMAP_ROW(k, MT), b = ROWMAP_BATCH(k); const bool rv = row >= 0; const int rowc = rv ? row : 0;
        const float* xr = rowc < NLAT ? F.in[0] + (size_t)rowc * DM : F.in[2] + (size_t)(rowc - NLAT) * DM;
        float v[32]; load_row32(xr, F.lane, v);
        if (b != bcur) { bcur = b; __syncthreads(); { const int c0 = F.tid * 4; *(LAS f32x4*)(Vsh + c0) = *(const f32x4*)(mod + (size_t)b * 12288 + c0); *(LAS f32x4*)(Vsc + c0) = *(const f32x4*)(mod + (size_t)b * 12288 + 2048 + c0); } __syncthreads(); }
        float mu, rstd; row_stats(v, mu, rstd);
        bf16_t* dst = WSP(bf16_t, WS_H) + (size_t)rowc * DM;
        if (rv)
#pragma unroll
        for (int i = 0; i < 8; ++i) { const int c = (i * 64 + F.lane) * 4; const f32x4 a = *(const LAS f32x4*)(Vsc + c), bq = *(const LAS f32x4*)(Vsh + c);
            const float o0 = (v[i * 4] - mu) * rstd * (1.f + a[0]) + bq[0], o1 = (v[i * 4 + 1] - mu) * rstd * (1.f + a[1]) + bq[1], o2 = (v[i * 4 + 2] - mu) * rstd * (1.f + a[2]) + bq[2], o3 = (v[i * 4 + 3] - mu) * rstd * (1.f + a[3]) + bq[3];
            u32x2 w; w.x = cvt_pk_bf16(o0, o1); w.y = cvt_pk_bf16(o2, o3); *(u32x2*)(dst + c) = w; }
    }
    __syncthreads();
}

template <int OFF0> __device__ __forceinline__ void tr_read16_attn(unsigned base, bf16x8 (&vf)[8]) {
    s16x4 r0, r1, r2, r3, r4, r5, r6, r7, r8, r9, r10, r11, r12, r13, r14, r15;
    asm volatile("ds_read_b64_tr_b16 %0, %16 offset:%c17+0\n\t"
        "ds_read_b64_tr_b16 %1, %16 offset:%c17+4352\n\t"
        "ds_read_b64_tr_b16 %2, %16 offset:%c17+32\n\t"
        "ds_read_b64_tr_b16 %3, %16 offset:%c17+4384\n\t"
        "ds_read_b64_tr_b16 %4, %16 offset:%c17+64\n\t"
        "ds_read_b64_tr_b16 %5, %16 offset:%c17+4416\n\t"
        "ds_read_b64_tr_b16 %6, %16 offset:%c17+96\n\t"
        "ds_read_b64_tr_b16 %7, %16 offset:%c17+4448\n\t"
        "ds_read_b64_tr_b16 %8, %16 offset:%c17+128\n\t"
        "ds_read_b64_tr_b16 %9, %16 offset:%c17+4480\n\t"
        "ds_read_b64_tr_b16 %10, %16 offset:%c17+160\n\t"
        "ds_read_b64_tr_b16 %11, %16 offset:%c17+4512\n\t"
        "ds_read_b64_tr_b16 %12, %16 offset:%c17+192\n\t"
        "ds_read_b64_tr_b16 %13, %16 offset:%c17+4544\n\t"
        "ds_read_b64_tr_b16 %14, %16 offset:%c17+224\n\t"
        "ds_read_b64_tr_b16 %15, %16 offset:%c17+4576\n\t"
        "s_waitcnt lgkmcnt(0)"
        : "=&v"(r0), "=&v"(r1), "=&v"(r2), "=&v"(r3), "=&v"(r4), "=&v"(r5), "=&v"(r6), "=&v"(r7), "=&v"(r8), "=&v"(r9), "=&v"(r10), "=&v"(r11), "=&v"(r12), "=&v"(r13), "=&v"(r14), "=&v"(r15) : "v"(base), "i"(OFF0) : "memory");
    vf[0] = (bf16x8){r0[0], r0[1], r0[2], r0[3], r1[0], r1[1], r1[2], r1[3]};
    vf[1] = (bf16x8){r2[0], r2[1], r2[2], r2[3], r3[0], r3[1], r3[2], r3[3]};
    vf[2] = (bf16x8){r4[0], r4[1], r4[2], r4[3], r5[0], r5[1], r5[2], r5[3]};
    vf[3] = (bf16x8){r6[0], r6[1], r6[2], r6[3], r7[0], r7[1], r7[2], r7[3]};
    vf[4] = (bf16x8){r8[0], r8[1], r8[2], r8[3], r9[0], r9[1], r9[2], r9[3]};
    vf[5] = (bf16x8){r10[0], r10[1], r10[2], r10[3], r11[0], r11[1], r11[2], r11[3]};
    vf[6] = (bf16x8){r12[0], r12[1], r12[2], r12[3], r13[0], r13[1], r13[2], r13[3]};
    vf[7] = (bf16x8){r14[0], r14[1], r14[2], r14[3], r15[0], r15[1], r15[2], r15[3]};
}
template <int OFF0> __device__ __forceinline__ void tr_read16_kdec(unsigned base, bf16x8 (&vf)[8]) {
    s16x4 r0, r1, r2, r3, r4, r5, r6, r7, r8, r9, r10, r11, r12, r13, r14, r15;
    asm volatile("ds_read_b64_tr_b16 %0, %16 offset:%c17+0\n\t"
        "ds_read_b64_tr_b16 %1, %16 offset:%c17+576\n\t"
        "ds_read_b64_tr_b16 %2, %16 offset:%c17+32\n\t"
        "ds_read_b64_tr_b16 %3, %16 offset:%c17+608\n\t"
        "ds_read_b64_tr_b16 %4, %16 offset:%c17+64\n\t"
        "ds_read_b64_tr_b16 %5, %16 offset:%c17+640\n\t"
        "ds_read_b64_tr_b16 %6, %16 offset:%c17+96\n\t"
        "ds_read_b64_tr_b16 %7, %16 offset:%c17+672\n\t"
        "ds_read_b64_tr_b16 %8, %16 offset:%c17+4608\n\t"
        "ds_read_b64_tr_b16 %9, %16 offset:%c17+5184\n\t"
        "ds_read_b64_tr_b16 %10, %16 offset:%c17+4640\n\t"
        "ds_read_b64_tr_b16 %11, %16 offset:%c17+5216\n\t"
        "ds_read_b64_tr_b16 %12, %16 offset:%c17+4672\n\t"
        "ds_read_b64_tr_b16 %13, %16 offset:%c17+5248\n\t"
        "ds_read_b64_tr_b16 %14, %16 offset:%c17+4704\n\t"
        "ds_read_b64_tr_b16 %15, %16 offset:%c17+5280\n\t"
        "s_waitcnt lgkmcnt(0)"
        : "=&v"(r0), "=&v"(r1), "=&v"(r2), "=&v"(r3), "=&v"(r4), "=&v"(r5), "=&v"(r6), "=&v"(r7), "=&v"(r8), "=&v"(r9), "=&v"(r10), "=&v"(r11), "=&v"(r12), "=&v"(r13), "=&v"(r14), "=&v"(r15) : "v"(base), "i"(OFF0) : "memory");
    vf[0] = (bf16x8){r0[0], r0[1], r0[2], r0[3], r1[0], r1[1], r1[2], r1[3]};
    vf[1] = (bf16x8){r2[0], r2[1], r2[2], r2[3], r3[0], r3[1], r3[2], r3[3]};
    vf[2] = (bf16x8){r4[0], r4[1], r4[2], r4[3], r5[0], r5[1], r5[2], r5[3]};
    vf[3] = (bf16x8){r6[0], r6[1], r6[2], r6[3], r7[0], r7[1], r7[2], r7[3]};
    vf[4] = (bf16x8){r8[0], r8[1], r8[2], r8[3], r9[0], r9[1], r9[2], r9[3]};
    vf[5] = (bf16x8){r10[0], r10[1], r10[2], r10[3], r11[0], r11[1], r11[2], r11[3]};
    vf[6] = (bf16x8){r12[0], r12[1], r12[2], r12[3], r13[0], r13[1], r13[2], r13[3]};
    vf[7] = (bf16x8){r14[0], r14[1], r14[2], r14[3], r15[0], r15[1], r15[2], r15[3]};
}
template <int OFF0> __device__ __forceinline__ void tr_read16_glav(unsigned base, bf16x8 (&vf)[8]) {
    s16x4 r0, r1, r2, r3, r4, r5, r6, r7, r8, r9, r10, r11, r12, r13, r14, r15;
    asm volatile("ds_read_b64_tr_b16 %0, %16 offset:%c17+0\n\t"
        "ds_read_b64_tr_b16 %1, %16 offset:%c17+4352\n\t"
        "ds_read_b64_tr_b16 %2, %16 offset:%c17+32\n\t"
        "ds_read_b64_tr_b16 %3, %16 offset:%c17+4384\n\t"
        "ds_read_b64_tr_b16 %4, %16 offset:%c17+64\n\t"
        "ds_read_b64_tr_b16 %5, %16 offset:%c17+4416\n\t"
        "ds_read_b64_tr_b16 %6, %16 offset:%c17+96\n\t"
        "ds_read_b64_tr_b16 %7, %16 offset:%c17+4448\n\t"
        "ds_read_b64_tr_b16 %8, %16 offset:%c17+8704\n\t"
        "ds_read_b64_tr_b16 %9, %16 offset:%c17+13056\n\t"
        "ds_read_b64_tr_b16 %10, %16 offset:%c17+8736\n\t"
        "ds_read_b64_tr_b16 %11, %16 offset:%c17+13088\n\t"
        "ds_read_b64_tr_b16 %12, %16 offset:%c17+8768\n\t"
        "ds_read_b64_tr_b16 %13, %16 offset:%c17+13120\n\t"
        "ds_read_b64_tr_b16 %14, %16 offset:%c17+8800\n\t"
        "ds_read_b64_tr_b16 %15, %16 offset:%c17+13152\n\t"
        "s_waitcnt lgkmcnt(0)"
        : "=&v"(r0), "=&v"(r1), "=&v"(r2), "=&v"(r3), "=&v"(r4), "=&v"(r5), "=&v"(r6), "=&v"(r7), "=&v"(r8), "=&v"(r9), "=&v"(r10), "=&v"(r11), "=&v"(r12), "=&v"(r13), "=&v"(r14), "=&v"(r15) : "v"(base), "i"(OFF0) : "memory");
    vf[0] = (bf16x8){r0[0], r0[1], r0[2], r0[3], r1[0], r1[1], r1[2], r1[3]};
    vf[1] = (bf16x8){r2[0], r2[1], r2[2], r2[3], r3[0], r3[1], r3[2], r3[3]};
    vf[2] = (bf16x8){r4[0], r4[1], r4[2], r4[3], r5[0], r5[1], r5[2], r5[3]};
    vf[3] = (bf16x8){r6[0], r6[1], r6[2], r6[3], r7[0], r7[1], r7[2], r7[3]};
    vf[4] = (bf16x8){r8[0], r8[1], r8[2], r8[3], r9[0], r9[1], r9[2], r9[3]};
    vf[5] = (bf16x8){r10[0], r10[1], r10[2], r10[3], r11[0], r11[1], r11[2], r11[3]};
    vf[6] = (bf16x8){r12[0], r12[1], r12[2], r12[3], r13[0], r13[1], r13[2], r13[3]};
    vf[7] = (bf16x8){r14[0], r14[1], r14[2], r14[3], r15[0], r15[1], r15[2], r15[3]};
}
template <int OFF0> __device__ __forceinline__ void tr_read8_attn(unsigned base, bf16x8 (&vf)[4]) {
    s16x4 r0, r1, r2, r3, r4, r5, r6, r7;
    asm volatile("ds_read_b64_tr_b16 %0, %8 offset:%c9+0\n\t"
        "ds_read_b64_tr_b16 %1, %8 offset:%c9+4352\n\t"
        "ds_read_b64_tr_b16 %2, %8 offset:%c9+32\n\t"
        "ds_read_b64_tr_b16 %3, %8 offset:%c9+4384\n\t"
        "ds_read_b64_tr_b16 %4, %8 offset:%c9+64\n\t"
        "ds_read_b64_tr_b16 %5, %8 offset:%c9+4416\n\t"
        "ds_read_b64_tr_b16 %6, %8 offset:%c9+96\n\t"
        "ds_read_b64_tr_b16 %7, %8 offset:%c9+4448\n\t"
        "s_waitcnt lgkmcnt(0)"
        : "=&v"(r0), "=&v"(r1), "=&v"(r2), "=&v"(r3), "=&v"(r4), "=&v"(r5), "=&v"(r6), "=&v"(r7) : "v"(base), "i"(OFF0) : "memory");
    vf[0] = (bf16x8){r0[0], r0[1], r0[2], r0[3], r1[0], r1[1], r1[2], r1[3]};
    vf[1] = (bf16x8){r2[0], r2[1], r2[2], r2[3], r3[0], r3[1], r3[2], r3[3]};
    vf[2] = (bf16x8){r4[0], r4[1], r4[2], r4[3], r5[0], r5[1], r5[2], r5[3]};
    vf[3] = (bf16x8){r6[0], r6[1], r6[2], r6[3], r7[0], r7[1], r7[2], r7[3]};
}
constexpr int AT_PITCH = 272;
constexpr int AT_TILE = 64 * AT_PITCH;
__device__ __forceinline__ void attn_item(const Frame& F, int l, int qrow0  , int qpos0  , int hp  , int b, int kc_lo, int nlat) {
    const bf16_t* __restrict__ proj = WSP(bf16_t, WS_R1); bf16_t* __restrict__ mix = WSP(bf16_t, WS_R3);
    const int lane = F.lane, i16 = lane & 15, g4 = lane >> 4, w = F.wave >> 1  , h = hp * 2 + (F.wave & 1), kvh = hp >> 1;
    LAS unsigned char* lds = F.lds;
    const int nchunk = nlat + 4;
    bf16x8 qf[2][4];
#pragma unroll
    for (int u = 0; u < 2; ++u) { const bf16_t* qp = proj + (size_t)(qrow0 + w * 32 + u * 16 + i16) * NINP + C_Q + h * 128 + 8 * g4;
#pragma unroll
        for (int ks = 0; ks < 4; ++ks) qf[u][ks] = *(const bf16x8*)(qp + ks * 32); }
    const float sink = F.in[7][l * 8 + h];
    const float SC = 0.08838834764831845f, C2 = SC * 1.4426950408889634f;
    float m_run[2] = {sink / SC, sink / SC}, l_run[2] = {(g4 == 0) ? 1.0f : 0.0f, (g4 == 0) ? 1.0f : 0.0f};
    f32x4 o[2][8];
#pragma unroll
    for (int u = 0; u < 2; ++u)
#pragma unroll
        for (int d = 0; d < 8; ++d) o[u][d] = (f32x4){0.f, 0.f, 0.f, 0.f};
    const int skey = F.tid >> 3, sseg = F.tid & 7;
    u32x4 rk0, rk1, rv0, rv1;
#define AT_CROW(c) (((c) < nlat) ? (b * SEQ + (kc_lo + (c)) * 64) : (NLAT + b * CTXL + ((c) - nlat) * 64))
#define AT_GLOAD(c) do { const bf16_t* kp_ = proj + (size_t)(AT_CROW(c) + skey) * NINP + C_K + kvh * 128 + sseg * 8; rk0 = *(const u32x4*)kp_; rk1 = *(const u32x4*)(kp_ + 64); rv0 = *(const u32x4*)(kp_ + 256); rv1 = *(const u32x4*)(kp_ + 256 + 64); } while (0)
#define AT_LSTORE(buf) do { LAS unsigned char* kb_ = lds + (buf) * 2 * AT_TILE + skey * AT_PITCH + sseg * 16; *(LAS u32x4*)kb_ = rk0; *(LAS u32x4*)(kb_ + 128) = rk1; *(LAS u32x4*)(kb_ + AT_TILE) = rv0; *(LAS u32x4*)(kb_ + AT_TILE + 128) = rv1; } while (0)
    AT_GLOAD(0); AT_LSTORE(0); __syncthreads();
    const int wq0 = qpos0 + w * 32;
    for (int c = 0; c < nchunk; ++c) {
        const int buf = c & 1;
        if (c + 1 < nchunk) AT_GLOAD(c + 1);
        const int k0 = (kc_lo + c) * 64; const bool lat = c < nlat;
        const bool skip = lat && (k0 > wq0 + 31 + 128 || k0 + 63 < wq0 - 128);
        const bool need_mask = lat && !(k0 >= wq0 + 31 - 128 && k0 + 63 <= wq0 + 128);
        if (!skip) {
        const LAS unsigned char* kb = lds + buf * 2 * AT_TILE; const LAS unsigned char* vb = kb + AT_TILE;
        f32x4 st[2][4];
#pragma unroll
        for (int kt = 0; kt < 4; ++kt) { st[0][kt] = (f32x4){0.f, 0.f, 0.f, 0.f}; st[1][kt] = (f32x4){0.f, 0.f, 0.f, 0.f};
#pragma unroll
            for (int ks = 0; ks < 4; ++ks) { const bf16x8 kf = *(const LAS bf16x8*)(kb + (kt * 16 + i16) * AT_PITCH + (ks * 32 + 8 * g4) * 2); st[0][kt] = MFMA16(kf, qf[0][ks], st[0][kt]); st[1][kt] = MFMA16(kf, qf[1][ks], st[1][kt]); } }
        if (need_mask) {
#pragma unroll
            for (int u = 0; u < 2; ++u) { const int qp = wq0 + u * 16 + i16; const int kp0 = k0 + 4 * g4;
#pragma unroll
                for (int kt = 0; kt < 4; ++kt)
#pragma unroll
                    for (int r = 0; r < 4; ++r) { const int dlt = qp - (kp0 + kt * 16 + r); if (dlt > 128 || dlt < -128) st[u][kt][r] = -1e30f; } } }
        bf16x8 pf[2][2];
#pragma unroll
        for (int u = 0; u < 2; ++u) {
            float mx = st[u][0][0];
#pragma unroll
            for (int kt = 0; kt < 4; ++kt)
#pragma unroll
                for (int r = 0; r < 4; ++r) mx = fmaxf(mx, st[u][kt][r]);
            mx = fmaxf(mx, shx<16>(mx)); mx = fmaxf(mx, shx<32>(mx));
            const float m_new = fmaxf(m_run[u], mx); const float alpha = __builtin_amdgcn_exp2f((m_run[u] - m_new) * C2); m_run[u] = m_new;
            const float mc = m_new * C2; float ps = 0.f;
#pragma unroll
            for (int kt = 0; kt < 4; ++kt)
#pragma unroll
                for (int r = 0; r < 4; ++r) { const float p = __builtin_amdgcn_exp2f(st[u][kt][r] * C2 - mc); st[u][kt][r] = p; ps += p; }
            l_run[u] = l_run[u] * alpha + ps;
            if (__any(alpha != 1.0f)) {
#pragma unroll
                for (int d = 0; d < 8; ++d) o[u][d] *= alpha; }
#pragma unroll
            for (int ks2 = 0; ks2 < 2; ++ks2) { u32x4 t4; t4.x = cvt_pk_bf16(st[u][2 * ks2][0], st[u][2 * ks2][1]); t4.y = cvt_pk_bf16(st[u][2 * ks2][2], st[u][2 * ks2][3]); t4.z = cvt_pk_bf16(st[u][2 * ks2 + 1][0], st[u][2 * ks2 + 1][1]); t4.w = cvt_pk_bf16(st[u][2 * ks2 + 1][2], st[u][2 * ks2 + 1][3]); pf[u][ks2] = __builtin_bit_cast(bf16x8, t4); }
        }
        const unsigned vaddr = lds_addr_of(vb) + (unsigned)((4 * g4 + (i16 >> 2)) * AT_PITCH + (4 * (i16 & 3)) * 2);
#pragma unroll
        for (int ks2 = 0; ks2 < 2; ++ks2) {
#pragma unroll
            for (int dh = 0; dh < 2; ++dh) { bf16x8 vf[4];
                if (ks2 == 0) { if (dh == 0) tr_read8_attn<0>(vaddr, vf); else tr_read8_attn<128>(vaddr, vf); } else { if (dh == 0) tr_read8_attn<32 * AT_PITCH>(vaddr, vf); else tr_read8_attn<32 * AT_PITCH + 128>(vaddr, vf); }
#pragma unroll
                for (int d = 0; d < 4; ++d) { o[0][dh * 4 + d] = MFMA16(vf[d], pf[0][ks2], o[0][dh * 4 + d]); o[1][dh * 4 + d] = MFMA16(vf[d], pf[1][ks2], o[1][dh * 4 + d]); } }
        }
        }
        if (c + 1 < nchunk) AT_LSTORE(buf ^ 1);
        __syncthreads();
    }
#undef AT_CROW
#undef AT_GLOAD
#undef AT_LSTORE
#pragma unroll
    for (int u = 0; u < 2; ++u) {
        float lr = l_run[u]; lr += shx<16>(lr); lr += shx<32>(lr);
        const float inv = 1.0f / lr;
        bf16_t* op = mix + (size_t)(qrow0 + w * 32 + u * 16 + i16) * DM + h * 128 + 4 * g4;
#pragma unroll
        for (int d = 0; d < 8; ++d) { u32x2 wv; wv.x = cvt_pk_bf16(o[u][d][0] * inv, o[u][d][1] * inv); wv.y = cvt_pk_bf16(o[u][d][2] * inv, o[u][d][3] * inv); *(u32x2*)(op + d * 16) = wv; } }
}
__device__ __forceinline__ void attn_items(const Frame& F, int l, int first, int stride) {
    const int nitem = 512 + (l == 0 ? 32 : 0);
    for (int it = first; it < nitem; it += stride) {
        if (it < 512) { const int hp = it & 3, qb = (it >> 2) & 31, b = it >> 7; const int kc_lo = qb > 0 ? qb * 2 - 2 : 0, kc_hi = qb < 31 ? qb * 2 + 3 : 63;
            attn_item(F, l, b * SEQ + qb * 128, qb * 128, hp, b, kc_lo, kc_hi - kc_lo + 1);
        } else { const int j = it - 512; const int hp = j & 3, half = (j >> 2) & 1, b = j >> 3;
            attn_item(F, l, NLAT + b * CTXL + half * 128, 0, hp, b, 0, 0); }
    }
}
constexpr int S5_APITCH = (768 + 8) * 2;
template <int NT, int KT, int MTL>
__device__ __forceinline__ void s5_mm(const LAS unsigned char* A, const bf16_t* __restrict__ Bt, int lane, int wave, f32x4 (&acc)[MTL][NT]) {
    const int i16 = lane & 15, g4 = lane >> 4;
#pragma unroll
    for (int m = 0; m < MTL; ++m)
#pragma unroll
        for (int n = 0; n < NT; ++n) acc[m][n] = (f32x4){0.f, 0.f, 0.f, 0.f};
    const bf16_t* bp = Bt + ((size_t)(wave * NT) * (KT / 32) * 64 + lane) * 8;
    const LAS unsigned char* ap = A + i16 * S5_APITCH + 16 * g4;
    constexpr int KB = (MTL >= 4 && NT >= 4) ? 1 : 4;
    for (int ks0 = 0; ks0 < KT / 32; ks0 += KB) {
        bf16x8 bf[KB][NT];
#pragma unroll
        for (int q = 0; q < KB; ++q)
#pragma unroll
            for (int n = 0; n < NT; ++n) bf[q][n] = *(const bf16x8*)(bp + (size_t)(n * (KT / 32) + ks0 + q) * 512);
#pragma unroll
        for (int q = 0; q < KB; ++q) {
#pragma unroll
            for (int m = 0; m < MTL; ++m) { const bf16x8 am = *(const LAS bf16x8*)(ap + m * 16 * S5_APITCH + (ks0 + q) * 64);
#pragma unroll
                for (int n = 0; n < NT; ++n) acc[m][n] = MFMA16(am, bf[q][n], acc[m][n]); } }
    }
}
__device__ __forceinline__ void s5a_items(const Frame& F, int l, int xcd, int first, int stride) {
    const bf16_t* __restrict__ su = WSP(bf16_t, WS_SU); float* __restrict__ S = WSP(float, WS_S5S);
    for (int li = first; li < (xcd < 0 ? 256 : 32); li += stride) { const int g = (xcd < 0) ? (li >> 3) : (xcd + 8 * (li >> 3)), rb = li & 7;
        __syncthreads();
        { u32x4 ta[10];
#pragma unroll
          for (int q = 0; q < 10; ++q) { const int e = F.tid + q * NTHR, r = e >> 6, sg = e & 63; ta[q] = *(const u32x4*)(su + ((size_t)g * MT + (size_t)(rb * 68 + r) * 32) * 16 + sg * 8); }
#pragma unroll
          for (int q = 0; q < 10; ++q) { const int e = F.tid + q * NTHR, r = e >> 6, sg = e & 63; *(LAS u32x4*)(F.lds + r * S5_APITCH + sg * 16) = ta[q]; } }
        __syncthreads();
        f32x4 acc[5][2]; s5_mm<2, 512, 5>(F.lds, WSP(bf16_t, WS_S5A) + (size_t)(l * 32 + g) * 256 * 512, F.lane, F.wave, acc);
        const int i16 = F.lane & 15, g4 = F.lane >> 4;
#pragma unroll
        for (int m = 0; m < 5; ++m)
#pragma unroll
            for (int r = 0; r < 4; ++r) { const int lr = m * 16 + 4 * g4 + r, cr = rb * 68 + lr; if (lr < 68) {
#pragma unroll
                for (int n = 0; n < 2; ++n) S[((size_t)cr * 32 + g) * 256 + F.wave * 32 + n * 16 + i16] = acc[m][n][r]; } }
    }
}
__device__ __forceinline__ void s5_scan(const Frame& F, int l, int first_thread, int nthreads) {
    const float* S = WSP(float, WS_S5S); bf16_t* SI = WSP(bf16_t, WS_S5IN);
    for (int e = first_thread; e < 4 * 32 * 128; e += nthreads) { const int p = e & 63, d = (e >> 6) & 1, g = (e >> 7) & 31, b = e >> 12;
        const f32x2 lt = WSP(f32x2, WS_LAMT)[((size_t)(l * 32 + g) * 2 + d) * 64 + p];
        float sx = 0.f, sy = 0.f; const size_t co = (size_t)g * 256 + d * 128 + p * 2;
#pragma unroll 8
        for (int i = 0; i < 136; ++i) { int r; if (i < 8) r = 512 + b * 8 + (d == 0 ? i : 7 - i); else r = b * 128 + (d == 0 ? (i - 8) : 127 - (i - 8));
            const f32x2 sv = *(const f32x2*)(S + (size_t)r * 8192 + co);
            *(unsigned*)(SI + (size_t)r * 8192 + co) = cvt_pk_bf16(sx, sy);
            const float nx = lt.x * sx - lt.y * sy + sv.x, ny = lt.x * sy + lt.y * sx + sv.y; sx = nx; sy = ny; }
    }
}
__device__ __forceinline__ void s5c_items(const Frame& F, int l, int xcd, int first, int stride) {
    const bf16_t* __restrict__ su = WSP(bf16_t, WS_SU); const bf16_t* __restrict__ SI = WSP(bf16_t, WS_S5IN); bf16_t* __restrict__ zb = WSP(bf16_t, WS_R3 + (size_t)MT * DM * 2);
    for (int li = first; li < (xcd < 0 ? 256 : 32); li += stride) { const int g = (xcd < 0) ? (li >> 3) : (xcd + 8 * (li >> 3)), rb = li & 7;
        __syncthreads();
#pragma unroll
        for (int hq = 0; hq < 2; ++hq) { u32x4 ta[5];
#pragma unroll
          for (int q = 0; q < 5; ++q) { const int e = F.tid + (hq * 5 + q) * NTHR, r = e >> 6, sg = e & 63; ta[q] = *(const u32x4*)(su + ((size_t)g * MT + (size_t)(rb * 68 + r) * 32) * 16 + sg * 8); }
#pragma unroll
          for (int q = 0; q < 5; ++q) { const int e = F.tid + (hq * 5 + q) * NTHR, r = e >> 6, sg = e & 63; *(LAS u32x4*)(F.lds + r * S5_APITCH + sg * 16) = ta[q]; } }
        { u32x4 tb[5];
#pragma unroll
          for (int q = 0; q < 5; ++q) { const int e = F.tid + q * NTHR, r = e >> 5, sg = e & 31; tb[q] = *(const u32x4*)(SI + ((size_t)(rb * 68 + r) * 32 + g) * 256 + sg * 8); }
#pragma unroll
          for (int q = 0; q < 5; ++q) { const int e = F.tid + q * NTHR, r = e >> 5, sg = e & 31; *(LAS u32x4*)(F.lds + r * S5_APITCH + 1024 + sg * 16) = tb[q]; } }
        __syncthreads();
        f32x4 acc[5][4]; s5_mm<4, 768, 5>(F.lds, WSP(bf16_t, WS_S5C) + (size_t)(l * 32 + g) * 512 * 768, F.lane, F.wave, acc);
        const int i16 = F.lane & 15, g4 = F.lane >> 4; const float dd = F.in[15][l * 512 + g * 16 + i16];
        __syncthreads();
#pragma unroll
        for (int m = 0; m < 5; ++m)
#pragma unroll
            for (int n = 0; n < 4; ++n)
#pragma unroll
                for (int r = 0; r < 4; ++r) { LAS bf16_t* up = (LAS bf16_t*)(F.lds + (m * 16 + 4 * g4 + r) * S5_APITCH) + (F.wave * 4 + n) * 16 + i16; *up = f2bf(gelu_tanh(acc[m][n][r] + dd * bf2f(*up))); }
        __syncthreads();
#pragma unroll
        for (int hq = 0; hq < 3; ++hq) { u32x4 tz[3];
#pragma unroll
          for (int q = 0; q < 3; ++q) { const int e = F.tid + (hq * 3 + q) * NTHR, r = e >> 6, sg = e & 63; tz[q] = *(const LAS u32x4*)(F.lds + r * S5_APITCH + sg * 16); }
#pragma unroll
          for (int q = 0; q < 3; ++q) { const int e = F.tid + (hq * 3 + q) * NTHR, r = e >> 6, sg = e & 63; if (r < 68) *(u32x4*)(zb + ((size_t)g * MT + (size_t)(rb * 68 + r) * 32) * 16 + sg * 8) = tz[q]; } }
    }
}
constexpr int GL_GB = 0  , GL_KD = 32768  , GL_VT = 51200  , GL_GZ = 68608  , GL_WG = 76800  ,
              GL_BL = 84992  , GL_TOT = 85504  ;
constexpr int G3_Q = 0  , G3_K = 18432, G3_V = 36864  , G3_S = 54272  , G3_SSQ = 91136  ;
constexpr int GL_P64 = 144, GL_P128 = 272;
__device__ __forceinline__ int gla_row0(int b, int j) { return j < 4 ? NLAT + b * CTXL + j * 64 : b * SEQ + (j - 4) * 64; }
__device__ __forceinline__ void gla1_items(const Frame& F, int l, int first, int stride) {
    const bf16_t* __restrict__ proj = WSP(bf16_t, WS_R1); float* __restrict__ upd = WSP(float, WS_R3 + (size_t)MT * DM * 2 + (size_t)MT * 512 * 2); float* __restrict__ dec = WSP(float, WS_GDEC);
    bf16_t* __restrict__ gqin = WSP(bf16_t, WS_GQIN); bf16_t* __restrict__ gkp = WSP(bf16_t, WS_GKP);
    LAS float* gb = (LAS float*)(F.lds + GL_GB); LAS float* gz = (LAS float*)(F.lds + GL_GZ); LAS float* wg = (LAS float*)(F.lds + GL_WG); LAS float* bl = (LAS float*)(F.lds + GL_BL); LAS float* tot = (LAS float*)(F.lds + GL_TOT);
    const int t = F.tid, tk = t >> 3, k0 = (t & 7) * 8;
    u32x2 gzr; u32x4 qv, kv, vv0, vv1; f32x4 wgr; f32x4 bg[2][2];
#define GL1_LOAD_A(IT) do { const int j_ = (IT) % 68, bh_ = (IT) / 68, h_ = bh_ & 3, b_ = bh_ >> 2; const bf16_t* rp_ = proj + (size_t)(gla_row0(b_, j_) + tk) * NINP; \
        gzr = *(const u32x2*)(rp_ + C_GZ + (t & 7) * 4); vv0 = *(const u32x4*)(rp_ + C_GV + h_ * 128 + (t & 7) * 8); vv1 = *(const u32x4*)(rp_ + C_GV + h_ * 128 + 64 + (t & 7) * 8); \
        { const int e4 = t * 4, d = e4 >> 10, r = (e4 >> 6) & 15, k = e4 & 63; wgr = *(const f32x4*)(F.in[18] + ((size_t)(l * 2 + d) * 16 + r) * 256 + h_ * 64 + k); } } while (0)
#define GL1_LOAD_B(IT) do { const int h_ = ((IT) / 68) & 3; _Pragma("unroll") for (int d = 0; d < 2; ++d) { bg[d][0] = *(const f32x4*)(F.in[19] + (l * 2 + d) * 256 + h_ * 64 + k0); bg[d][1] = *(const f32x4*)(F.in[19] + (l * 2 + d) * 256 + h_ * 64 + k0 + 4); } } while (0)
#define GL1_LOAD_C(IT) do { const int j_ = (IT) % 68, bh_ = (IT) / 68, h_ = bh_ & 3, b_ = bh_ >> 2; const bf16_t* rp_ = proj + (size_t)(gla_row0(b_, j_) + tk) * NINP; \
        qv = *(const u32x4*)(rp_ + C_GQ + h_ * 64 + k0); kv = *(const u32x4*)(rp_ + C_GK + h_ * 64 + k0); } while (0)
    if (first < 16 * 68) { GL1_LOAD_A(first); GL1_LOAD_B(first); GL1_LOAD_C(first); }
    for (int it = first; it < 16 * 68; it += stride) { const int j = it % 68, bh = it / 68, h = bh & 3, b = bh >> 2; const bool more = it + stride < 16 * 68;
        __syncthreads();
        { const int c0 = (t & 7) * 4; gz[tk * 32 + c0] = bflo(gzr.x); gz[tk * 32 + c0 + 1] = bfhi(gzr.x); gz[tk * 32 + c0 + 2] = bflo(gzr.y); gz[tk * 32 + c0 + 3] = bfhi(gzr.y); *(LAS f32x4*)(wg + t * 4) = wgr;
          *(LAS u32x4*)(F.lds + GL_VT + tk * GL_P128 + (t & 7) * 16) = vv0; *(LAS u32x4*)(F.lds + GL_VT + tk * GL_P128 + 128 + (t & 7) * 16) = vv1; }
        __syncthreads();
        if (more) GL1_LOAD_A(it + stride);
#pragma unroll
        for (int d = 0; d < 2; ++d) { float a[8] = {bg[d][0][0], bg[d][0][1], bg[d][0][2], bg[d][0][3], bg[d][1][0], bg[d][1][1], bg[d][1][2], bg[d][1][3]};
#pragma unroll
            for (int r = 0; r < 16; ++r) { const float zv = gz[tk * 32 + d * 16 + r]; const f32x4 w0 = *(const LAS f32x4*)(wg + (d * 16 + r) * 64 + k0), w1 = *(const LAS f32x4*)(wg + (d * 16 + r) * 64 + k0 + 4);
                a[0] += zv * w0[0]; a[1] += zv * w0[1]; a[2] += zv * w0[2]; a[3] += zv * w0[3]; a[4] += zv * w1[0]; a[5] += zv * w1[1]; a[6] += zv * w1[2]; a[7] += zv * w1[3]; }
#pragma unroll
            for (int q = 0; q < 8; ++q) gb[(d * 64 + tk) * 64 + k0 + q] = logsigmoidf_(a[q]) * (1.0f / 16.0f); }
        if (more) GL1_LOAD_B(it + stride);
        __syncthreads();
        { const int k = t & 63, seg = t >> 6; float vf[8], vb[8]; float rf = 0.f, rb = 0.f;
#pragma unroll
          for (int q = 0; q < 8; ++q) { rf += gb[(seg * 8 + q) * 64 + k]; vf[q] = rf; }
#pragma unroll
          for (int q = 7; q >= 0; --q) { rb += gb[(64 + seg * 8 + q) * 64 + k]; vb[q] = rb; }
          tot[seg * 64 + k] = rf; tot[512 + seg * 64 + k] = rb;
          __syncthreads();
          float pf = 0.f, pb = 0.f, af = 0.f, ab = 0.f;
#pragma unroll
          for (int s2 = 0; s2 < 8; ++s2) { const float x = tot[s2 * 64 + k], y = tot[512 + s2 * 64 + k]; af += x; ab += y; if (s2 < seg) pf += x; if (s2 > seg) pb += y; }
#pragma unroll
          for (int q = 0; q < 8; ++q) { gb[(seg * 8 + q) * 64 + k] = vf[q] + pf; gb[(64 + seg * 8 + q) * 64 + k] = vb[q] + pb; }
          if (seg == 0) { bl[k] = af; bl[64 + k] = ab; } }
        __syncthreads();
        { const float qq[8] = {bflo(qv.x), bfhi(qv.x), bflo(qv.y), bfhi(qv.y), bflo(qv.z), bfhi(qv.z), bflo(qv.w), bfhi(qv.w)}, kk[8] = {bflo(kv.x), bfhi(kv.x), bflo(kv.y), bfhi(kv.y), bflo(kv.z), bfhi(kv.z), bflo(kv.w), bfhi(kv.w)};
#pragma unroll
          for (int d = 0; d < 2; ++d) { float qo[8], ko[8], kd[8];
#pragma unroll
              for (int q = 0; q < 8; ++q) { const float bv = gb[(d * 64 + tk) * 64 + k0 + q]; qo[q] = qq[q] * 0.125f * __expf(bv); ko[q] = kk[q] * __expf(-bv); kd[q] = kk[q] * __expf(bl[d * 64 + k0 + q] - bv); }
              const size_t go = ((size_t)(((b * 4 + h) * 2 + d) * 68 + j) * 64 + tk) * 64 + k0; u32x4 w;
              w.x = cvt_pk_bf16(qo[0], qo[1]); w.y = cvt_pk_bf16(qo[2], qo[3]); w.z = cvt_pk_bf16(qo[4], qo[5]); w.w = cvt_pk_bf16(qo[6], qo[7]); *(u32x4*)(gqin + go) = w;
              w.x = cvt_pk_bf16(ko[0], ko[1]); w.y = cvt_pk_bf16(ko[2], ko[3]); w.z = cvt_pk_bf16(ko[4], ko[5]); w.w = cvt_pk_bf16(ko[6], ko[7]); *(u32x4*)(gkp + go) = w;
              w.x = cvt_pk_bf16(kd[0], kd[1]); w.y = cvt_pk_bf16(kd[2], kd[3]); w.z = cvt_pk_bf16(kd[4], kd[5]); w.w = cvt_pk_bf16(kd[6], kd[7]); *(LAS u32x4*)(F.lds + GL_KD + (d * 64 + tk) * GL_P64 + k0 * 2) = w; }
          if (t < 128) dec[(size_t)((((b * 4 + h) * 2 + (t >> 6)) * 68) + j) * 64 + (t & 63)] = __expf(bl[t]); }
        if (more) GL1_LOAD_C(it + stride);
        __syncthreads();
        const int i16 = F.lane & 15, g4 = F.lane >> 4, w = F.wave;
        const unsigned va = lds_addr_of(F.lds + GL_VT) + (unsigned)((8 * g4 + (i16 >> 2)) * GL_P128 + (w * 16 + 4 * (i16 & 3)) * 2);
        const unsigned ka = lds_addr_of(F.lds + GL_KD) + (unsigned)((8 * g4 + (i16 >> 2)) * GL_P64 + (4 * (i16 & 3)) * 2);
        const bf16x8 af0 = tr_read2(va, va + 4 * GL_P128), af1 = tr_read2(va + 32 * GL_P128, va + 32 * GL_P128 + 4 * GL_P128);
#pragma unroll
        for (int d = 0; d < 2; ++d) { bf16x8 kf[8]; if (d == 0) tr_read16_kdec<0>(ka, kf); else tr_read16_kdec<64 * GL_P64>(ka, kf);
            float* up = upd + (size_t)((((b * 4 + h) * 2 + d) * 68) + j) * 8192;
#pragma unroll
            for (int kt = 0; kt < 4; ++kt) { f32x4 acc = (f32x4){0.f, 0.f, 0.f, 0.f}; acc = MFMA16(af0, kf[kt], acc); acc = MFMA16(af1, kf[4 + kt], acc);
#pragma unroll
                for (int r = 0; r < 4; ++r) up[(w * 16 + 4 * g4 + r) * 64 + kt * 16 + i16] = acc[r]; } }
    }
#undef GL1_LOAD_A
#undef GL1_LOAD_B
#undef GL1_LOAD_C
}
__device__ __forceinline__ void gla3_items(const Frame& F, int l, int first, int stride) {
    const bf16_t* __restrict__ proj = WSP(bf16_t, WS_R1); const bf16_t* __restrict__ gst = WSP(bf16_t, WS_GST); bf16_t* __restrict__ mix = WSP(bf16_t, WS_R3);
    const bf16_t* __restrict__ gqin = WSP(bf16_t, WS_GQIN); const bf16_t* __restrict__ gkp = WSP(bf16_t, WS_GKP);
    const int jlo = (l == 0) ? 0 : 4;
    const int nj = 68 - jlo; const int t = F.tid, tk = t >> 3, sg8 = t & 7;
    const int i16 = F.lane & 15, g4 = F.lane >> 4, w = F.wave, tt = w & 3, vh = w >> 2;
    u32x4 rq[2], rk[2], rs[2][2], rv[2];
#define GL3_LOAD(IT) do { const int j_ = jlo + (IT) % nj, bh_ = (IT) / nj, h_ = bh_ & 3, b_ = bh_ >> 2; const int row0_ = gla_row0(b_, j_); \
        _Pragma("unroll") for (int d = 0; d < 2; ++d) { const size_t cj = (size_t)(((b_ * 4 + h_) * 2 + d) * 68 + j_); rq[d] = *(const u32x4*)(gqin + (cj * 64 + tk) * 64 + sg8 * 8); rk[d] = *(const u32x4*)(gkp + (cj * 64 + tk) * 64 + sg8 * 8); \
            _Pragma("unroll") for (int q = 0; q < 2; ++q) { const int e = t + q * NTHR; rs[d][q] = *(const u32x4*)(gst + cj * 8192 + (size_t)(e >> 3) * 64 + (e & 7) * 8); } } \
        _Pragma("unroll") for (int q = 0; q < 2; ++q) rv[q] = *(const u32x4*)(proj + (size_t)(row0_ + tk) * NINP + C_GV + h_ * 128 + (sg8 + 8 * q) * 8); } while (0)
    if (first < 16 * nj) GL3_LOAD(first);
    for (int it = first; it < 16 * nj; it += stride) { const int j = jlo + it % nj, bh = it / nj, h = bh & 3, b = bh >> 2; const int row0 = gla_row0(b, j);
        const size_t orow = (size_t)(row0 + tt * 16 + i16);
        u32x2 rr[4]; f32x4 ng[4];
#pragma unroll
        for (int v4 = 0; v4 < 4; ++v4) { const int v = (vh * 4 + v4) * 16 + 4 * g4; rr[v4] = *(const u32x2*)(proj + orow * NINP + C_GR + h * 128 + v); ng[v4] = *(const f32x4*)(F.in[20] + l * 128 + v); }
        __syncthreads();
#pragma unroll
        for (int d = 0; d < 2; ++d) { *(LAS u32x4*)(F.lds + G3_Q + (d * 64 + tk) * GL_P64 + sg8 * 16) = rq[d]; *(LAS u32x4*)(F.lds + G3_K + (d * 64 + tk) * GL_P64 + sg8 * 16) = rk[d];
#pragma unroll
            for (int q = 0; q < 2; ++q) { const int e = t + q * NTHR; *(LAS u32x4*)(F.lds + G3_S + (d * 128 + (e >> 3)) * GL_P64 + (e & 7) * 16) = rs[d][q]; } }
#pragma unroll
        for (int q = 0; q < 2; ++q) *(LAS u32x4*)(F.lds + G3_V + tk * GL_P128 + (sg8 + 8 * q) * 16) = rv[q];
        __syncthreads();
        if (it + stride < 16 * nj) GL3_LOAD(it + stride);
        f32x4 o[4];
#pragma unroll
        for (int v4 = 0; v4 < 4; ++v4) o[v4] = (f32x4){0.f, 0.f, 0.f, 0.f};
        bf16x8 vf[8];
        tr_read16_glav<0>(lds_addr_of(F.lds + G3_V) + (unsigned)((4 * g4 + (i16 >> 2)) * GL_P128 + (vh * 64 + 4 * (i16 & 3)) * 2), vf);
#pragma unroll
        for (int d = 0; d < 2; ++d) {
            const LAS unsigned char* qb_ = F.lds + G3_Q + d * 64 * GL_P64; const LAS unsigned char* kb_ = F.lds + G3_K + d * 64 * GL_P64; const LAS unsigned char* sb_ = F.lds + G3_S + d * 128 * GL_P64;
            bf16x8 qf[2];
#pragma unroll
            for (int ks = 0; ks < 2; ++ks) qf[ks] = *(const LAS bf16x8*)(qb_ + (tt * 16 + i16) * GL_P64 + (ks * 32 + 8 * g4) * 2);
            f32x4 st[4];
#pragma unroll
            for (int s4 = 0; s4 < 4; ++s4) { st[s4] = (f32x4){0.f, 0.f, 0.f, 0.f};
#pragma unroll
                for (int ks = 0; ks < 2; ++ks) { const bf16x8 kf = *(const LAS bf16x8*)(kb_ + (s4 * 16 + i16) * GL_P64 + (ks * 32 + 8 * g4) * 2); st[s4] = MFMA16(kf, qf[ks], st[s4]); }
#pragma unroll
                for (int r = 0; r < 4; ++r) { const int s = s4 * 16 + 4 * g4 + r, tq = tt * 16 + i16; if (d == 0 ? (s > tq) : (s < tq)) st[s4][r] = 0.f; } }
#pragma unroll
            for (int ks2 = 0; ks2 < 2; ++ks2) {
                bf16x8 pf; { u32x4 t4; t4.x = cvt_pk_bf16(st[2 * ks2][0], st[2 * ks2][1]); t4.y = cvt_pk_bf16(st[2 * ks2][2], st[2 * ks2][3]); t4.z = cvt_pk_bf16(st[2 * ks2 + 1][0], st[2 * ks2 + 1][1]); t4.w = cvt_pk_bf16(st[2 * ks2 + 1][2], st[2 * ks2 + 1][3]); pf = __builtin_bit_cast(bf16x8, t4); }
#pragma unroll
                for (int v4 = 0; v4 < 4; ++v4) o[v4] = MFMA16(vf[ks2 * 4 + v4], pf, o[v4]);
            }
#pragma unroll
            for (int v4 = 0; v4 < 4; ++v4)
#pragma unroll
                for (int ks = 0; ks < 2; ++ks) { const bf16x8 sf = *(const LAS bf16x8*)(sb_ + ((vh * 4 + v4) * 16 + i16) * GL_P64 + (ks * 32 + 8 * g4) * 2); o[v4] = MFMA16(sf, qf[ks], o[v4]); }
        }
        float ss = 0.f;
#pragma unroll
        for (int v4 = 0; v4 < 4; ++v4)
#pragma unroll
            for (int r = 0; r < 4; ++r) ss += o[v4][r] * o[v4][r];
        ss += shx<16>(ss); ss += shx<32>(ss);
        LAS float* ssq = (LAS float*)(F.lds + G3_SSQ);
        if (g4 == 0) ssq[vh * 64 + tt * 16 + i16] = ss;
        __syncthreads();
        const float rinv = rsqrtf((ssq[tt * 16 + i16] + ssq[64 + tt * 16 + i16]) * (1.0f / 128.0f) + LN_EPS);
#pragma unroll
        for (int v4 = 0; v4 < 4; ++v4) { const int v = (vh * 4 + v4) * 16 + 4 * g4; const float r0 = bflo(rr[v4].x), r1 = bfhi(rr[v4].x), r2 = bflo(rr[v4].y), r3 = bfhi(rr[v4].y);
            u32x2 wv; wv.x = cvt_pk_bf16(o[v4][0] * rinv * ng[v4][0] * siluf_(r0), o[v4][1] * rinv * ng[v4][1] * siluf_(r1)); wv.y = cvt_pk_bf16(o[v4][2] * rinv * ng[v4][2] * siluf_(r2), o[v4][3] * rinv * ng[v4][3] * siluf_(r3));
            *(u32x2*)(mix + orow * DM + 1536 + h * 128 + v) = wv; }
    }
#undef GL3_LOAD
}
__device__ __forceinline__ void row_stats1(const float (&v)[32], float& mu, float& rstd) {
    float s = 0.f, q = 0.f;
#pragma unroll
    for (int i = 0; i < 32; ++i) { s += v[i]; q += v[i] * v[i]; }
    s = wave_sum_dpp(s); q = wave_sum_dpp(q);
    mu = s * (1.0f / 2048.0f); const float var = fmaxf(q * (1.0f / 2048.0f) - mu * mu, 0.f); rstd = rsqrtf(var + LN_EPS);
}
__device__ __forceinline__ void phase_ln_mid(const Frame& F, int l) {
    float alpha_ = ALPHA; asm volatile("" : "+v"(alpha_));
    const int nrows = (l == 0) ? MT : NLAT;
    const float* __restrict__ mod = WSP(float, WS_MOD) + (size_t)l * 5 * 12288; const bf16_t* __restrict__ Y = WSP(bf16_t, WS_R2);
    LAS float* Rt = (LAS float*)F.lds;
    { const float* __restrict__ rp = F.in[26] + (size_t)l * 2048 * 16; f32x4 rv[16];
#pragma unroll
      for (int q = 0; q < 16; ++q) rv[q] = *(const f32x4*)(rp + (size_t)(F.tid + NTHR * q) * 4);
#pragma unroll
      for (int q = 0; q < 16; ++q) { const int e4 = F.tid + NTHR * q, c = e4 >> 2, x4 = (e4 & 3) * 4; Rt[(x4 + 0) * 2048 + c] = rv[q][0]; Rt[(x4 + 1) * 2048 + c] = rv[q][1]; Rt[(x4 + 2) * 2048 + c] = rv[q][2]; Rt[(x4 + 3) * 2048 + c] = rv[q][3]; } }
    __syncthreads();
    const float* __restrict__ g1 = F.in[22] + l * DM; const float* __restrict__ b1 = F.in[23] + l * DM;
    bf16_t* __restrict__ X1 = WSP(bf16_t, WS_X1); bf16_t* __restrict__ H = WSP(bf16_t, WS_H);
#define LNM_XIN(r) ((r) < NLAT ? F.in[0] + (size_t)(r) * DM : F.in[2] + (size_t)((r) - NLAT) * DM)
#define LNM_XLOAD(r) do { if (l == 0) { const float* __restrict__ xin = LNM_XIN(r); _Pragma("unroll") for (int i = 0; i < 8; ++i) xa[i] = *(const f32x4*)(xin + (i * 64 + F.lane) * 4); } \
        else { const bf16_t* __restrict__ xin = WSP(bf16_t, WS_X2B) + (size_t)(r) * DM; _Pragma("unroll") for (int i = 0; i < 8; ++i) { const u32x2 t_ = *(const u32x2*)(xin + (i * 64 + F.lane) * 4); xa[i][0] = __uint_as_float(t_.x); xa[i][1] = __uint_as_float(t_.y); } } \
        _Pragma("unroll") for (int i = 0; i < 8; ++i) ya[i] = *(const u32x2*)(Y + (size_t)(r) * DM + (i * 64 + F.lane) * 4); } while (0)
    f32x4 xa[8]; u32x2 ya[8];
#pragma unroll
    for (int i = 0; i < 8; ++i) xa[i] = (f32x4){0.f, 0.f, 0.f, 0.f};
    const int ntrip = ROWMAP_NTRIP(nrows);
    { const int row = ROWMAP_ROW(0, nrows); if (row >= 0) LNM_XLOAD(row); }
    LAS float* Vgt1 = (LAS float*)(F.lds + 131072); LAS float* Vsc2 = Vgt1 + 2048; LAS float* Vsh2 = Vsc2 + 2048;
    int bcur = -1;
    for (int k = 0; k < ntrip; ++k) {
        const int row = ROWMAP_ROW(k, nrows), b = ROWMAP_BATCH(k);
        if (b != bcur) { bcur = b; __syncthreads();
            { const float* mb = mod + (size_t)b * 12288; const int c0 = F.tid * 4; *(LAS f32x4*)(Vgt1 + c0) = *(const f32x4*)(mb + 4096 + c0); *(LAS f32x4*)(Vsc2 + c0) = *(const f32x4*)(mb + 8192 + c0); *(LAS f32x4*)(Vsh2 + c0) = *(const f32x4*)(mb + 6144 + c0); }
            __syncthreads(); }
        float v[32];
        { f32x4 ga[8];
#pragma unroll
          for (int i = 0; i < 8; ++i) ga[i] = *(const LAS f32x4*)(Vgt1 + (i * 64 + F.lane) * 4);
#pragma unroll
          for (int i = 0; i < 8; ++i) { float x0 = xa[i][0], x1 = xa[i][1], x2 = xa[i][2], x3 = xa[i][3];
              if (l != 0) { const unsigned p0 = __float_as_uint(xa[i][0]), p1 = __float_as_uint(xa[i][1]); x0 = bflo(p0); x1 = bfhi(p0); x2 = bflo(p1); x3 = bfhi(p1); }
              v[i * 4] = alpha_ * x0 + ga[i][0] * bflo(ya[i].x); v[i * 4 + 1] = alpha_ * x1 + ga[i][1] * bfhi(ya[i].x); v[i * 4 + 2] = alpha_ * x2 + ga[i][2] * bflo(ya[i].y); v[i * 4 + 3] = alpha_ * x3 + ga[i][3] * bfhi(ya[i].y); } }
        { const int nrow = (k + 1 < ntrip) ? ROWMAP_ROW(k + 1, nrows) : -1; if (nrow >= 0) LNM_XLOAD(nrow); }
        if (row < 0) continue;
        f32x4 gg[8], bb[8];
#pragma unroll
        for (int i = 0; i < 8; ++i) { const int c0 = (i * 64 + F.lane) * 4; gg[i] = *(const f32x4*)(g1 + c0); bb[i] = *(const f32x4*)(b1 + c0); }
        float mu, rstd; row_stats1(v, mu, rstd);
#pragma unroll
        for (int i = 0; i < 8; ++i) { const int c0 = (i * 64 + F.lane) * 4; f32x4 o;
#pragma unroll
            for (int c = 0; c < 4; ++c) { o[c] = (v[i * 4 + c] - mu) * rstd * gg[i][c] + bb[i][c]; v[i * 4 + c] = o[c]; }
            u32x2 w1; w1.x = cvt_pk_bf16(o[0], o[1]); w1.y = cvt_pk_bf16(o[2], o[3]); *(u32x2*)(X1 + (size_t)row * DM + c0) = w1; }
#pragma unroll
        for (int i = 0; i < 8; ++i) { const int c0 = (i * 64 + F.lane) * 4; gg[i] = *(const LAS f32x4*)(Vsc2 + c0); bb[i] = *(const LAS f32x4*)(Vsh2 + c0); }
        row_stats1(v, mu, rstd);
#pragma unroll
        for (int i = 0; i < 8; ++i) { const int c0 = (i * 64 + F.lane) * 4;
#pragma unroll
            for (int c = 0; c < 4; ++c) v[i * 4 + c] = (v[i * 4 + c] - mu) * rstd * (1.f + gg[i][c]) + bb[i][c];
            u32x2 w; w.x = cvt_pk_bf16(v[i * 4], v[i * 4 + 1]); w.y = cvt_pk_bf16(v[i * 4 + 2], v[i * 4 + 3]); *(u32x2*)(H + (size_t)row * DM + c0) = w; }
        float s16[16];
#pragma unroll
        for (int x = 0; x < 16; ++x) { float s = 0.f;
#pragma unroll
            for (int i = 0; i < 8; ++i) { const f32x4 r = *(const LAS f32x4*)(Rt + x * 2048 + (i * 64 + F.lane) * 4); s += v[i * 4] * r[0] + v[i * 4 + 1] * r[1] + v[i * 4 + 2] * r[2] + v[i * 4 + 3] * r[3]; }
            s16[x] = s; if ((x & 3) == 3) __builtin_amdgcn_sched_barrier(0); }
        float t8[8], t4[4], t2[2], t1;
        { const bool hi = (F.lane & 32) != 0;
#pragma unroll
          for (int j = 0; j < 8; ++j) { const float send = hi ? s16[j] : s16[8 + j], keep = hi ? s16[8 + j] : s16[j]; t8[j] = keep + shx<32>(send); } }
        { const bool hi = (F.lane & 16) != 0;
#pragma unroll
          for (int j = 0; j < 4; ++j) { const float send = hi ? t8[j] : t8[4 + j], keep = hi ? t8[4 + j] : t8[j]; t4[j] = keep + shx<16>(send); } }
        { const bool hi = (F.lane & 8) != 0;
#pragma unroll
          for (int j = 0; j < 2; ++j) { const float send = hi ? t4[j] : t4[2 + j], keep = hi ? t4[2 + j] : t4[j]; t2[j] = keep + shx<8>(send); } }
        { const bool hi = (F.lane & 4) != 0; const float send = hi ? t2[0] : t2[1], keep = hi ? t2[1] : t2[0]; t1 = keep + shx<4>(send); }
        t1 += shx<2>(t1); t1 += shx<1>(t1);
        const int xid = ((F.lane >> 5) & 1) * 8 + ((F.lane >> 4) & 1) * 4 + ((F.lane >> 3) & 1) * 2 + ((F.lane >> 2) & 1);
        float mx = t1; mx = fmaxf(mx, shx<4>(mx)); mx = fmaxf(mx, shx<8>(mx)); mx = fmaxf(mx, shx<16>(mx)); mx = fmaxf(mx, shx<32>(mx));
        const float ex = __expf(t1 - mx); float sm = ex; sm += shx<4>(sm); sm += shx<8>(sm); sm += shx<16>(sm); sm += shx<32>(sm);
        if ((F.lane & 3) == 0) WSP(float, WS_AFF)[(size_t)row * 16 + xid] = ex / sm;
    }
#undef LNM_XIN
#undef LNM_XLOAD
    __syncthreads();
}
__device__ __forceinline__ void phase_topk(const Frame& F, int l) {
    LAS unsigned* keys = (LAS unsigned*)F.lds;
    LAS unsigned* hist = keys + 4096;
    LAS unsigned* misc = hist + 256;
    const float* aff = WSP(float, WS_AFF); int* tokslot = WSP(int, WS_TOKSLOT); int* seltok = WSP(int, WS_SELTOK); unsigned short* vt16 = WSP(unsigned short, WS_VT);
    const int nitem = (l == 0) ? 128 : 64;
    if (l == 0 && F.bid >= F.G - NE) { const int e = F.bid - (F.G - NE), kr2 = F.tid >> 5, c42 = F.tid & 31; *(unsigned*)(vt16 + ((e * 9 + 8) * 4096 + kr2 * 256 + 8 * (c42 ^ pg8::g8swz_(kr2))) / 2 + 2) = 0u; }
    for (int it = F.bid; it < nitem; it += F.G) { const int set = it >> 6, b = (it >> 4) & 3, e = it & 15;
        const int n = set == 0 ? SEQ : CTXL, cap = set == 0 ? 512 : 32, base = set == 0 ? b * SEQ : NLAT + b * CTXL;
        __syncthreads();
        for (int i = F.tid; i < n; i += NTHR) keys[i] = __float_as_uint(aff[(size_t)(base + i) * 16 + e]);
        if (F.tid == 0) { misc[0] = 0u; misc[1] = (unsigned)cap; }
        __syncthreads();
        for (int pass = 0; pass < 4; ++pass) { const int shift = 24 - 8 * pass; const unsigned himask = pass == 0 ? 0u : (0xffffffffu << (shift + 8));
            if (F.tid < 256) hist[F.tid] = 0u;
            __syncthreads();
            const unsigned prefix = misc[0];
            for (int i = F.tid; i < n; i += NTHR) { const unsigned k = keys[i]; if ((k & himask) == prefix) __hip_atomic_fetch_add(&hist[(k >> shift) & 255u], 1u, __ATOMIC_RELAXED, __HIP_MEMORY_SCOPE_WORKGROUP); }
            __syncthreads();
            { const unsigned rem = misc[1];
              unsigned hc = (F.tid < 256) ? hist[255 - F.tid] : 0u, inc = hc;
              for (int o = 1; o < 64; o <<= 1) { const unsigned a = __shfl_up(inc, o); if (F.lane >= o) inc += a; }
              if (F.lane == 63) misc[40 + F.wave] = inc;
              __syncthreads();
              unsigned off = 0; for (int w2 = 0; w2 < F.wave; ++w2) off += misc[40 + w2];
              inc += off;
              if (F.tid < 256 && inc >= rem && inc - hc < rem) { misc[0] = prefix | ((unsigned)(255 - F.tid) << shift); misc[1] = rem - (inc - hc); } }
            __syncthreads();
        }
        const unsigned thr = misc[0], take_eq = misc[1];
        const int per = n / NTHR; unsigned cg = 0, ce = 0;
        const int i0 = per ? F.tid * per : F.tid, cnt = per ? per : (F.tid < n ? 1 : 0);
        for (int q = 0; q < cnt; ++q) { const unsigned k = keys[i0 + q]; cg += (k > thr); ce += (k == thr); }
        unsigned sg = cg, se = ce;
        for (int o = 1; o < 64; o <<= 1) { const unsigned a = __shfl_up(sg, o), c2 = __shfl_up(se, o); if (F.lane >= o) { sg += a; se += c2; } }
        if (F.lane == 63) { misc[8 + F.wave] = sg; misc[24 + F.wave] = se; }
        __syncthreads();
        unsigned og = 0, oe = 0; for (int w2 = 0; w2 < F.wave; ++w2) { og += misc[8 + w2]; oe += misc[24 + w2]; }
        unsigned pg = og + sg - cg, pe = oe + se - ce;
        for (int q = 0; q < cnt; ++q) { const int i = i0 + q; const unsigned k = keys[i]; const bool sel = (k > thr) || (k == thr && pe < take_eq);
            const unsigned slot = pg + (pe < take_eq ? pe : take_eq);
            const int erow = set == 0 ? b * 512 + (int)slot : 2048 + b * 32 + (int)slot;
            tokslot[(size_t)(base + i) * 16 + e] = sel ? erow : -1;
            if (sel) { seltok[e * ER + erow] = base + i;
                const int pm = e * 9 + (erow >> 8), rr = erow & 255, R = rr & 63, sl = (rr >> 7) * 2 + ((rr >> 6) & 1);
#pragma unroll
                for (int q8 = 0; q8 < 8; ++q8) { const int t2 = ((R >> 4) * 2 + (q8 >> 2)) * 64 + (R & 15) * 4 + (q8 & 3), kr2 = t2 >> 5, c42 = t2 & 31;
                    vt16[(pm * 4096 + kr2 * 256 + 8 * (c42 ^ pg8::g8swz_(kr2))) / 2 + sl] = (unsigned short)(base + i); } }
            pg += (k > thr); pe += (k == thr); }
    }
    __syncthreads();
}
__device__ __forceinline__ void phase_gather(const Frame& F, int l) {
    const int valid = (l == 0) ? 2176 : 2048, rows = (l == 0) ? ER : 2048;
    const int* __restrict__ seltok = WSP(int, WS_SELTOK); const bf16_t* __restrict__ H = WSP(bf16_t, WS_H); bf16_t* __restrict__ xe = WSP(bf16_t, WS_R2);
    const int n = NE * rows, step = F.G * 8;
    for (int it = F.bid * 8 + F.wave; it < n; it += 4 * step) {
        int tok[4]; bf16_t* dst[4];
#pragma unroll
        for (int u = 0; u < 4; ++u) { const int i = it + u * step; tok[u] = -1; dst[u] = xe;
            if (i < n) { const int e = i / rows, r = i % rows; dst[u] = xe + (size_t)(e * ER + r) * DM; tok[u] = (r < valid) ? seltok[e * ER + r] : -2; } }
        u32x4 v[4][4];
#pragma unroll
        for (int u = 0; u < 4; ++u) { const bf16_t* src = H + (size_t)(tok[u] >= 0 ? tok[u] : 0) * DM;
#pragma unroll
            for (int q = 0; q < 4; ++q) v[u][q] = *(const u32x4*)(src + (q * 64 + F.lane) * 8); }
#pragma unroll
        for (int u = 0; u < 4; ++u) if (tok[u] != -1) {
#pragma unroll
            for (int q = 0; q < 4; ++q) *(u32x4*)(dst[u] + (q * 64 + F.lane) * 8) = (tok[u] >= 0) ? v[u][q] : (u32x4){0u, 0u, 0u, 0u}; }
    }
}
__device__ __forceinline__ void phase_combine(const Frame& F, int l) {
    float alpha_ = ALPHA; asm volatile("" : "+v"(alpha_));
    const int nrows = (l == 0) ? MT : NLAT;
    const float* mod = WSP(float, WS_MOD) + (size_t)l * 5 * 12288; const float* modn = WSP(float, WS_MOD) + (size_t)5 * 12288;
    const float* aff = WSP(float, WS_AFF); const int* tokslot = WSP(int, WS_TOKSLOT); const bf16_t* ye = WSP(bf16_t, WS_R3);
    const float* g2 = F.in[24] + l * DM; const float* b2 = F.in[25] + l * DM;
    LAS float* Vg2 = (LAS float*)F.lds; LAS float* Vb2 = Vg2 + 2048; LAS float* Vgt2 = Vb2 + 2048; LAS float* Vsh = Vgt2 + 2048; LAS float* Vsc = Vsh + 2048;
    __syncthreads();
    { const int c0 = F.tid * 4; *(LAS f32x4*)(Vg2 + c0) = *(const f32x4*)(g2 + c0); *(LAS f32x4*)(Vb2 + c0) = *(const f32x4*)(b2 + c0); }
    int bcur = -1;
    int myslot = -1; float myg = 0.f; u32x4 xv[4];
    const int ntrip = ROWMAP_NTRIP(nrows);
    { const int row = ROWMAP_ROW(0, nrows); if (row >= 0) { if (F.lane < 16) { myslot = tokslot[(size_t)row * 16 + F.lane]; myg = aff[(size_t)row * 16 + F.lane]; }
        const bf16_t* xp = WSP(bf16_t, WS_X1) + (size_t)row * DM;
#pragma unroll
        for (int i = 0; i < 4; ++i) xv[i] = *(const u32x4*)(xp + (i * 64 + F.lane) * 8); } }
    for (int k = 0; k < ntrip; ++k) {
        const int row = ROWMAP_ROW(k, nrows), b = ROWMAP_BATCH(k);
        if (b != bcur) { bcur = b; __syncthreads();
            { const int c0 = F.tid * 4; *(LAS f32x4*)(Vgt2 + c0) = *(const f32x4*)(mod + (size_t)b * 12288 + 10240 + c0);
              if (l == 0) { *(LAS f32x4*)(Vsh + c0) = *(const f32x4*)(modn + (size_t)b * 12288 + c0); *(LAS f32x4*)(Vsc + c0) = *(const f32x4*)(modn + (size_t)b * 12288 + 2048 + c0); } }
            __syncthreads(); }
        float v[32];
#pragma unroll
        for (int i = 0; i < 4; ++i) { v[i * 8] = bflo(xv[i].x); v[i * 8 + 1] = bfhi(xv[i].x); v[i * 8 + 2] = bflo(xv[i].y); v[i * 8 + 3] = bfhi(xv[i].y); v[i * 8 + 4] = bflo(xv[i].z); v[i * 8 + 5] = bfhi(xv[i].z); v[i * 8 + 6] = bflo(xv[i].w); v[i * 8 + 7] = bfhi(xv[i].w); }
        const int cslot = myslot; const float cg = myg;
        { const int nrow = (k + 1 < ntrip) ? ROWMAP_ROW(k + 1, nrows) : -1; if (nrow >= 0) {
            if (F.lane < 16) { myslot = tokslot[(size_t)nrow * 16 + F.lane]; myg = aff[(size_t)nrow * 16 + F.lane]; }
            const bf16_t* xp = WSP(bf16_t, WS_X1) + (size_t)nrow * DM;
#pragma unroll
            for (int i = 0; i < 4; ++i) xv[i] = *(const u32x4*)(xp + (i * 64 + F.lane) * 8); } }
        if (row < 0) continue;
        float f[32];
#pragma unroll
        for (int i = 0; i < 32; ++i) f[i] = 0.f;
        unsigned long long msk = __ballot(cslot >= 0);
        while (msk) {
            const int e0 = __builtin_ctzll(msk); msk &= msk - 1; const int e1 = msk ? __builtin_ctzll(msk) : e0; const bool two = msk != 0; msk &= msk - 1;
            const int s0 = __builtin_amdgcn_readlane(cslot, e0), s1 = __builtin_amdgcn_readlane(cslot, e1);
            const float w0 = __int_as_float(__builtin_amdgcn_readlane(__float_as_int(cg), e0)), w1 = two ? __int_as_float(__builtin_amdgcn_readlane(__float_as_int(cg), e1)) : 0.f;
            const bf16_t* y0 = ye + (size_t)(e0 * ER + s0) * DM; const bf16_t* y1 = ye + (size_t)(e1 * ER + s1) * DM;
            u32x4 a[4], c[4];
#pragma unroll
            for (int i = 0; i < 4; ++i) { a[i] = *(const u32x4*)(y0 + (i * 64 + F.lane) * 8); c[i] = *(const u32x4*)(y1 + (i * 64 + F.lane) * 8); }
#pragma unroll
            for (int i = 0; i < 4; ++i) {
                f[i * 8 + 0] += w0 * bflo(a[i].x) + w1 * bflo(c[i].x); f[i * 8 + 1] += w0 * bfhi(a[i].x) + w1 * bfhi(c[i].x);
                f[i * 8 + 2] += w0 * bflo(a[i].y) + w1 * bflo(c[i].y); f[i * 8 + 3] += w0 * bfhi(a[i].y) + w1 * bfhi(c[i].y);
                f[i * 8 + 4] += w0 * bflo(a[i].z) + w1 * bflo(c[i].z); f[i * 8 + 5] += w0 * bfhi(a[i].z) + w1 * bfhi(c[i].z);
                f[i * 8 + 6] += w0 * bflo(a[i].w) + w1 * bflo(c[i].w); f[i * 8 + 7] += w0 * bfhi(a[i].w) + w1 * bfhi(c[i].w); }
        }
#pragma unroll
        for (int i = 0; i < 4; ++i) { const f32x4 ga = *(const LAS f32x4*)(Vgt2 + (i * 64 + F.lane) * 8), gc = *(const LAS f32x4*)(Vgt2 + (i * 64 + F.lane) * 8 + 4);
#pragma unroll
            for (int c = 0; c < 4; ++c) { v[i * 8 + c] = alpha_ * v[i * 8 + c] + ga[c] * f[i * 8 + c]; v[i * 8 + 4 + c] = alpha_ * v[i * 8 + 4 + c] + gc[c] * f[i * 8 + 4 + c]; } }
        float mu, rstd; row_stats1(v, mu, rstd);
        float* xo = F.out + (size_t)row * DM; bf16_t* xb = WSP(bf16_t, WS_X2B) + (size_t)row * DM;
#pragma unroll
        for (int i = 0; i < 4; ++i) { const int c0 = (i * 64 + F.lane) * 8;
#pragma unroll
            for (int hh = 0; hh < 2; ++hh) { const f32x4 gg = *(const LAS f32x4*)(Vg2 + c0 + hh * 4), bb = *(const LAS f32x4*)(Vb2 + c0 + hh * 4); f32x4 o;
#pragma unroll
                for (int c = 0; c < 4; ++c) { o[c] = (v[i * 8 + hh * 4 + c] - mu) * rstd * gg[c] + bb[c]; v[i * 8 + hh * 4 + c] = o[c]; }
                if (l != 0) *(f32x4*)(xo + c0 + hh * 4) = o; }
            if (l == 0 && row < NLAT) { u32x4 w; w.x = cvt_pk_bf16(v[i * 8], v[i * 8 + 1]); w.y = cvt_pk_bf16(v[i * 8 + 2], v[i * 8 + 3]); w.z = cvt_pk_bf16(v[i * 8 + 4], v[i * 8 + 5]); w.w = cvt_pk_bf16(v[i * 8 + 6], v[i * 8 + 7]); *(u32x4*)(xb + c0) = w; } }
        if (l == 0) { row_stats1(v, mu, rstd); bf16_t* hd = WSP(bf16_t, WS_H) + (size_t)row * DM;
#pragma unroll
            for (int i = 0; i < 4; ++i) { const int c0 = (i * 64 + F.lane) * 8; float o[8];
#pragma unroll
                for (int hh = 0; hh < 2; ++hh) { const f32x4 a = *(const LAS f32x4*)(Vsc + c0 + hh * 4), bq = *(const LAS f32x4*)(Vsh + c0 + hh * 4);
#pragma unroll
                    for (int c = 0; c < 4; ++c) o[hh * 4 + c] = (v[i * 8 + hh * 4 + c] - mu) * rstd * (1.f + a[c]) + bq[c]; }
                u32x4 w; w.x = cvt_pk_bf16(o[0], o[1]); w.y = cvt_pk_bf16(o[2], o[3]); w.z = cvt_pk_bf16(o[4], o[5]); w.w = cvt_pk_bf16(o[6], o[7]); *(u32x4*)(hd + c0) = w; } }
    }
    __syncthreads();
}
#ifndef PROBE_SUB
#define PROBE_SUB 0
#endif
__device__ __forceinline__ void s5_scan2(const Frame& F, int l, int first_thread, int nthreads) {
    const float* __restrict__ S = WSP(float, WS_S5S); bf16_t* __restrict__ SI = WSP(bf16_t, WS_S5IN);
    for (int e = first_thread; e < 4 * 32 * 128; e += nthreads) { const int p = e & 63, d = (e >> 6) & 1, g = (e >> 7) & 31, b = e >> 12;
        const f32x2 lt = WSP(f32x2, WS_LAMT)[((size_t)(l * 32 + g) * 2 + d) * 64 + p];
        float sx = 0.f, sy = 0.f; const size_t co = (size_t)g * 256 + d * 128 + p * 2;
#define S5S_ROW(i) (((i) < 8) ? (512 + b * 8 + (d == 0 ? (i) : 7 - (i))) : (b * 128 + (d == 0 ? ((i) - 8) : 127 - ((i) - 8))))
        for (int i0 = 0; i0 < 136; i0 += 34) { f32x2 sv[34];
#pragma unroll
            for (int q = 0; q < 34; ++q) { const int r = S5S_ROW(i0 + q); sv[q] = *(const f32x2*)(S + ((unsigned)r * 8192u + (unsigned)co)); }
#pragma unroll
            for (int q = 0; q < 34; ++q) { const int r = S5S_ROW(i0 + q); *(unsigned*)(SI + ((unsigned)r * 8192u + (unsigned)co)) = cvt_pk_bf16(sx, sy);
                const float nx = lt.x * sx - lt.y * sy + sv[q].x, ny = lt.x * sy + lt.y * sx + sv[q].y; sx = nx; sy = ny; } }
#undef S5S_ROW
    }
}
template <int NEL>
__device__ __forceinline__ void gla_scan_n(const float* __restrict__ upd, const float* __restrict__ dec, bf16_t* __restrict__ st, int e0, int es) {
    int el[NEL], bhd[NEL], d[NEL], k[NEL]; float s[NEL];
#pragma unroll
    for (int a = 0; a < NEL; ++a) { const int e = e0 + a * es; el[a] = e & 8191; bhd[a] = e >> 13; d[a] = bhd[a] & 1; k[a] = el[a] & 63; s[a] = 0.f; }
    for (int p0 = 0; p0 < 68; p0 += 17) { float u[NEL][17], dc[NEL][17];
#pragma unroll
        for (int q = 0; q < 17; ++q)
#pragma unroll
            for (int a = 0; a < NEL; ++a) { const int pos = p0 + q; const int j = d[a] == 0 ? pos : (pos < 4 ? 3 - pos : 71 - pos); const unsigned base = (unsigned)(bhd[a] * 68 + j); u[a][q] = upd[base * 8192u + (unsigned)el[a]]; dc[a][q] = dec[base * 64u + (unsigned)k[a]]; }
#pragma unroll
        for (int q = 0; q < 17; ++q)
#pragma unroll
            for (int a = 0; a < NEL; ++a) { const int pos = p0 + q; const int j = d[a] == 0 ? pos : (pos < 4 ? 3 - pos : 71 - pos); const unsigned base = (unsigned)(bhd[a] * 68 + j); st[base * 8192u + (unsigned)el[a]] = f2bf(s[a]); s[a] = dc[a][q] * s[a] + u[a][q]; } }
}
__device__ __forceinline__ void gla_scan2(const Frame& F, int first_thread, int nthreads) {
    const float* __restrict__ upd = WSP(float, WS_R3 + (size_t)MT * DM * 2 + (size_t)MT * 512 * 2); const float* __restrict__ dec = WSP(float, WS_GDEC); bf16_t* __restrict__ st = WSP(bf16_t, WS_GST);
    const int N = 32 * 8192;
    for (int e = first_thread; e < N; e += 3 * nthreads) {
        if (e + 2 * nthreads < N) gla_scan_n<3>(upd, dec, st, e, nthreads);
        else if (e + nthreads < N) gla_scan_n<2>(upd, dec, st, e, nthreads);
        else gla_scan_n<1>(upd, dec, st, e, nthreads); }
}

#define XB_TMO      128
#define XB_XCNT(j)  (256  + 64 * (j))
#define XB_XSUB(j)  (1280 + 64 * (j))
#define XB_XGEN(j)  (2304 + 64 * (j))
#define XB_TOP      3328
#define XB_TOPGEN   3392
#define XCD_BAR_WORDS 3456
#define XB_SPIN_CAP (1u << 18)

__device__ __forceinline__ unsigned xb_ld(unsigned* p)              { return __hip_atomic_load(p, __ATOMIC_RELAXED, __HIP_MEMORY_SCOPE_AGENT); }
__device__ __forceinline__ unsigned xb_add(unsigned* p, unsigned v) { return __hip_atomic_fetch_add(p, v, __ATOMIC_RELAXED, __HIP_MEMORY_SCOPE_AGENT); }
__device__ __forceinline__ unsigned xb_xcc_id() { return (unsigned)__builtin_amdgcn_s_getreg((3 << 11) | 20) & 0xFu; }
#define XB_SPIN(cond, bar) do { unsigned _sp = 0; while (cond) { __builtin_amdgcn_s_sleep(1); \
    if ((++_sp & 255u) == 0u) { if (xb_ld(&(bar)[XB_TMO])) break; if (_sp > XB_SPIN_CAP) { atomicAdd(&(bar)[XB_TMO], 1u); break; } } } } while (0)

struct XcdBarrier {
    unsigned* bar; unsigned x;
    volatile LAS unsigned* st;
};

__device__ __forceinline__ XcdBarrier xcd_barrier_post(unsigned* bar, volatile LAS unsigned* st) {
    XcdBarrier b; b.bar = bar; b.x = xb_xcc_id(); b.st = st;
    if (threadIdx.x == 0) (void)xb_add(&bar[XB_XCNT(b.x)], 1u);
    return b;
}
__device__ __forceinline__ void xcd_barrier_complete(unsigned* bar, unsigned x, unsigned& nloc, unsigned& nx) {
    const unsigned G = gridDim.x * gridDim.y * gridDim.z;
    unsigned sum, cnt, mine, sp = 0u;
    for (;;) {
        sum = 0u; cnt = 0u; mine = 0u;
#pragma unroll
        for (unsigned j = 0; j < 16; ++j) { const unsigned c = xb_ld(&bar[XB_XCNT(j)]); sum += c; cnt += (c > 0u) ? 1u : 0u; mine = (j == x) ? c : mine; }
        if (sum == G) break;
        __builtin_amdgcn_s_sleep(1);
        if ((++sp & 255u) == 0u) { if (xb_ld(&bar[XB_TMO])) break; if (sp > XB_SPIN_CAP) { atomicAdd(&bar[XB_TMO], 1u); break; } }
    }
    nloc = mine > 0u ? mine : 1u; nx = cnt > 0u ? cnt : 1u;
}

__device__ __forceinline__ void xcd_barrier(const XcdBarrier& b) {
    asm volatile("s_waitcnt vmcnt(0)" ::: "memory");
    __syncthreads();
    if (threadIdx.x == 0) {
        unsigned* bar = b.bar;
        __builtin_amdgcn_s_waitcnt(0);
        unsigned nloc = b.st[0], nx = b.st[1];
        if (nloc == 0u) { xcd_barrier_complete(bar, b.x, nloc, nx); b.st[0] = nloc; b.st[1] = nx; }
        const unsigned old = xb_add(&bar[XB_XSUB(b.x)], 1u);
        const unsigned gen = old / nloc;
        if (old + 1u == (gen + 1u) * nloc) {
            __builtin_amdgcn_fence(__ATOMIC_RELEASE, "agent");
            asm volatile("s_waitcnt vmcnt(0)" ::: "memory");
            const unsigned og = xb_add(&bar[XB_TOP], 1u);
            const unsigned tg = og / nx;
            if (og + 1u == (tg + 1u) * nx) xb_add(&bar[XB_TOPGEN], 1u);
            else XB_SPIN(xb_ld(&bar[XB_TOPGEN]) == tg, bar);
            __builtin_amdgcn_fence(__ATOMIC_ACQUIRE, "agent");
            xb_add(&bar[XB_XGEN(b.x)], 1u);
            asm volatile("s_waitcnt vmcnt(0)" ::: "memory");
        } else {
            XB_SPIN(xb_ld(&bar[XB_XGEN(b.x)]) == gen, bar);
            __builtin_amdgcn_fence(__ATOMIC_ACQUIRE, "agent");
            asm volatile("s_waitcnt vmcnt(0)" ::: "memory");
        }
    }
    __syncthreads();
}


__device__ __forceinline__ int wrapadd(int a, int b, int n) { int x = a + (b < n ? b : 0); return x >= n ? x - n : x; }
__device__ __forceinline__ void conv_share(int c, int G, int NU, int& q0, int& q1) { int g_; asm volatile("v_mov_b32 %0, %1" : "=v"(g_) : "s"(G)); q0 = __builtin_amdgcn_readfirstlane((int)((long)c * NU / g_)); q1 = __builtin_amdgcn_readfirstlane((int)((long)(c + 1) * NU / g_)); }
constexpr int N_PHASES = 27;
__global__ void __launch_bounds__(NTHR, 2) mega_fwd(Args args) {
    extern __shared__ __attribute__((aligned(16))) unsigned char lds_raw[];
    Frame F; F.in = args.in; F.out = args.out; F.ws = args.ws; F.lds = (LAS unsigned char*)lds_raw;
    F.tid = threadIdx.x; F.lane = F.tid & 63; F.wave = __builtin_amdgcn_readfirstlane(F.tid >> 6); F.G = gridDim.x; F.bid = blockIdx.x;
    const int wave0_ = __builtin_amdgcn_readfirstlane((int)threadIdx.x >> 6);
#define FRESH() do { int t_; asm volatile("v_mbcnt_lo_u32_b32 %0, -1, 0\n\tv_mbcnt_hi_u32_b32 %0, -1, %0" : "=v"(t_)); t_ |= (wave0_ << 6); F.tid = t_; F.lane = t_ & 63; F.wave = __builtin_amdgcn_readfirstlane(t_ >> 6); { const void* ka_ = (const void*)__builtin_amdgcn_kernarg_segment_ptr(); unsigned char* w_; float* o_; asm volatile("s_load_dwordx2 %0, %2, 0xf8\n\ts_load_dwordx2 %1, %2, 0xf0\n\ts_waitcnt lgkmcnt(0)" : "=&s"(w_), "=&s"(o_) : "s"(ka_) : "memory"); F.ws = w_; F.out = o_; F.bid = blockIdx.x; } } while (0)
    const int lo = args.ph_lo, hi = args.ph_hi;
    const bool fused = (hi - lo) > 1;
    if (F.tid == 0) *(LAS u32x4*)(F.lds + LDS_BAR_OFF) = (u32x4){0u, 0u, 0u, 0u};
    __syncthreads();
    XcdBarrier bar; bar.bar = (unsigned*)(F.ws + WS_CTL); bar.x = 0; bar.st = nullptr;
    if (fused) bar = xcd_barrier_post((unsigned*)(F.ws + WS_CTL), (volatile LAS unsigned*)(F.lds + LDS_BAR_OFF));
#ifdef ONLY_PHASE
#define IN(k) (((k) == ONLY_PHASE || (k) == ONLY_PHASE + 12) && lo <= (k) && (k) < hi)
#else
#define IN(k) (lo <= (k) && (k) < hi)
#endif
#define SEAM(k) do { if (IN((k) + 1)) xcd_barrier(bar); } while (0)
#ifndef PROBE_REP
#define PROBE_REP 0
#endif
#define NREP(bit) (((PROBE_REP >> (bit)) & 1) ? 2 : 1)
    if (IN(0)) { FRESH(); phase_prologue(F); SEAM(0); }
    if (IN(1)) { FRESH(); phase_mod_reduce(F); SEAM(1); }
    if (IN(2)) { FRESH(); phase_ln1_first(F); SEAM(2); }
    for (int l = 0; l < 2; ++l) {
        const int pb = 3 + l * 12;
        if (IN(pb + 0)) { FRESH();
            pg8::Gemm g{WSP(bf16_t, WS_H), WSP(bf16_t, WS_WIN) + (size_t)l * NINP * DM, MT, NINP, DM}; pg8::StaticOrder S; S.init(MT, NINP, F.G, F.bid);
            pg8::EpiProj E{WSP(bf16_t, WS_R1), WSP(bf16_t, WS_SU), WSP(float, WS_ROPE)};
            pg8::gemm_phase<pg8::EpiProj, pg8::StaticOrder>(F.lds, g, S, E, F.tid); SEAM(pb + 0); }
        if (IN(pb + 1)) { FRESH(); for (int r_ = 0; r_ < (PROBE_SUB == 1 ? 2 : 1); ++r_) attn_items(F, l, F.bid, F.G); for (int r_ = 0; r_ < (PROBE_SUB == 2 ? 2 : 1); ++r_) if ((F.G & 7) == 0) s5a_items(F, l, F.bid & 7, wrapadd(F.bid >> 3, F.G >> 4, F.G >> 3), F.G >> 3); else s5a_items(F, l, -1, F.bid, F.G); for (int r_ = 0; r_ < (PROBE_SUB == 3 ? 2 : 1); ++r_) gla1_items(F, l, wrapadd(F.bid, 96, F.G), F.G); SEAM(pb + 1); }
        if (IN(pb + 2)) { FRESH(); if (F.bid < 32) s5_scan2(F, l, F.bid * NTHR + F.tid, 32 * NTHR); else gla_scan2(F, (F.bid - 32) * NTHR + F.tid, (F.G - 32) * NTHR); SEAM(pb + 2); }
        if (IN(pb + 3)) { FRESH(); for (int r_ = 0; r_ < (PROBE_SUB == 4 ? 2 : 1); ++r_) if ((F.G & 7) == 0) s5c_items(F, l, F.bid & 7, F.bid >> 3, F.G >> 3); else s5c_items(F, l, -1, F.bid, F.G); for (int r_ = 0; r_ < (PROBE_SUB == 5 ? 2 : 1); ++r_) gla3_items(F, l, wrapadd(F.bid, 32, F.G), F.G); SEAM(pb + 3); }
        if (IN(pb + 4)) { FRESH();
            pg8::Gemm g{WSP(bf16_t, WS_R3 + (size_t)MT * DM * 2), WSP(bf16_t, WS_WGLU) + (size_t)l * 512 * 512, MT, 512, 512}; pg8::StaticOrder S; S.init(MT, 512, F.G, F.bid);
            pg8::EpiGlu E{WSP(bf16_t, WS_R3 + (size_t)MT * DM * 2), F.in[17] + l * 512, WSP(bf16_t, WS_R3)};
            pg8::gemm_phase<pg8::EpiGlu, pg8::StaticOrder, MT>(F.lds, g, S, E, F.tid); SEAM(pb + 4); }
        if (IN(pb + 5)) { FRESH();
            pg8::Gemm g{WSP(bf16_t, WS_R3), WSP(bf16_t, WS_WOUT) + (size_t)l * DM * DM, NLAT, DM, DM};
            pg8::EpiBf16 E{WSP(bf16_t, WS_R2), DM};
            const bool qtail = (F.G >= 128);
            { const int split = 0;     pg8::OutOrder0 S; S.S0.init((l == 0 && !split && !qtail) ? MT : NLAT, DM, F.G, F.bid); S.G = F.G; S.c = F.bid; S.split = split; pg8::gemm_phase<pg8::EpiBf16, pg8::OutOrder0>(F.lds, g, S, E, F.tid); }
            if (l == 0 && qtail) { FRESH(); if (F.bid < 128) pg8::gemm_quarter<pg8::EpiBf16>(F.lds, g, 64 + (F.bid >> 5), (F.bid >> 2) & 7, (F.bid >> 1) & 1, F.bid & 1, E, F.tid); }
            SEAM(pb + 5); }
        if (IN(pb + 6)) { FRESH(); phase_ln_mid(F, l); SEAM(pb + 6); }
        if (IN(pb + 7)) { FRESH(); phase_topk(F, l); SEAM(pb + 7); }
        if (IN(pb + 9)) { FRESH();
            pg8::GemmF g{WSP(bf16_t, WS_H), F.in[27] + (size_t)l * NE * DM * DM, F.in[28] + (size_t)l * NE * DM * DM, (size_t)DM * DM, 128, DM, DM, nullptr, WSP(unsigned, WS_VT)};
            pg8::GroupedOrder S{NE, (l == 0) ? 9 : 8, 16, 9, F.G, F.bid, 0};
            pg8::EpiGateUp E{WSP(bf16_t, WS_R1)};
            pg8::gemm_phase_fb<pg8::EpiGateUp, pg8::GroupedOrder, 0, false, true>(F.lds, g, S, E, F.tid); SEAM(pb + 9); }
        if (IN(pb + 10)) { FRESH();
            pg8::GemmF g{WSP(bf16_t, WS_R1), F.in[29] + (size_t)l * NE * DM * DM, F.in[29] + (size_t)l * NE * DM * DM + 128, (size_t)DM * DM, 256, DM, DM, nullptr};
            pg8::GroupedOrder S{NE, (l == 0) ? 9 : 8, 8, 9, F.G, F.bid, 0};
            pg8::EpiBf16 E{WSP(bf16_t, WS_R3), DM};
            pg8::gemm_phase_fb<pg8::EpiBf16, pg8::GroupedOrder>(F.lds, g, S, E, F.tid); SEAM(pb + 10); }
        if (IN(pb + 11)) { FRESH(); phase_combine(F, l); SEAM(pb + 11); }
    }
#undef IN
#undef SEAM
}

#ifndef PROBE_NREP
#define PROBE_NREP 2
#endif
#ifndef PROBE_REP_MASK
#define PROBE_REP_MASK 0ull
#endif
#ifndef MK_MULTI
#define MK_MULTI 0
#endif
extern "C" void kernel_launch(void* const* d_in, const int* in_sizes, int n_in, void* d_out, int out_size, void* d_ws, size_t ws_size, hipStream_t stream) {
    static int grid = 0;
    if (grid == 0) {
        if (n_in != 30 || out_size != NLAT * DM || ws_size < WS_END) { fprintf(stderr, "kernel_launch: unexpected shapes (n_in %d, out %d, ws %zu, need %zu)\n", n_in, out_size, ws_size, (size_t)WS_END); grid = -1; return; }
        int dev = 0, cus = 0, per_cu = 0;
        if (hipGetDevice(&dev) != hipSuccess || hipDeviceGetAttribute(&cus, hipDeviceAttributeMultiprocessorCount, dev) != hipSuccess) { grid = -1; return; }
        if (hipFuncSetAttribute((const void*)mega_fwd, hipFuncAttributeMaxDynamicSharedMemorySize, LDS_BYTES) != hipSuccess) { fprintf(stderr, "kernel_launch: hipFuncSetAttribute failed\n"); grid = -1; return; }
        if (hipOccupancyMaxActiveBlocksPerMultiprocessor(&per_cu, (const void*)mega_fwd, NTHR, LDS_BYTES) != hipSuccess || per_cu < 1) fprintf(stderr, "kernel_launch: occupancy query says %d\n", per_cu);
        (void)hipGetLastError();
        grid = cus;
    }
    if (grid < 0) return;
    (void)hipMemsetAsync((char*)d_ws + WS_CTL, 0, CTL_BYTES, stream);
    Args a{};
    for (int i = 0; i < 30; ++i) a.in[i] = (const float*)d_in[i];
    a.out = (float*)d_out; a.ws = (unsigned char*)d_ws;
#if MK_MULTI
    for (int p = 0; p < N_PHASES; ++p) { const int nrep = ((PROBE_REP_MASK >> p) & 1ull) ? PROBE_NREP : 1; for (int r = 0; r < nrep; ++r) { a.ph_lo = p; a.ph_hi = p + 1; hipLaunchKernelGGL(mega_fwd, dim3(grid), dim3(NTHR), LDS_BYTES, stream, a); } }
#else
    a.ph_lo = 0; a.ph_hi = N_PHASES; hipLaunchKernelGGL(mega_fwd, dim3(grid), dim3(NTHR), LDS_BYTES, stream, a);
#endif
}
```

```cpp
#include <hip/hip_runtime.h>
#ifndef PROBE_SUB
#define PROBE_SUB 0
#endif
#include <cstdio>
#include <cstdint>

#define LAS __attribute__((address_space(3)))
typedef unsigned short bf16_t;
typedef short bf16x8 __attribute__((ext_vector_type(8)));
typedef short s16x4 __attribute__((ext_vector_type(4)));
typedef float f32x4 __attribute__((ext_vector_type(4)));
typedef float f32x2 __attribute__((ext_vector_type(2)));
typedef unsigned u32x4 __attribute__((ext_vector_type(4)));
typedef unsigned u32x2 __attribute__((ext_vector_type(2)));

constexpr int NB = 4, SEQ = 4096, CTXL = 256, DM = 2048;
constexpr int NLAT = NB * SEQ, NCTX = NB * CTXL, MT = NLAT + NCTX;
constexpr int NIN = 3616, NINP = 3840;
constexpr int C_Q = 0, C_K = 1024, C_V = 1280, C_SU = 1536, C_GQ = 2048, C_GK = 2304, C_GV = 2560, C_GR = 3072, C_GZ = 3584;
constexpr int NE = 16, ER = 2304;
constexpr float ALPHA = 1.41421356237309515f;
constexpr float LN_EPS = 1e-6f;
constexpr int NTHR = 512;
constexpr int LDS_BYTES = 163840;
constexpr int LDS_BAR_OFF = 163840 - 64;

constexpr size_t al256(size_t x) { return (x + 255) & ~(size_t)255; }
constexpr size_t WS_CTL = 0, CTL_BYTES = 1u << 20;
constexpr size_t WS_MODP = WS_CTL + CTL_BYTES;
constexpr size_t WS_MOD = WS_MODP + (size_t)2 * 32 * 5 * 12288 * 4;
constexpr size_t WS_ROPE = WS_MOD + (size_t)2 * 5 * 12288 * 4;
constexpr size_t WS_LAMT = WS_ROPE + 64 * 32 * 8;
constexpr size_t WS_WIN = al256(WS_LAMT + 2 * 32 * 2 * 64 * 8);
constexpr size_t WS_WOUT = WS_WIN + (size_t)2 * NINP * DM * 2;
constexpr size_t WS_WGLU = WS_WOUT + (size_t)2 * DM * DM * 2;
constexpr size_t WS_WGU = WS_WGLU + (size_t)2 * 512 * 512 * 2;
constexpr size_t WS_X2B = WS_WGU;
constexpr size_t WS_WDN = WS_WGU + (size_t)2 * NE * 4096 * DM * 2;
constexpr size_t WS_S5A = WS_WDN + (size_t)2 * NE * 2048 * DM * 2;
constexpr size_t WS_S5C = WS_S5A + (size_t)2 * 32 * 256 * 512 * 2;
constexpr size_t WS_X1 = WS_S5C + (size_t)2 * 32 * 512 * 768 * 2;
constexpr size_t WS_X2C = WS_X1 + (size_t)MT * DM * 4;
constexpr size_t WS_H = WS_X2C + (size_t)NCTX * DM * 4;
constexpr size_t WS_R1 = WS_H + (size_t)MT * DM * 2;
constexpr size_t R_BYTES = (size_t)NE * ER * DM * 2;
constexpr size_t WS_R2 = WS_R1 + R_BYTES;
constexpr size_t WS_R3 = WS_R2 + R_BYTES;
constexpr size_t R3_BYTES = (size_t)MT * DM * 2 + (size_t)MT * 512 * 2 + (size_t)32 * 68 * 8192 * 4;
constexpr size_t WS_SU = WS_R3 + R3_BYTES;
constexpr size_t WS_AFF = WS_SU + (size_t)32 * MT * 16 * 2;
constexpr size_t WS_TOKSLOT = WS_AFF + (size_t)MT * 16 * 4;
constexpr size_t WS_SELTOK = WS_TOKSLOT + (size_t)MT * 16 * 4;
constexpr size_t WS_S5S = WS_SELTOK + (size_t)NE * ER * 4;
constexpr size_t WS_S5IN = WS_S5S + (size_t)544 * 32 * 256 * 4;
constexpr size_t WS_GDEC = WS_S5IN + (size_t)544 * 32 * 256 * 2;
constexpr size_t WS_GST = WS_GDEC + (size_t)32 * 68 * 64 * 4;
constexpr size_t WS_GQIN = WS_GST + (size_t)32 * 68 * 8192 * 2;
constexpr size_t WS_GKP = WS_GQIN + (size_t)32 * 68 * 4096 * 2;
constexpr size_t WS_VT = WS_GKP + (size_t)32 * 68 * 4096 * 2;
constexpr size_t WS_END = WS_VT + (size_t)NE * 9 * 4096;
static_assert(R3_BYTES >= R_BYTES, "YE must fit in R3");
static_assert((size_t)MT * NINP * 2 <= R_BYTES && (size_t)MT * DM * 4 <= R_BYTES, "PROJ / Y fit");
static_assert(WS_END < (size_t)2000 * 1000 * 1000, "workspace budget");

__device__ __forceinline__ unsigned cvt_pk_bf16(float lo, float hi) { unsigned r; asm volatile("v_cvt_pk_bf16_f32 %0, %1, %2" : "=v"(r) : "v"(lo), "v"(hi)); return r; }
typedef _Float16 h2_t __attribute__((ext_vector_type(2)));
__device__ __forceinline__ unsigned cvt_pk_f16(float lo, float hi) { h2_t h; h.x = (_Float16)lo; h.y = (_Float16)hi; return __builtin_bit_cast(unsigned, h); }
__device__ __forceinline__ bf16_t f2bf(float x) { return (bf16_t)(cvt_pk_bf16(x, 0.f) & 0xffffu); }
__device__ __forceinline__ float bf2f(bf16_t b) { return __uint_as_float(((unsigned)b) << 16); }
__device__ __forceinline__ float bflo(unsigned w) { return __uint_as_float(w << 16); }
__device__ __forceinline__ float bfhi(unsigned w) { return __uint_as_float(w & 0xffff0000u); }
template <int O>
__device__ __forceinline__ float shx(float v) {
    const int x = __float_as_int(v);
    if constexpr (O == 1) return __int_as_float(__builtin_amdgcn_update_dpp(0, x, 0xB1, 0xF, 0xF, true));
    else if constexpr (O == 2) return __int_as_float(__builtin_amdgcn_update_dpp(0, x, 0x4E, 0xF, 0xF, true));
    else if constexpr (O == 4) { const int t = __builtin_amdgcn_update_dpp(0, x, 0x1B, 0xF, 0xF, true); return __int_as_float(__builtin_amdgcn_update_dpp(0, t, 0x141, 0xF, 0xF, true)); }
    else if constexpr (O == 8) return __int_as_float(__builtin_amdgcn_update_dpp(0, x, 0x128, 0xF, 0xF, true));
    else { const unsigned lane_ = __builtin_amdgcn_mbcnt_hi(~0u, __builtin_amdgcn_mbcnt_lo(~0u, 0u));
        if constexpr (O == 16) { const auto r = __builtin_amdgcn_permlane16_swap((unsigned)x, (unsigned)x, false, false); return __int_as_float((int)((lane_ & 16u) ? r[0] : r[1])); }
        else { static_assert(O == 32, "shx: power-of-two offsets below 64"); const auto r = __builtin_amdgcn_permlane32_swap((unsigned)x, (unsigned)x, false, false); return __int_as_float((int)((lane_ & 32u) ? r[0] : r[1])); } }
}
__device__ __forceinline__ float wave_sum_dpp(float x) {
    x += __int_as_float(__builtin_amdgcn_update_dpp(0, __float_as_int(x), 0xB1, 0xF, 0xF, true));
    x += __int_as_float(__builtin_amdgcn_update_dpp(0, __float_as_int(x), 0x4E, 0xF, 0xF, true));
    x += __int_as_float(__builtin_amdgcn_update_dpp(0, __float_as_int(x), 0x141, 0xF, 0xF, true));
    x += __int_as_float(__builtin_amdgcn_update_dpp(0, __float_as_int(x), 0x140, 0xF, 0xF, true));
    const int xi = __float_as_int(x);
    return __int_as_float(__builtin_amdgcn_readlane(xi, 0)) + __int_as_float(__builtin_amdgcn_readlane(xi, 16)) + __int_as_float(__builtin_amdgcn_readlane(xi, 32)) + __int_as_float(__builtin_amdgcn_readlane(xi, 48));
}
__device__ __forceinline__ float wave_sum(float v) { return wave_sum_dpp(v); }
__device__ __forceinline__ float wave_max(float v) { v = fmaxf(v, shx<1>(v)); v = fmaxf(v, shx<2>(v)); v = fmaxf(v, shx<4>(v)); v = fmaxf(v, shx<8>(v)); v = fmaxf(v, shx<16>(v)); return fmaxf(v, shx<32>(v)); }
__device__ __forceinline__ float sigmoidf_(float x) { return 1.0f / (1.0f + __expf(-x)); }
__device__ __forceinline__ float siluf_(float x) { return x * __builtin_amdgcn_rcpf(1.0f + __expf(-x)); }
__device__ __forceinline__ float gelu_tanh(float x) { const float u = 0.7978845608028654f * (x + 0.044715f * x * x * x); const float e = __expf(-2.0f * fabsf(u)); const float t = (1.0f - e) * __builtin_amdgcn_rcpf(1.0f + e); return 0.5f * x * (1.0f + (u < 0.f ? -t : t)); }
__device__ __forceinline__ float logsigmoidf_(float x) { return fminf(x, 0.f) - __logf(1.0f + __expf(-fabsf(x))); }
__device__ __forceinline__ s16x4 tr_read(unsigned lds_addr) { s16x4 r; asm volatile("ds_read_b64_tr_b16 %0, %1\n\ts_waitcnt lgkmcnt(0)" : "=&v"(r) : "v"(lds_addr) : "memory"); return r; }
__device__ __forceinline__ bf16x8 tr_read2(unsigned a0, unsigned a1) { s16x4 r0, r1; asm volatile("ds_read_b64_tr_b16 %0, %2\n\tds_read_b64_tr_b16 %1, %3\n\ts_waitcnt lgkmcnt(0)" : "=&v"(r0), "=&v"(r1) : "v"(a0), "v"(a1) : "memory");
    bf16x8 o; o[0] = r0[0]; o[1] = r0[1]; o[2] = r0[2]; o[3] = r0[3]; o[4] = r1[0]; o[5] = r1[1]; o[6] = r1[2]; o[7] = r1[3]; return o; }
__device__ __forceinline__ unsigned lds_addr_of(const LAS void* p) { return (unsigned)(uintptr_t)p; }
#define MFMA16(a, b, c) __builtin_amdgcn_mfma_f32_16x16x32_bf16((a), (b), (c), 0, 0, 0)
namespace pg8 {
#define PG8_LAS __attribute__((address_space(3)))
constexpr int BM = 256, BK = 64, HALF = 128, HTB = HALF * BK * 2  , STAGE_BYTES = 8 * HTB, NXCD = 8, WGM = 8;

__host__ __device__ __forceinline__ int lds_byte(int r, int c) { const int st = (r >> 4) * 2 + (c >> 5), rr = r & 15, cc = c & 31, ob = rr * 64 + cc * 2; return st * 1024 + (ob ^ (((ob >> 9) & 1) << 5)); }
__host__ __device__ __forceinline__ void stage_rc(int b, int& R, int& C) { const int st = b / 1024, sb = b % 1024, swz = sb ^ (((sb >> 9) & 1) << 5); R = (st >> 1) * 16 + swz / 64; C = (st & 1) * 32 + (swz % 64) / 2; }
__host__ __device__ __forceinline__ int perm32(int rho) { const int n = rho >> 4, i = rho & 15; return 8 * (i >> 2) + 4 * n + (i & 3); }

struct Unit { int pm, pn, pb, e, fl; };
struct Gemm { const bf16_t* A; const bf16_t* Bt; int M, N, K; };

struct StaticOrder {
    int nM, nN, nwg, G, c;
    __host__ __device__ void init(int M, int N, int G_, int c_) { nM = M / BM; nN = N / BM; nwg = nM * nN; G = G_; c = c_; }
    __host__ __device__ bool next(int i, Unit& u) const {
        const long L = (long)i * G + c; if (L >= nwg) return false;
        int wgid = (int)L; { const int q = nwg / NXCD, r = nwg % NXCD, xcd = wgid % NXCD, off = wgid / NXCD; wgid = (xcd < r ? xcd * (q + 1) : r * (q + 1) + (xcd - r) * q) + off; }
        const int nig = WGM * nN, gid = wgid / nig, fm = gid * WGM, gsz = (nM - fm) < WGM ? (nM - fm) : WGM;
        u.pm = fm + ((wgid % nig) % gsz); u.pn = (wgid % nig) / gsz; u.pb = u.pn; u.e = 0; u.fl = 0; return true;
    }
    __device__ __forceinline__ void a_ready(const Unit&) const {}
    __device__ __forceinline__ void done(const Unit&) const {}
    __device__ __forceinline__ void after_unit(int, int) const {}
    __device__ __forceinline__ void finish(int, int) const {}
};
template <class Epi, class Sched, int AGRP = 0  >
__device__ __forceinline__ void gemm_phase(PG8_LAS unsigned char* lds, const Gemm g, const Sched& S, const Epi& E, const int tid) {
    const int wid = __builtin_amdgcn_readfirstlane(tid >> 6), lane = tid & 63, wr = wid >> 2, wc = wid & 3, fr = lane & 15, fq = lane >> 4;
    const int K = g.K, nt = K / BK;
    unsigned voffA[2], voffB[2];
#pragma unroll
    for (int i = 0; i < 2; ++i) { int R, C; stage_rc(tid * 16 + i * 8192, R, C); const int Rb = Epi::PERM ? ((R & ~31) + perm32(R & 31)) : R;
        voffA[i] = AGRP ? (unsigned)((C >> 4) * AGRP * 16 + R * 16 + (C & 15)) * 2u : (unsigned)(R * K + C) * 2u; voffB[i] = (unsigned)(Rb * K + C) * 2u; }
    const size_t kstepB = (size_t)(BK * 2), hstepB = (size_t)HALF * K * 2, tstepB = 2 * hstepB;
    const size_t kstepA = AGRP ? (size_t)4 * AGRP * 32 : kstepB, hstepA = AGRP ? (size_t)HALF * 32 : hstepB, tstepA = 2 * hstepA;
    const unsigned ldsw = (unsigned)wid * 1024u;
    const int aoff = lds_byte(wr * 64 + fr, fq * 8), boff = lds_byte(wc * 32 + fr, fq * 8);
#define PG8_SA(b, h) (((b) * 2 + (h)) * HTB)
#define PG8_SB(b, h) ((4 + (b) * 2 + (h)) * HTB)
#define PG8_STAGE(bufoff, gbase, voff) do { _Pragma("unroll") for (int _i = 0; _i < 2; ++_i) \
        __builtin_amdgcn_global_load_lds((const unsigned*)((const char*)(gbase) + (voff)[_i]), (PG8_LAS unsigned*)(lds + (bufoff) + ldsw + _i * 8192), 16, 0, 0); } while (0)
#define PG8_LDA(dst, b, h) do { _Pragma("unroll") for (int m = 0; m < 4; ++m) _Pragma("unroll") for (int k = 0; k < 2; ++k) dst[m][k] = *(const PG8_LAS bf16x8*)(lds + PG8_SA(b, h) + aoff + m * 2048 + k * 1024); } while (0)
#define PG8_LDB(dst, b, h) do { _Pragma("unroll") for (int n = 0; n < 2; ++n) _Pragma("unroll") for (int k = 0; k < 2; ++k) dst[n][k] = *(const PG8_LAS bf16x8*)(lds + PG8_SB(b, h) + boff + n * 2048 + k * 1024); } while (0)
#define PG8_MMA(ai, bj, At, Bt) do { __builtin_amdgcn_s_setprio(1); _Pragma("unroll") for (int m = 0; m < 4; ++m) _Pragma("unroll") for (int n = 0; n < 2; ++n) _Pragma("unroll") for (int k = 0; k < 2; ++k) \
        acc[ai][bj][m][n] = __builtin_amdgcn_mfma_f32_16x16x32_bf16(Bt[n][k], At[m][k], acc[ai][bj][m][n], 0, 0, 0); __builtin_amdgcn_s_setprio(0); } while (0)
#define PG8_WAIT_V(n) asm volatile("s_waitcnt vmcnt(" #n ")" ::: "memory")
#define PG8_WAIT_L(n) asm volatile("s_waitcnt lgkmcnt(" #n ")" ::: "memory")
#define PG8_BAR __builtin_amdgcn_s_barrier()
#define PG8_SCHED __builtin_amdgcn_sched_barrier(0)
    Unit cur, nxt; int ui = 0;
#define PG8_UNI(u) do { (u).pm = __builtin_amdgcn_readfirstlane((u).pm); (u).pn = __builtin_amdgcn_readfirstlane((u).pn); (u).pb = __builtin_amdgcn_readfirstlane((u).pb); (u).e = __builtin_amdgcn_readfirstlane((u).e); (u).fl = __builtin_amdgcn_readfirstlane((u).fl); } while (0)
    if (!S.next(0, cur)) { S.finish(-1, tid); return; } PG8_UNI(cur);
    f32x4 acc[2][2][4][2];
#pragma unroll
    for (int a = 0; a < 2; ++a)
#pragma unroll
        for (int b = 0; b < 2; ++b)
#pragma unroll
            for (int m = 0; m < 4; ++m)
#pragma unroll
                for (int n = 0; n < 2; ++n) acc[a][b][m][n] = (f32x4){0.f, 0.f, 0.f, 0.f};
    bf16x8 At[4][2], B0[2][2], B1[2][2];
    const char* cA = (const char*)g.A + (size_t)cur.pm * tstepA; const char* cB = (const char*)g.Bt + (size_t)cur.pb * tstepB;
    S.a_ready(cur);
    PG8_STAGE(PG8_SB(0, 0), cB, voffB); PG8_STAGE(PG8_SA(0, 0), cA, voffA); PG8_STAGE(PG8_SB(0, 1), cB + hstepB, voffB); PG8_STAGE(PG8_SA(0, 1), cA + hstepA, voffA);
    if (wr == 1) PG8_BAR;
    PG8_WAIT_V(4); PG8_BAR;
    PG8_STAGE(PG8_SB(1, 0), cB + kstepB, voffB); PG8_STAGE(PG8_SA(1, 0), cA + kstepA, voffA); PG8_STAGE(PG8_SB(1, 1), cB + hstepB + kstepB, voffB);
    PG8_WAIT_V(6); PG8_BAR;
    for (;;) {
        const bool has_next = S.next(ui + 1, nxt); PG8_UNI(nxt);
        const char* nA = has_next ? (const char*)g.A + (size_t)nxt.pm * tstepA : cA; const char* nB = has_next ? (const char*)g.Bt + (size_t)nxt.pb * tstepB : cB;
        for (int t = 0; t < nt; t += 2) {
            const bool last = (t == nt - 2);
            const char* a1 = cA + (size_t)(t + 1) * kstepA;
            const char* a2 = last ? nA : cA + (size_t)(t + 2) * kstepA; const char* b2 = last ? nB : cB + (size_t)(t + 2) * kstepB;
            const char* a3 = a2 + kstepA; const char* b3 = b2 + kstepB;
            if (last && has_next) S.a_ready(nxt);
            PG8_LDB(B0, 0, 0); PG8_SCHED; PG8_LDA(At, 0, 0); PG8_STAGE(PG8_SA(1, 1), a1 + hstepA, voffA);
            PG8_WAIT_L(8); PG8_BAR; PG8_WAIT_L(0); PG8_MMA(0, 0, At, B0); PG8_BAR; PG8_SCHED;
            PG8_LDB(B1, 0, 1); PG8_STAGE(PG8_SB(0, 0), b2, voffB);
            PG8_BAR; PG8_WAIT_L(0); PG8_MMA(0, 1, At, B1); PG8_BAR;
            PG8_LDA(At, 0, 1); PG8_STAGE(PG8_SA(0, 0), a2, voffA);
            PG8_BAR; PG8_WAIT_L(0); PG8_MMA(1, 0, At, B0); PG8_BAR; PG8_SCHED;
            PG8_STAGE(PG8_SB(0, 1), b2 + hstepB, voffB);
            PG8_WAIT_V(6); PG8_BAR; PG8_MMA(1, 1, At, B1); PG8_BAR;
            PG8_LDB(B0, 1, 0); PG8_SCHED; PG8_LDA(At, 1, 0); PG8_STAGE(PG8_SA(0, 1), a2 + hstepA, voffA);
            PG8_WAIT_L(8); PG8_BAR; PG8_WAIT_L(0); PG8_MMA(0, 0, At, B0); PG8_BAR; PG8_SCHED;
            PG8_LDB(B1, 1, 1); PG8_STAGE(PG8_SB(1, 0), b3, voffB);
            PG8_BAR; PG8_WAIT_L(0); PG8_MMA(0, 1, At, B1); PG8_BAR;
            PG8_LDA(At, 1, 1); PG8_STAGE(PG8_SA(1, 0), a3, voffA);
            PG8_BAR; PG8_WAIT_L(0); PG8_MMA(1, 0, At, B0); PG8_BAR; PG8_SCHED;
            PG8_STAGE(PG8_SB(1, 1), b3 + hstepB, voffB);
            PG8_WAIT_V(6); PG8_BAR; PG8_MMA(1, 1, At, B1); PG8_BAR;
        }
        if constexpr (!Epi::AFTER_DRAIN) { for (int r_ = 0; r_ < (PROBE_SUB == 9 ? 2 : 1); ++r_) E(acc, cur, wr, wc, fr, fq); S.done(cur); S.after_unit(ui, tid); }
        if (!has_next) break;
#pragma unroll
        for (int a = 0; a < 2; ++a)
#pragma unroll
            for (int b = 0; b < 2; ++b)
#pragma unroll
                for (int m = 0; m < 4; ++m)
#pragma unroll
                    for (int n = 0; n < 2; ++n) acc[a][b][m][n] = (f32x4){0.f, 0.f, 0.f, 0.f};
        cur = nxt; cA = nA; cB = nB; ++ui;
    }
    S.finish(ui, tid);
    PG8_WAIT_V(0);
    if (wr == 0) PG8_BAR;
    PG8_BAR;
    if constexpr (Epi::AFTER_DRAIN) { E.fused(acc, cur, wr, wc, fr, fq, lds, wid, lane); S.done(cur); }
#undef PG8_SA
#undef PG8_SB
#undef PG8_STAGE
#undef PG8_LDA
#undef PG8_LDB
#undef PG8_MMA
#undef PG8_WAIT_V
#undef PG8_WAIT_L
#undef PG8_BAR
#undef PG8_SCHED
#undef PG8_UNI
}
template <class Epi>
__device__ __forceinline__ void gemm_quarter(PG8_LAS unsigned char* lds, const Gemm g, const int pm, const int pn, const int mh, const int nh, const Epi& E, const int tid) {
    const int wid = __builtin_amdgcn_readfirstlane(tid >> 6), lane = tid & 63, wr = wid >> 2, wc = wid & 3, fr = lane & 15, fq = lane >> 4;
    const int K = g.K, nt = K / BK;
    unsigned voffA[2], voffB[2];
#pragma unroll
    for (int i = 0; i < 2; ++i) { int R, C; stage_rc(tid * 16 + i * 8192, R, C); const int Rb = Epi::PERM ? ((R & ~31) + perm32(R & 31)) : R; voffA[i] = (unsigned)(R * K + C) * 2u; voffB[i] = (unsigned)(Rb * K + C) * 2u; }
    const char* cA = (const char*)g.A + ((size_t)pm * BM + (size_t)mh * HALF) * K * 2; const char* cB = (const char*)g.Bt + ((size_t)pn * BM + (size_t)nh * HALF) * K * 2;
    const unsigned ldsw = (unsigned)wid * 1024u;
    const int aoff = lds_byte(wr * 64 + fr, fq * 8), boff = lds_byte(wc * 32 + fr, fq * 8);
#define PQ_SA(b) (((b) * 2) * HTB)
#define PQ_SB(b) ((4 + (b) * 2) * HTB)
#define PQ_STAGE(bufoff, gbase, voff) do { _Pragma("unroll") for (int _i = 0; _i < 2; ++_i) \
        __builtin_amdgcn_global_load_lds((const unsigned*)((const char*)(gbase) + (voff)[_i]), (PG8_LAS unsigned*)(lds + (bufoff) + ldsw + _i * 8192), 16, 0, 0); } while (0)
    f32x4 acc[2][2][4][2];
#pragma unroll
    for (int a = 0; a < 2; ++a)
#pragma unroll
        for (int b = 0; b < 2; ++b)
#pragma unroll
            for (int m = 0; m < 4; ++m)
#pragma unroll
                for (int n = 0; n < 2; ++n) acc[a][b][m][n] = (f32x4){0.f, 0.f, 0.f, 0.f};
    PQ_STAGE(PQ_SA(0), cA, voffA); PQ_STAGE(PQ_SB(0), cB, voffB);
    for (int t = 0; t < nt; ++t) { const int b = t & 1;
        if (t + 1 < nt) { PQ_STAGE(PQ_SA(b ^ 1), cA + (size_t)(t + 1) * (BK * 2), voffA); PQ_STAGE(PQ_SB(b ^ 1), cB + (size_t)(t + 1) * (BK * 2), voffB); asm volatile("s_waitcnt vmcnt(4)" ::: "memory"); }
        else asm volatile("s_waitcnt vmcnt(0)" ::: "memory");
        __builtin_amdgcn_s_barrier();
        bf16x8 At[4][2], B0[2][2];
#pragma unroll
        for (int m = 0; m < 4; ++m)
#pragma unroll
            for (int k = 0; k < 2; ++k) At[m][k] = *(const PG8_LAS bf16x8*)(lds + (b ? PQ_SA(1) : PQ_SA(0)) + aoff + m * 2048 + k * 1024);
#pragma unroll
        for (int n = 0; n < 2; ++n)
#pragma unroll
            for (int k = 0; k < 2; ++k) B0[n][k] = *(const PG8_LAS bf16x8*)(lds + (b ? PQ_SB(1) : PQ_SB(0)) + boff + n * 2048 + k * 1024);
        asm volatile("s_waitcnt lgkmcnt(0)" ::: "memory");
#pragma unroll
        for (int m = 0; m < 4; ++m)
#pragma unroll
            for (int n = 0; n < 2; ++n)
#pragma unroll
                for (int k = 0; k < 2; ++k) acc[0][0][m][n] = __builtin_amdgcn_mfma_f32_16x16x32_bf16(B0[n][k], At[m][k], acc[0][0][m][n], 0, 0, 0);
        __builtin_amdgcn_s_barrier();
    }
    Unit u; u.pm = pm; u.pn = pn; u.pb = pn; u.e = 0; u.fl = 1 | 2 | (mh ? 8 : 0) | (nh ? 16 : 0);
    E(acc, u, wr, wc, fr, fq);
#undef PQ_SA
#undef PQ_SB
#undef PQ_STAGE
}
}
namespace pg8 {
struct GemmF { const bf16_t* A; const float* Bf0; const float* Bf1; size_t estride; int ncstep; int ldb; int K; bf16_t* img; const unsigned* vt = nullptr; };
__device__ __forceinline__ int g8swz(int k) { return (k & 1) | (((k >> 1) & 1) << 3) | (((k >> 3) & 1) << 4); }
template <class Epi, class Sched, int VAR = 0, bool IMG = false, bool GATH = false  >
__device__ __forceinline__ void gemm_phase_fb(PG8_LAS unsigned char* lds, const GemmF g, const Sched& S, const Epi& E, const int tid) {
    static_assert(Epi::PERM && !Epi::AFTER_DRAIN, "f32-B body: 2-byte-output epilogues only");
    const int wid = __builtin_amdgcn_readfirstlane(tid >> 6), lane = tid & 63, wr = wid >> 2, wc = wid & 3, fr = lane & 15, fq = lane >> 4;
    const int K = g.K, nt = K / BK;
    unsigned voffA0; { int R, C; stage_rc(tid * 16, R, C); voffA0 = (unsigned)(R * K + C) * 2u; }
    const unsigned kstepA = (unsigned)(BK * 2), hstepA = (unsigned)HALF * K * 2, tstepA = 2 * hstepA;
    const unsigned kstepB = (unsigned)BK * (unsigned)g.ldb * 4u;
    const unsigned ldsw = (unsigned)wid * 1024u;
    const int aoff = lds_byte(wr * 64 + fr, fq * 8);
    const int kr = tid >> 5, c4 = tid & 31;
    const unsigned voffBf = (unsigned)(kr * g.ldb + c4 * 4) * 4u; const unsigned jstepB = 16u * (unsigned)g.ldb * 4u;
    u32x4 rs0, rs1;
    { const unsigned long long p0 = (unsigned long long)(uintptr_t)g.Bf0, p1 = (unsigned long long)(uintptr_t)g.Bf1;
      rs0.x = __builtin_amdgcn_readfirstlane((unsigned)p0); rs0.y = __builtin_amdgcn_readfirstlane((unsigned)(p0 >> 32) & 0xffffu); rs0.z = 0x7fffffffu; rs0.w = 0x00020000u;
      rs1.x = __builtin_amdgcn_readfirstlane((unsigned)p1); rs1.y = __builtin_amdgcn_readfirstlane((unsigned)(p1 >> 32) & 0xffffu); rs1.z = 0x7fffffffu; rs1.w = 0x00020000u; }
    const __amdgpu_buffer_rsrc_t rsA = __builtin_amdgcn_make_buffer_rsrc((void*)g.A, 0, 0x7fffffff, 0x00020000);
    const __amdgpu_buffer_rsrc_t rsI = __builtin_amdgcn_make_buffer_rsrc((void*)g.img, 0, 0x7fffffff, 0x00020000);
    const unsigned istepI = (unsigned)(K / BK) * 32768u;
    const unsigned woffB = (unsigned)(kr * 256 + 8 * (c4 ^ g8swz(kr)));
    u32x2 vt = {0u, 0u}, vn = {0u, 0u}; unsigned c2 = 0; u32x4 rsV = {0u, 0u, 0u, 0u};
    if constexpr (GATH) { int R, C; stage_rc(tid * 16, R, C); c2 = (unsigned)C * 2u; const unsigned long long pv = (unsigned long long)(uintptr_t)g.vt;
        rsV.x = __builtin_amdgcn_readfirstlane((unsigned)pv); rsV.y = __builtin_amdgcn_readfirstlane((unsigned)(pv >> 32) & 0xffffu); rsV.z = 0x7fffffffu; rsV.w = 0x00020000u; }
    const unsigned lds0 = (unsigned)(uintptr_t)lds;
    unsigned btb0; { const int q = fr >> 2, p = fr & 3, krow = 8 * fq + q; btb0 = lds0 + (unsigned)(krow * 256 + 8 * ((8 * wc + 2 * p) ^ g8swz(krow))); }
#define PG8_SA(b, h) (((b) * 2 + (h)) * HTB)
#define PG8_SB(b, h) ((4 + (b) * 2 + (h)) * HTB)
#define PG8_STAGEA(b, h, base) do { if constexpr (GATH) { const unsigned _p = (h) ? vt.y : vt.x; \
        __builtin_amdgcn_raw_ptr_buffer_load_lds(rsA, (PG8_LAS void*)(lds + PG8_SA(b, h) + ldsw), 16, ((_p & 0xffffu) << 12) + c2, (base), 0, 0); \
        __builtin_amdgcn_raw_ptr_buffer_load_lds(rsA, (PG8_LAS void*)(lds + PG8_SA(b, h) + ldsw + 8192), 16, ((_p >> 16) << 12) + c2, (base), 0, 0); } else { _Pragma("unroll") for (int _i = 0; _i < 2; ++_i) \
        __builtin_amdgcn_raw_ptr_buffer_load_lds(rsA, (PG8_LAS void*)(lds + PG8_SA(b, h) + ldsw + _i * 8192), 16, voffA0, (base) + (unsigned)(h) * hstepA + (unsigned)_i * 128u * (unsigned)K, 0, 0); } } while (0)
#define PG8_BISSUE(R, rs, soff) do { if constexpr (VAR == 2 || VAR == 3 || VAR == 4) break; _Pragma("unroll") for (int _j = 0; _j < 4; ++_j) { const unsigned _so = (VAR == 5) ? (unsigned)__builtin_amdgcn_readfirstlane(_j * jstepB) : (unsigned)__builtin_amdgcn_readfirstlane((soff) + _j * jstepB); \
        asm volatile("buffer_load_dwordx4 %0, %1, %2, %3 offen" : "=v"(R[_j]) : "v"(voffBf), "s"(rs), "s"(_so) : "memory"); } } while (0)
#define PG8_RPIN(R) asm volatile("" : "+v"(R[0]), "+v"(R[1]), "+v"(R[2]), "+v"(R[3]))
#define PG8_BCOMMIT(R, bufoff, imgoff) do { if constexpr (VAR == 1 || VAR == 3 || VAR == 4) break; _Pragma("unroll") for (int _j = 0; _j < 4; ++_j) { u32x2 _w; _w.x = cvt_pk_bf16(R[_j][0], R[_j][1]); _w.y = cvt_pk_bf16(R[_j][2], R[_j][3]); \
        *(PG8_LAS u32x2*)(lds + (bufoff) + woffB + _j * 4096) = _w; \
        if constexpr (IMG) __builtin_amdgcn_raw_buffer_store_b64(_w, rsI, woffB, (unsigned)__builtin_amdgcn_readfirstlane((int)((imgoff) + _j * 4096)), 0); } } while (0)
#define PG8_WAIT_VC() do { if constexpr (IMG) asm volatile("s_waitcnt vmcnt(10)" ::: "memory"); else asm volatile("s_waitcnt vmcnt(6)" ::: "memory"); } while (0)
#define PG8_LDA(dst, b, h) do { _Pragma("unroll") for (int m = 0; m < 4; ++m) _Pragma("unroll") for (int k = 0; k < 2; ++k) dst[m][k] = *(const PG8_LAS bf16x8*)(lds + PG8_SA(b, h) + aoff + m * 2048 + k * 1024); } while (0)
#define PG8_LDBT(dst, b, h) do { if constexpr (VAR == 4) break; const unsigned _a0 = btb0 + PG8_SB(b, h), _a1 = (btb0 ^ 8u) + PG8_SB(b, h); s16x4 _r0, _r1, _r2, _r3, _r4, _r5, _r6, _r7; \
        asm volatile("ds_read_b64_tr_b16 %0, %8\n\tds_read_b64_tr_b16 %1, %8 offset:1024\n\tds_read_b64_tr_b16 %2, %8 offset:8192\n\tds_read_b64_tr_b16 %3, %8 offset:9216\n\t" \
                     "ds_read_b64_tr_b16 %4, %9\n\tds_read_b64_tr_b16 %5, %9 offset:1024\n\tds_read_b64_tr_b16 %6, %9 offset:8192\n\tds_read_b64_tr_b16 %7, %9 offset:9216" \
                     : "=&v"(_r0), "=&v"(_r1), "=&v"(_r2), "=&v"(_r3), "=&v"(_r4), "=&v"(_r5), "=&v"(_r6), "=&v"(_r7) : "v"(_a0), "v"(_a1) : "memory"); \
        dst[0][0] = (bf16x8){_r0[0], _r0[1], _r0[2], _r0[3], _r1[0], _r1[1], _r1[2], _r1[3]}; dst[0][1] = (bf16x8){_r2[0], _r2[1], _r2[2], _r2[3], _r3[0], _r3[1], _r3[2], _r3[3]}; \
        dst[1][0] = (bf16x8){_r4[0], _r4[1], _r4[2], _r4[3], _r5[0], _r5[1], _r5[2], _r5[3]}; dst[1][1] = (bf16x8){_r6[0], _r6[1], _r6[2], _r6[3], _r7[0], _r7[1], _r7[2], _r7[3]}; } while (0)
#define PG8_BPIN(Bt) asm volatile("" : "+v"(Bt[0][0]), "+v"(Bt[0][1]), "+v"(Bt[1][0]), "+v"(Bt[1][1]))
#define PG8_MMA(ai, bj, At, Bt) do { __builtin_amdgcn_s_setprio(1); _Pragma("unroll") for (int m = 0; m < 4; ++m) _Pragma("unroll") for (int n = 0; n < 2; ++n) _Pragma("unroll") for (int k = 0; k < 2; ++k) \
        acc[ai][bj][m][n] = __builtin_amdgcn_mfma_f32_16x16x32_bf16(Bt[n][k], At[m][k], acc[ai][bj][m][n], 0, 0, 0); __builtin_amdgcn_s_setprio(0); } while (0)
#define PG8_WAIT_V(n) asm volatile("s_waitcnt vmcnt(" #n ")" ::: "memory")
#define PG8_WAIT_L(n) asm volatile("s_waitcnt lgkmcnt(" #n ")" ::: "memory")
#define PG8_BAR __builtin_amdgcn_s_barrier()
#define PG8_SCHED __builtin_amdgcn_sched_barrier(0)
#define PG8_BOFF(u) ((unsigned)__builtin_amdgcn_readfirstlane((int)(((size_t)(u).e * g.estride + (size_t)(u).pn * g.ncstep) * 4)))
    Unit cur, nxt; int ui = 0;
#define PG8_UNI(u) do { (u).pm = __builtin_amdgcn_readfirstlane((u).pm); (u).pn = __builtin_amdgcn_readfirstlane((u).pn); (u).pb = __builtin_amdgcn_readfirstlane((u).pb); (u).e = __builtin_amdgcn_readfirstlane((u).e); (u).fl = __builtin_amdgcn_readfirstlane((u).fl); } while (0)
    if (!S.next(0, cur)) { S.finish(-1, tid); return; } PG8_UNI(cur);
    f32x4 acc[2][2][4][2];
#pragma unroll
    for (int a = 0; a < 2; ++a)
#pragma unroll
        for (int b = 0; b < 2; ++b)
#pragma unroll
            for (int m = 0; m < 4; ++m)
#pragma unroll
                for (int n = 0; n < 2; ++n) acc[a][b][m][n] = (f32x4){0.f, 0.f, 0.f, 0.f};
    bf16x8 At[4][2], B0[2][2], B1[2][2];
    f32x4 bp[4], bq[4];
    unsigned cA = GATH ? 0u : (unsigned)cur.pm * tstepA, cB = PG8_BOFF(cur), cI = (unsigned)cur.pb * istepI;
    if constexpr (GATH) { vt = *(const u32x2*)((const char*)g.vt + (size_t)cur.pm * 4096 + woffB); vn = vt; }
    S.a_ready(cur);
    PG8_BISSUE(bq, rs0, cB); PG8_STAGEA(0, 0, cA); PG8_BISSUE(bp, rs1, cB); PG8_STAGEA(0, 1, cA);
    if (wr == 1) PG8_BAR;
    PG8_WAIT_V(6); PG8_RPIN(bq); PG8_BCOMMIT(bq, PG8_SB(0, 0), cI); PG8_WAIT_L(0); PG8_BAR;
    PG8_BISSUE(bq, rs0, cB + kstepB); PG8_STAGEA(1, 0, cA + kstepA);
    PG8_WAIT_VC(); PG8_RPIN(bp); PG8_BCOMMIT(bp, PG8_SB(0, 1), cI + 16384u);
    PG8_BISSUE(bp, rs1, cB + kstepB);
    PG8_WAIT_VC(); PG8_RPIN(bq); PG8_BCOMMIT(bq, PG8_SB(1, 0), cI + 32768u);
    PG8_BISSUE(bq, rs0, cB + 2 * kstepB);
    PG8_WAIT_L(0); PG8_BAR;
    for (;;) {
        const bool has_next = S.next(ui + 1, nxt); PG8_UNI(nxt);
        const unsigned nA = GATH ? 0u : (has_next ? (unsigned)nxt.pm * tstepA : cA);
        const unsigned nV = (unsigned)__builtin_amdgcn_readfirstlane((has_next ? nxt.pm : cur.pm) * 4096);
        const unsigned nB = has_next ? PG8_BOFF(nxt) : cB; const unsigned nI = has_next ? (unsigned)nxt.pb * istepI : cI;
        for (int t = 0; t < nt; t += 2) {
            const bool last = (t == nt - 2);
            const unsigned a1 = cA + (unsigned)(t + 1) * kstepA, a2 = last ? nA : cA + (unsigned)(t + 2) * kstepA, a3 = a2 + kstepA;
            const unsigned b2 = last ? nB : cB + (unsigned)(t + 2) * kstepB, b3 = b2 + kstepB;
            const unsigned i2 = last ? nI : cI + (unsigned)(t + 2) * 32768u, i3 = i2 + 32768u;
            const unsigned b4 = (t + 4 < nt) ? cB + (unsigned)(t + 4) * kstepB : nB + (unsigned)(t + 4 - nt) * kstepB;
            if (last && has_next) S.a_ready(nxt);
            PG8_LDBT(B0, 0, 0); PG8_SCHED; PG8_LDA(At, 0, 0); PG8_STAGEA(1, 1, a1); if constexpr (GATH) { vt.x = last ? vn.x : vt.x; vt.y = last ? vn.y : vt.y; }
            PG8_WAIT_L(8); PG8_BAR; PG8_WAIT_L(0); PG8_BPIN(B0); PG8_MMA(0, 0, At, B0); PG8_BAR; PG8_SCHED;
            PG8_LDBT(B1, 0, 1); PG8_WAIT_VC(); PG8_RPIN(bp); if constexpr (GATH) asm volatile("buffer_load_dwordx2 %0, %1, %2, %3 offen" : "=v"(vn) : "v"(woffB), "s"(rsV), "s"(nV) : "memory");
            PG8_BCOMMIT(bp, PG8_SB(1, 1), cI + (unsigned)(t + 1) * 32768u + 16384u); PG8_BISSUE(bp, rs1, b2);
            PG8_BAR; PG8_WAIT_L(0); PG8_BPIN(B1); PG8_MMA(0, 1, At, B1); PG8_BAR;
            PG8_LDA(At, 0, 1); PG8_STAGEA(0, 0, a2);
            PG8_BAR; PG8_WAIT_L(0); PG8_MMA(1, 0, At, B0); PG8_BAR; PG8_SCHED;
            PG8_WAIT_VC(); PG8_RPIN(bq); PG8_BCOMMIT(bq, PG8_SB(0, 0), i2); PG8_BISSUE(bq, rs0, b3);
            PG8_BAR; PG8_MMA(1, 1, At, B1); PG8_BAR;
            PG8_LDBT(B0, 1, 0); PG8_SCHED; PG8_LDA(At, 1, 0); PG8_STAGEA(0, 1, a2);
            PG8_WAIT_L(8); PG8_BAR; PG8_WAIT_L(0); PG8_BPIN(B0); PG8_MMA(0, 0, At, B0); PG8_BAR; PG8_SCHED;
            PG8_LDBT(B1, 1, 1); PG8_WAIT_VC(); PG8_RPIN(bp); PG8_BCOMMIT(bp, PG8_SB(0, 1), i2 + 16384u); PG8_BISSUE(bp, rs1, b3);
            PG8_BAR; PG8_WAIT_L(0); PG8_BPIN(B1); PG8_MMA(0, 1, At, B1); PG8_BAR;
            PG8_LDA(At, 1, 1); PG8_STAGEA(1, 0, a3);
            PG8_BAR; PG8_WAIT_L(0); PG8_MMA(1, 0, At, B0); PG8_BAR; PG8_SCHED;
            PG8_WAIT_VC(); PG8_RPIN(bq); PG8_BCOMMIT(bq, PG8_SB(1, 0), i3); PG8_BISSUE(bq, rs0, b4);
            PG8_BAR; PG8_MMA(1, 1, At, B1); PG8_BAR;
        }
        int ln_; asm volatile("v_mbcnt_lo_u32_b32 %0, -1, 0\n\tv_mbcnt_hi_u32_b32 %0, -1, %0" : "=v"(ln_));
        { int fr_ = ln_ & 15, fq_ = ln_ >> 4;
          for (int r_ = 0; r_ < (PROBE_SUB == 8 ? 2 : 1); ++r_) E(acc, cur, wr, wc, fr_, fq_); }
        S.done(cur);
        if (!has_next) break;
#pragma unroll
        for (int a = 0; a < 2; ++a)
#pragma unroll
            for (int b = 0; b < 2; ++b)
#pragma unroll
                for (int m = 0; m < 4; ++m)
#pragma unroll
                    for (int n = 0; n < 2; ++n) acc[a][b][m][n] = (f32x4){0.f, 0.f, 0.f, 0.f};
        cur = nxt; cA = nA; cB = nB; cI = nI; ++ui;
    }
    PG8_WAIT_V(0); PG8_WAIT_L(0);
    asm volatile("" :: "v"(bp[0]), "v"(bp[1]), "v"(bp[2]), "v"(bp[3]), "v"(bq[0]), "v"(bq[1]), "v"(bq[2]), "v"(bq[3]));
    if (wr == 0) PG8_BAR;
    PG8_BAR;
#undef PG8_SA
#undef PG8_SB
#undef PG8_STAGEA
#undef PG8_BISSUE
#undef PG8_BCOMMIT
#undef PG8_RPIN
#undef PG8_WAIT_VC
#undef PG8_LDA
#undef PG8_LDBT
#undef PG8_BPIN
#undef PG8_MMA
#undef PG8_WAIT_V
#undef PG8_WAIT_L
#undef PG8_BAR
#undef PG8_SCHED
#undef PG8_UNI
#undef PG8_BOFF
}
}
namespace pg8 {
struct GroupedOrder {
    int nE, nMt, nNt, ERT, G, c, mt0;
    __device__ __forceinline__ bool next(int i, Unit& u) const {
        const int nwg = nE * nMt * nNt; const long L = (long)i * G + c; if (L >= nwg) return false;
        int wgid = (int)L; { const int q = nwg / NXCD, r = nwg % NXCD, xcd = wgid % NXCD, off = wgid / NXCD; wgid = (xcd < r ? xcd * (q + 1) : r * (q + 1) + (xcd - r) * q) + off; }
        const int per = nMt * nNt, e = wgid / per, rem = wgid % per, mt = rem % nMt, nt = rem / nMt;
        u.e = e; u.pm = e * ERT + mt0 + mt; u.pn = nt; u.pb = e * nNt + nt; u.fl = 0; return true;
    }
    __device__ __forceinline__ void a_ready(const Unit&) const {}
    __device__ __forceinline__ void done(const Unit&) const {}
    __device__ __forceinline__ void after_unit(int, int) const {}
    __device__ __forceinline__ void finish(int, int) const {}
};
struct OutOrder0 {
    StaticOrder S0; int G, c, split;
    __device__ __forceinline__ bool next(int i, Unit& u) const {
        const long L = (long)i * G + c; if (!split || L < 512) return S0.next(i, u);
        const int h = (int)L - 512; if (h >= 64) return false;
        u.pm = 64 + (h >> 4); u.pn = (h >> 1) & 7; u.pb = u.pn; u.e = 0; u.fl = (h & 1) ? 4 : 2; return true;
    }
    __device__ __forceinline__ void a_ready(const Unit&) const {}
    __device__ __forceinline__ void done(const Unit&) const {}
    __device__ __forceinline__ void after_unit(int, int) const {}
    __device__ __forceinline__ void finish(int, int) const {}
};

__device__ __forceinline__ int g8swz_(int k) { return (k & 1) | (((k >> 1) & 1) << 3) | (((k >> 3) & 1) << 4); }
struct ConvJob {
    const float* W0; const float* W1; size_t estride; int ncstep, ldb, nNt; bf16_t* img; int q0, q1, slot;
    __device__ __forceinline__ void run(int tid) const {
        const int kr = tid >> 5, c4 = tid & 31; const unsigned woff = (unsigned)(kr * 256 + 8 * (c4 ^ g8swz_(kr)));
        for (int q = q0; q < q1; q += 2) {
            f32x4 v[2][2][4];
#pragma unroll
            for (int u = 0; u < 2; ++u) { const int qq = (q + u < q1) ? q + u : q; const int pb = qq >> 5, kt = qq & 31, e = pb / nNt, nt = pb % nNt;
#pragma unroll
                for (int h = 0; h < 2; ++h) { const float* src = (h ? W1 : W0) + (size_t)e * estride + (size_t)nt * ncstep + (size_t)(kt * 64 + kr) * ldb + 4 * c4;
#pragma unroll
                    for (int j = 0; j < 4; ++j) v[u][h][j] = *(const f32x4*)(src + (size_t)(16 * j) * ldb); } }
#pragma unroll
            for (int u = 0; u < 2; ++u) { if (q + u >= q1) break; const int qq = q + u; const int pb = qq >> 5, kt = qq & 31;
                unsigned char* dst = (unsigned char*)img + (size_t)pb * 1048576 + (size_t)kt * 32768 + woff;
#pragma unroll
                for (int h = 0; h < 2; ++h)
#pragma unroll
                    for (int j = 0; j < 4; ++j) { u32x2 w; w.x = cvt_pk_bf16(v[u][h][j][0], v[u][h][j][1]); w.y = cvt_pk_bf16(v[u][h][j][2], v[u][h][j][3]); *(u32x2*)(dst + h * 16384 + j * 4096) = w; } }
        }
        asm volatile("s_waitcnt vmcnt(0)" ::: "memory");
    }
};
struct StaticOrderConv : StaticOrder { ConvJob job;
    __device__ __forceinline__ void after_unit(int ui, int tid) const { if (ui == job.slot) job.run(tid); }
    __device__ __forceinline__ void finish(int last, int tid) const { if (last < job.slot) job.run(tid); } };
struct GroupedOrderConv : GroupedOrder { ConvJob job;
    __device__ __forceinline__ void after_unit(int ui, int tid) const { if (ui == job.slot) job.run(tid); }
    __device__ __forceinline__ void finish(int last, int tid) const { if (last < job.slot) job.run(tid); } };
struct EpiProj {
    static constexpr bool PERM = true, AFTER_DRAIN = false;
    bf16_t* proj; bf16_t* su; const float* rope;
    __device__ __forceinline__ void operator()(const f32x4 (&acc)[2][2][4][2], const Unit& u, int wr, int wc, int fr, int fq) const {
        const int row0 = u.pm * BM + wr * 64 + fr; const int colt = u.pn * BM;
        const bool do_rope = (u.pn < 5) && (u.pm < 64);
        const bool is_su = (u.pn == 6) || (u.pn == 7);
#pragma unroll
        for (int ai = 0; ai < 2; ++ai)
#pragma unroll
            for (int m = 0; m < 4; ++m) {
                const int row = row0 + ai * HALF + m * 16;
#pragma unroll
                for (int bj = 0; bj < 2; ++bj) {
                    const int col = colt + bj * HALF + wc * 32 + 8 * fq;
                    f32x4 v0 = acc[ai][bj][m][0], v1 = acc[ai][bj][m][1];
                    if (do_rope) {
                        const int jj = col & 127, t = row & 4095; const int pos = (jj < 64) ? (t >> 6) : (t & 63); const int i0 = (jj & 63) >> 1;
                        const f32x4 cs0 = *(const f32x4*)(rope + (pos * 32 + i0) * 2), cs1 = *(const f32x4*)(rope + (pos * 32 + i0 + 2) * 2);
                        f32x4 o0, o1;
                        o0[0] = v0[0] * cs0[0] - v0[1] * cs0[1]; o0[1] = v0[1] * cs0[0] + v0[0] * cs0[1];
                        o0[2] = v0[2] * cs0[2] - v0[3] * cs0[3]; o0[3] = v0[3] * cs0[2] + v0[2] * cs0[3];
                        o1[0] = v1[0] * cs1[0] - v1[1] * cs1[1]; o1[1] = v1[1] * cs1[0] + v1[0] * cs1[1];
                        o1[2] = v1[2] * cs1[2] - v1[3] * cs1[3]; o1[3] = v1[3] * cs1[2] + v1[2] * cs1[3];
                        v0 = o0; v1 = o1;
                    }
                    u32x4 w; w.x = cvt_pk_bf16(v0[0], v0[1]); w.y = cvt_pk_bf16(v0[2], v0[3]); w.z = cvt_pk_bf16(v1[0], v1[1]); w.w = cvt_pk_bf16(v1[2], v1[3]);
                    if (is_su) { const int g = (col - C_SU) >> 4, h0 = col & 15; *(u32x4*)(su + ((size_t)g * MT + row) * 16 + h0) = w; }
                    else *(u32x4*)(proj + (size_t)row * NINP + col) = w;
                }
            }
    }
};
struct EpiGlu {
    static constexpr bool PERM = true, AFTER_DRAIN = false;
    const bf16_t* z; const float* bias; bf16_t* mix;
    __device__ __forceinline__ void operator()(const f32x4 (&acc)[2][2][4][2], const Unit& u, int wr, int wc, int fr, int fq) const {
        const int row0 = u.pm * BM + wr * 64 + fr; const int colt = u.pn * BM;
#pragma unroll
        for (int ai = 0; ai < 2; ++ai)
#pragma unroll
            for (int m = 0; m < 4; ++m) {
                const int row = row0 + ai * HALF + m * 16;
#pragma unroll
                for (int bj = 0; bj < 2; ++bj) {
                    const int col = colt + bj * HALF + wc * 32 + 8 * fq;
                    const f32x4 b0 = *(const f32x4*)(bias + col), b1 = *(const f32x4*)(bias + col + 4);
                    const u32x4 zz = *(const u32x4*)(z + ((size_t)(col >> 4) * MT + row) * 16 + (col & 15));
                    const f32x4 v0 = acc[ai][bj][m][0] + b0, v1 = acc[ai][bj][m][1] + b1;
                    float o[8];
                    o[0] = bflo(zz.x) * sigmoidf_(v0[0]); o[1] = bfhi(zz.x) * sigmoidf_(v0[1]); o[2] = bflo(zz.y) * sigmoidf_(v0[2]); o[3] = bfhi(zz.y) * sigmoidf_(v0[3]);
                    o[4] = bflo(zz.z) * sigmoidf_(v1[0]); o[5] = bfhi(zz.z) * sigmoidf_(v1[1]); o[6] = bflo(zz.w) * sigmoidf_(v1[2]); o[7] = bfhi(zz.w) * sigmoidf_(v1[3]);
                    u32x4 w; w.x = cvt_pk_bf16(o[0], o[1]); w.y = cvt_pk_bf16(o[2], o[3]); w.z = cvt_pk_bf16(o[4], o[5]); w.w = cvt_pk_bf16(o[6], o[7]);
                    *(u32x4*)(mix + (size_t)row * DM + 1024 + col) = w;
                }
            }
    }
};
struct EpiF32 {
    static constexpr bool PERM = false, AFTER_DRAIN = false;
    float* C; int ldc;
    __device__ __forceinline__ void operator()(const f32x4 (&acc)[2][2][4][2], const Unit& u, int wr, int wc, int fr, int fq) const {
        const int row0 = u.pm * BM + wr * 64 + fr, col0 = u.pn * BM + wc * 32 + 4 * fq;
#pragma unroll
        for (int ai = 0; ai < 2; ++ai)
#pragma unroll
            for (int m = 0; m < 4; ++m) { float* rowp = C + (size_t)(row0 + ai * HALF + m * 16) * ldc + col0;
#pragma unroll
                for (int bj = 0; bj < 2; ++bj)
#pragma unroll
                    for (int n = 0; n < 2; ++n) *(f32x4*)(rowp + bj * HALF + n * 16) = acc[ai][bj][m][n]; }
    }
};
struct EpiGateUp {
    static constexpr bool PERM = true, AFTER_DRAIN = false;
    bf16_t* hid;
    __device__ __forceinline__ void operator()(const f32x4 (&acc)[2][2][4][2], const Unit& u, int wr, int wc, int fr, int fq) const {
        const int row0 = u.pm * BM + wr * 64 + fr; const int col = u.pn * HALF + wc * 32 + 8 * fq;
#pragma unroll
        for (int ai = 0; ai < 2; ++ai) { if (ai == 1 && (u.fl & 1)) continue;
#pragma unroll
            for (int m = 0; m < 4; ++m) {
                const int row = row0 + ai * HALF + m * 16;
                const f32x4 g0 = acc[ai][0][m][0], g1 = acc[ai][0][m][1], u0 = acc[ai][1][m][0], u1 = acc[ai][1][m][1];
                u32x4 w; w.x = cvt_pk_bf16(siluf_(g0[0]) * u0[0], siluf_(g0[1]) * u0[1]); w.y = cvt_pk_bf16(siluf_(g0[2]) * u0[2], siluf_(g0[3]) * u0[3]);
                w.z = cvt_pk_bf16(siluf_(g1[0]) * u1[0], siluf_(g1[1]) * u1[1]); w.w = cvt_pk_bf16(siluf_(g1[2]) * u1[2], siluf_(g1[3]) * u1[3]);
                *(u32x4*)(hid + (size_t)row * DM + col) = w;
            } }
    }
};
struct EpiBf16 {
    static constexpr bool PERM = true, AFTER_DRAIN = false;
    bf16_t* O; int ldc;
    __device__ __forceinline__ void operator()(const f32x4 (&acc)[2][2][4][2], const Unit& u, int wr, int wc, int fr, int fq) const {
        const int row0 = u.pm * BM + wr * 64 + fr + ((u.fl & 8) ? HALF : 0); const int colt = u.pn * BM + ((u.fl & 16) ? HALF : 0);
#pragma unroll
        for (int ai = 0; ai < 2; ++ai) { if (ai == 1 && (u.fl & 1)) continue;
#pragma unroll
            for (int m = 0; m < 4; ++m) {
                bf16_t* rowp = O + (size_t)(row0 + ai * HALF + m * 16) * ldc + colt + wc * 32 + 8 * fq;
#pragma unroll
                for (int bj = 0; bj < 2; ++bj) { if ((bj == 1 && (u.fl & 2)) || (bj == 0 && (u.fl & 4))) continue; const f32x4 v0 = acc[ai][bj][m][0], v1 = acc[ai][bj][m][1];
                    u32x4 w; w.x = cvt_pk_bf16(v0[0], v0[1]); w.y = cvt_pk_bf16(v0[2], v0[3]); w.z = cvt_pk_bf16(v1[0], v1[1]); w.w = cvt_pk_bf16(v1[2], v1[3]);
                    *(u32x4*)(rowp + bj * HALF) = w; }
            } }
    }
};
}
struct Args { const float* in[30]; float* out; unsigned char* ws; int ph_lo, ph_hi; };
struct Frame {
    const float* const* in; float* out; unsigned char* ws; LAS unsigned char* lds; int tid, lane, wave, G, bid;
};
#define WSP(T, off) ((T*)(F.ws + (off)))

__device__ __forceinline__ int rope_perm(int o) { return (o < 64) ? (2 * (o & 31) + (o >> 5)) : (64 + 2 * ((o - 64) & 31) + ((o - 64) >> 5)); }
struct TileDesc { const float* src; bf16_t* dst; int ldn, nvalid, K, n0, k0, mode, ebase; };
__device__ __forceinline__ void tile_decode(const Frame& F, int q, TileDesc& d) {
    const int l = q / 752; q %= 752;
    if (q < 480) { d.src = F.in[6] + (size_t)l * DM * NIN; d.ldn = NIN; d.nvalid = NIN; d.K = DM; d.n0 = (q >> 3) * 64; d.k0 = (q & 7) * 256; d.dst = WSP(bf16_t, WS_WIN) + (size_t)l * NINP * DM; d.mode = 1; d.ebase = 0; }
    else if (q < 736) { q -= 480; d.src = F.in[21] + (size_t)l * DM * DM; d.ldn = DM; d.nvalid = DM; d.K = DM; d.n0 = (q >> 3) * 64; d.k0 = (q & 7) * 256; d.dst = WSP(bf16_t, WS_WOUT) + (size_t)l * DM * DM; d.mode = 0; d.ebase = 0; }
    else { q -= 736; d.src = F.in[16] + (size_t)l * 512 * 512; d.ldn = 512; d.nvalid = 512; d.K = 512; d.n0 = (q >> 1) * 64; d.k0 = (q & 1) * 256; d.dst = WSP(bf16_t, WS_WGLU) + (size_t)l * 512 * 512; d.mode = 0; d.ebase = 0; }
}
__device__ __forceinline__ void tile_load(const Frame& F, const TileDesc& d, f32x4 (&v)[8]) {
    const int kk = F.tid >> 4, n4 = (F.tid & 15) * 4;
#pragma unroll
    for (int i = 0; i < 8; ++i) { v[i] = (f32x4){0.f, 0.f, 0.f, 0.f}; if (d.n0 + n4 < d.nvalid) v[i] = *(const f32x4*)(d.src + (size_t)(d.k0 + kk + 32 * i) * d.ldn + d.n0 + n4); }
}
__device__ __forceinline__ void tile_to_lds(const Frame& F, const f32x4 (&v)[8]) {
    LAS float* tile = (LAS float*)F.lds; const int kk = F.tid >> 4, n4 = (F.tid & 15) * 4;
#pragma unroll
    for (int i = 0; i < 8; ++i) { const int k = kk + 32 * i; tile[k * 65 + n4 + 0] = v[i][0]; tile[k * 65 + n4 + 1] = v[i][1]; tile[k * 65 + n4 + 2] = v[i][2]; tile[k * 65 + n4 + 3] = v[i][3]; }
}
__device__ __forceinline__ void tile_store(const Frame& F, const TileDesc& d) {
    LAS float* tile = (LAS float*)F.lds; const int t = F.tid; const int n = t >> 3; const int ng = d.n0 + n; int drow;
    if (d.mode == 0) drow = ng;
    else if (d.mode == 1) { if (ng < 1280) drow = (ng & ~127) + rope_perm(ng & 127); else drow = ng; }
    else drow = d.ebase + (ng >> 7) * 256 + (ng & 127);
#pragma unroll
    for (int q = 0; q < 4; ++q) { const int k8 = (t & 7) * 8 + 64 * q; float v[8];
#pragma unroll
        for (int jj = 0; jj < 8; ++jj) v[jj] = tile[(k8 + jj) * 65 + n];
        u32x4 w; w.x = cvt_pk_bf16(v[0], v[1]); w.y = cvt_pk_bf16(v[2], v[3]); w.z = cvt_pk_bf16(v[4], v[5]); w.w = cvt_pk_bf16(v[6], v[7]);
        *(u32x4*)(d.dst + (size_t)drow * d.K + d.k0 + k8) = w; }
}
__device__ __forceinline__ void mod_partial(const Frame& F, int item) {
    const int l = item / 192, rem = item % 192, ks = rem / 6, cb = rem % 6;
    LAS float* sv = (LAS float*)F.lds;
    if (F.tid < 320) { const int r = F.tid >> 6, k = F.tid & 63; const float c = (r < 4) ? F.in[1][r * DM + ks * 64 + k] : F.in[3][ks * 64 + k]; sv[F.tid] = siluf_(c); }
    __syncthreads();
    const int col = cb * 2048 + F.tid * 4;
    const float* w = F.in[4] + (size_t)l * DM * 12288 + (size_t)(ks * 64) * 12288 + col;
    f32x4 a0 = {0, 0, 0, 0}, a1 = a0, a2 = a0, a3 = a0, a4 = a0;
#pragma unroll 4
    for (int k = 0; k < 64; ++k) { const f32x4 wv = *(const f32x4*)(w + (size_t)k * 12288);
        a0 += wv * sv[k]; a1 += wv * sv[64 + k]; a2 += wv * sv[128 + k]; a3 += wv * sv[192 + k]; a4 += wv * sv[256 + k]; }
    float* p = WSP(float, WS_MODP) + ((size_t)(l * 32 + ks) * 5) * 12288 + col;
    *(f32x4*)(p) = a0; *(f32x4*)(p + 12288) = a1; *(f32x4*)(p + 2 * 12288) = a2; *(f32x4*)(p + 3 * 12288) = a3; *(f32x4*)(p + 4 * 12288) = a4;
    __syncthreads();
}
__device__ __forceinline__ void rope_table(const Frame& F) {
    float* rp = WSP(float, WS_ROPE);
    for (int e = F.tid; e < 2048; e += NTHR) { const int pos = e >> 5, i = e & 31; const float inv = powf(10000.0f, -(float)i / 32.0f); const float ang = (float)pos * inv;
        rp[e * 2] = cosf(ang); rp[e * 2 + 1] = sinf(ang); }
}
__device__ __forceinline__ void s5_weights(const Frame& F, int l, int g, int hq) {
    LAS f32x2* pw = (LAS f32x2*)F.lds;
    LAS f32x2* bb = pw + 2 * 33 * 64;
    LAS f32x2* cc = bb + 2 * 64 * 16;
    LAS f32x2* cf = cc + 2 * 16 * 64;
    LAS float* Kt = (LAS float*)(cf + 128);
    const int t = F.tid;
    if (t < 128) { const int d = t >> 6, p = t & 63; const size_t ix = ((size_t)(l * 2 + d) * 32 + g) * 64 + p;
        const float lre = F.in[8][ix], lim = F.in[9][ix]; const float dt = expf(F.in[10][(l * 2 + d) * 32 + g]);
        const float ar = lre * dt, ai = lim * dt; const float mag = expf(ar); const float c = cosf(ai), s = sinf(ai); const f32x2 lb = {mag * c, mag * s};
        const float sh = sinf(0.5f * ai); const float nx = expm1f(ar) * c - 2.0f * sh * sh, ny = mag * s;
        const float den = lre * lre + lim * lim; cf[t] = (f32x2){(nx * lre + ny * lim) / den, (ny * lre - nx * lim) / den};
        f32x2 cur = {1.f, 0.f}; pw[(d * 33 + 0) * 64 + p] = cur;
        for (int k = 1; k <= 32; ++k) { const f32x2 nx2 = {cur.x * lb.x - cur.y * lb.y, cur.x * lb.y + cur.y * lb.x}; cur = nx2; pw[(d * 33 + k) * 64 + p] = cur; }
        if (hq == 0) WSP(f32x2, WS_LAMT)[((size_t)(l * 32 + g) * 2 + d) * 64 + p] = cur; }
    for (int e = t; e < 2048; e += NTHR) { const int d = e >> 10, h = (e >> 6) & 15, p = e & 63;
        const size_t ic = (((size_t)(l * 2 + d) * 32 + g) * 16 + h) * 64 + p; cc[(d * 16 + h) * 64 + p] = (f32x2){F.in[13][ic], F.in[14][ic]}; }
    __syncthreads();
    for (int e = t; e < 2048; e += NTHR) { const int d = e >> 10, p = (e >> 4) & 63, h = e & 15;
        const size_t ib = (((size_t)(l * 2 + d) * 32 + g) * 64 + p) * 16 + h; const float br = F.in[11][ib], bi = F.in[12][ib]; const f32x2 c = cf[d * 64 + p];
        bb[(d * 64 + p) * 16 + h] = (f32x2){c.x * br - c.y * bi, c.x * bi + c.y * br}; }
    __syncthreads();
    for (int e = t; e < 4096; e += NTHR) { const int d = e >> 11, j = (e >> 6) & 31, hp = 4 * hq + ((e >> 4) & 3), h = e & 15; float acc = 0.f;
#pragma unroll 4
        for (int p = 0; p < 64; ++p) { const f32x2 c = cc[(d * 16 + hp) * 64 + p], w = pw[(d * 33 + j) * 64 + p], b = bb[(d * 64 + p) * 16 + h];
            const float tx = c.x * w.x - c.y * w.y, ty = c.x * w.y + c.y * w.x; acc += tx * b.x - ty * b.y; }
        Kt[((d * 32 + j) * 16 + hp) * 16 + h] = acc; }
    __syncthreads();
    bf16_t* Wa = WSP(bf16_t, WS_S5A) + (size_t)(l * 32 + g) * 256 * 512;
    for (int e = hq * 16384 + t; e < (hq + 1) * 16384; e += NTHR) { const int p2 = e * 2, j = p2 & 7, lane = (p2 >> 3) & 63, f = p2 >> 9, ntile = f >> 4, ks = f & 15; const int n = ntile * 16 + (lane & 15), k2 = ks * 32 + (lane >> 4) * 8 + j;
        const int d = n >> 7, p = (n >> 1) & 63, c = n & 1; const int s = k2 >> 4, h = k2 & 15;
        const f32x2 w = pw[(d * 33 + (d == 0 ? 31 - s : s)) * 64 + p]; const f32x2 b0 = bb[(d * 64 + p) * 16 + h], b1 = bb[(d * 64 + p) * 16 + h + 1];
        const float v0 = c == 0 ? (w.x * b0.x - w.y * b0.y) : (w.x * b0.y + w.y * b0.x), v1 = c == 0 ? (w.x * b1.x - w.y * b1.y) : (w.x * b1.y + w.y * b1.x);
        *(unsigned*)(Wa + p2) = cvt_pk_bf16(v0, v1); }
    bf16_t* Wc = WSP(bf16_t, WS_S5C) + (size_t)(l * 32 + g) * 512 * 768;
    for (int e = t; e < 768 * 64; e += NTHR) { const int jp = e & 3, il = (e >> 2) & 3, g4 = (e >> 4) & 3, f = e >> 6; const int lane = g4 * 16 + 4 * hq + il, j = 2 * jp, p2 = (f * 64 + lane) * 8 + j, ntile = f / 24, ks = f % 24;
        const int n = ntile * 16 + (lane & 15), k2 = ks * 32 + g4 * 8 + j;
        const int tt = n >> 4, hp = n & 15; float v0, v1;
        if (k2 < 512) { const int s = k2 >> 4, h = k2 & 15; v0 = 0.f; v1 = 0.f;
            if (s <= tt) { v0 += Kt[((0 * 32 + (tt - s)) * 16 + hp) * 16 + h]; v1 += Kt[((0 * 32 + (tt - s)) * 16 + hp) * 16 + h + 1]; }
            if (s >= tt) { v0 += Kt[((1 * 32 + (s - tt)) * 16 + hp) * 16 + h]; v1 += Kt[((1 * 32 + (s - tt)) * 16 + hp) * 16 + h + 1]; } }
        else { const int d = (k2 - 512) >> 7, p = ((k2 - 512) >> 1) & 63; const f32x2 c = cc[(d * 16 + hp) * 64 + p], w = pw[(d * 33 + (d == 0 ? tt + 1 : 32 - tt)) * 64 + p];
            v0 = c.x * w.x - c.y * w.y; v1 = -(c.x * w.y + c.y * w.x); }
        *(unsigned*)(Wc + p2) = cvt_pk_bf16(v0, v1); }
    __syncthreads();
}
__device__ __forceinline__ void phase_prologue(const Frame& F) {
    int it = F.bid;
    for (; it < 256; it += F.G) s5_weights(F, it >> 7, (it >> 2) & 31, it & 3);
    for (; it < 256 + 384; it += F.G) mod_partial(F, it - 256);
    if (it == 640) { rope_table(F); it += F.G; }
    const int NT_ALL = 2 * 752;
    int q = it - 641;
    if (q < NT_ALL) {
        TileDesc d0, d1; f32x4 v0[8], v1[8];
        tile_decode(F, q, d0); tile_load(F, d0, v0);
        bool has1 = (q + F.G) < NT_ALL; d1 = d0; if (has1) { tile_decode(F, q + F.G, d1); tile_load(F, d1, v1); }
        for (;;) {
            tile_to_lds(F, v0); __syncthreads();
            const TileDesc c0 = d0; const bool has2 = (q + 2 * F.G) < NT_ALL;
            if (has2) { tile_decode(F, q + 2 * F.G, d0); tile_load(F, d0, v0); }
            tile_store(F, c0); __syncthreads();
            if (!has1) break;
            tile_to_lds(F, v1); __syncthreads();
            const TileDesc c1 = d1; const bool has3 = (q + 3 * F.G) < NT_ALL;
            if (has3) { tile_decode(F, q + 3 * F.G, d1); tile_load(F, d1, v1); }
            tile_store(F, c1); __syncthreads();
            if (!has2) break;
            q += 2 * F.G; has1 = has3;
        }
    }
}
__device__ __forceinline__ void phase_mod_reduce(const Frame& F) {
    for (int e = F.bid * NTHR + F.tid; e < 2 * 5 * 12288; e += F.G * NTHR) { const int l = e / 61440, rem = e % 61440, col = rem % 12288;
        float s = F.in[5][l * 12288 + col]; const float* p = WSP(float, WS_MODP) + (size_t)l * 32 * 61440 + rem;
        float pv[32];
#pragma unroll
        for (int ks = 0; ks < 32; ++ks) pv[ks] = p[(size_t)ks * 61440];
#pragma unroll
        for (int ks = 0; ks < 32; ++ks) s += pv[ks];
        WSP(float, WS_MOD)[e] = s; }
}
__device__ __forceinline__ void row_stats(const float (&v)[32], float& mu, float& rstd) {
    float s = 0.f;
#pragma unroll
    for (int i = 0; i < 32; ++i) s += v[i];
    mu = wave_sum(s) * (1.0f / 2048.0f); float q = 0.f;
#pragma unroll
    for (int i = 0; i < 32; ++i) { const float d = v[i] - mu; q += d * d; }
    rstd = rsqrtf(wave_sum(q) * (1.0f / 2048.0f) + LN_EPS);
}
__device__ __forceinline__ void load_row32(const float* p, int lane, float (&v)[32]) {
#pragma unroll
    for (int i = 0; i < 8; ++i) { const f32x4 t = *(const f32x4*)(p + (i * 64 + lane) * 4); v[i * 4] = t[0]; v[i * 4 + 1] = t[1]; v[i * 4 + 2] = t[2]; v[i * 4 + 3] = t[3]; }
}
__device__ __forceinline__ void mod_store_bf16(const float (&v)[32], float mu, float rstd, const float* sh, const float* sc, bf16_t* dst, int lane) {
#pragma unroll
    for (int i = 0; i < 8; ++i) { const int c = (i * 64 + lane) * 4; const f32x4 a = *(const f32x4*)(sc + c), b = *(const f32x4*)(sh + c);
        const float o0 = (v[i * 4] - mu) * rstd * (1.f + a[0]) + b[0], o1 = (v[i * 4 + 1] - mu) * rstd * (1.f + a[1]) + b[1], o2 = (v[i * 4 + 2] - mu) * rstd * (1.f + a[2]) + b[2], o3 = (v[i * 4 + 3] - mu) * rstd * (1.f + a[3]) + b[3];
        u32x2 w; w.x = cvt_pk_bf16(o0, o1); w.y = cvt_pk_bf16(o2, o3); *(u32x2*)(dst + c) = w; }
}
#define ROWMAP_NTRIP(nrows) (F.G == 256 ? ((nrows) > NLAT ? 9 : 8) : ((nrows) + F.G * 8 - 1) / (F.G * 8))
#define ROWMAP_ROW(k, nrows) (F.G == 256 ? ((k) < 8 ? F.bid * 64 + (k) * 8 + F.wave : (F.wave < 4 ? NLAT + F.bid * 4 + F.wave : -1)) : ((F.bid * 8 + F.wave + (k) * F.G * 8) < (nrows) ? (F.bid * 8 + F.wave + (k) * F.G * 8) : -1))
#define ROWMAP_BATCH(k) (F.G == 256 ? ((k) < 8 ? (F.bid >> 6) : 4) : ((F.bid * 8 + (k) * F.G * 8) < NLAT ? ((F.bid * 8 + (k) * F.G * 8) >> 12) : 4))
__device__ __forceinline__ void phase_ln1_first(const Frame& F) {
    const float* mod = WSP(float, WS_MOD);
    LAS float* Vsh = (LAS float*)F.lds; LAS float* Vsc = Vsh + 2048; int bcur = -1;
    const int ntrip = ROWMAP_NTRIP(MT);
    for (int k = 0; k < ntrip; ++k) { const int row = ROWMAP_ROW(k, MT), b = ROWMAP_BATCH(k); const bool rv = row >= 0; const int rowc = rv ? row : 0;
        const float* xr = rowc < NLAT ? F.in[0] + (size_t)rowc * DM : F.in[2] + (size_t)(rowc - NLAT) * DM;
        float v[32]; load_row32(xr, F.lane, v);
        if (b != bcur) { bcur = b; __syncthreads(); { const int c0 = F.tid * 4; *(LAS f32x4*)(Vsh + c0) = *(const f32x4*)(mod + (size_t)b * 12288 + c0); *(LAS f32x4*)(Vsc + c0) = *(const f32x4*)(mod + (size_t)b * 12288 + 2048 + c0); } __syncthreads(); }
        float mu, rstd; row_stats(v, mu, rstd);
        bf16_t* dst = WSP(bf16_t, WS_H) + (size_t)rowc * DM;
        if (rv)
#pragma unroll
        for (int i = 0; i < 8; ++i) { const int c = (i * 64 + F.lane) * 4; const f32x4 a = *(const LAS f32x4*)(Vsc + c), bq = *(const LAS f32x4*)(Vsh + c);
            const float o0 = (v[i * 4] - mu) * rstd * (1.f + a[0]) + bq[0], o1 = (v[i * 4 + 1] - mu) * rstd * (1.f + a[1]) + bq[1], o2 = (v[i * 4 + 2] - mu) * rstd * (1.f + a[2]) + bq[2], o3 = (v[i * 4 + 3] - mu) * rstd * (1.f + a[3]) + bq[3];
            u32x2 w; w.x = cvt_pk_bf16(o0, o1); w.y = cvt_pk_bf16(o2, o3); *(u32x2*)(dst + c) = w; }
    }
    __syncthreads();
}

template <int OFF0> __device__ __forceinline__ void tr_read16_attn(unsigned base, bf16x8 (&vf)[8]) {
    s16x4 r0, r1, r2, r3, r4, r5, r6, r7, r8, r9, r10, r11, r12, r13, r14, r15;
    asm volatile("ds_read_b64_tr_b16 %0, %16 offset:%c17+0\n\t"
        "ds_read_b64_tr_b16 %1, %16 offset:%c17+4352\n\t"
        "ds_read_b64_tr_b16 %2, %16 offset:%c17+32\n\t"
        "ds_read_b64_tr_b16 %3, %16 offset:%c17+4384\n\t"
        "ds_read_b64_tr_b16 %4, %16 offset:%c17+64\n\t"
        "ds_read_b64_tr_b16 %5, %16 offset:%c17+4416\n\t"
        "ds_read_b64_tr_b16 %6, %16 offset:%c17+96\n\t"
        "ds_read_b64_tr_b16 %7, %16 offset:%c17+4448\n\t"
        "ds_read_b64_tr_b16 %8, %16 offset:%c17+128\n\t"
        "ds_read_b64_tr_b16 %9, %16 offset:%c17+4480\n\t"
        "ds_read_b64_tr_b16 %10, %16 offset:%c17+160\n\t"
        "ds_read_b64_tr_b16 %11, %16 offset:%c17+4512\n\t"
        "ds_read_b64_tr_b16 %12, %16 offset:%c17+192\n\t"
        "ds_read_b64_tr_b16 %13, %16 offset:%c17+4544\n\t"
        "ds_read_b64_tr_b16 %14, %16 offset:%c17+224\n\t"
        "ds_read_b64_tr_b16 %15, %16 offset:%c17+4576\n\t"
        "s_waitcnt lgkmcnt(0)"
        : "=&v"(r0), "=&v"(r1), "=&v"(r2), "=&v"(r3), "=&v"(r4), "=&v"(r5), "=&v"(r6), "=&v"(r7), "=&v"(r8), "=&v"(r9), "=&v"(r10), "=&v"(r11), "=&v"(r12), "=&v"(r13), "=&v"(r14), "=&v"(r15) : "v"(base), "i"(OFF0) : "memory");
    vf[0] = (bf16x8){r0[0], r0[1], r0[2], r0[3], r1[0], r1[1], r1[2], r1[3]};
    vf[1] = (bf16x8){r2[0], r2[1], r2[2], r2[3], r3[0], r3[1], r3[2], r3[3]};
    vf[2] = (bf16x8){r4[0], r4[1], r4[2], r4[3], r5[0], r5[1], r5[2], r5[3]};
    vf[3] = (bf16x8){r6[0], r6[1], r6[2], r6[3], r7[0], r7[1], r7[2], r7[3]};
    vf[4] = (bf16x8){r8[0], r8[1], r8[2], r8[3], r9[0], r9[1], r9[2], r9[3]};
    vf[5] = (bf16x8){r10[0], r10[1], r10[2], r10[3], r11[0], r11[1], r11[2], r11[3]};
    vf[6] = (bf16x8){r12[0], r12[1], r12[2], r12[3], r13[0], r13[1], r13[2], r13[3]};
    vf[7] = (bf16x8){r14[0], r14[1], r14[2], r14[3], r15[0], r15[1], r15[2], r15[3]};
}
template <int OFF0> __device__ __forceinline__ void tr_read16_kdec(unsigned base, bf16x8 (&vf)[8]) {
    s16x4 r0, r1, r2, r3, r4, r5, r6, r7, r8, r9, r10, r11, r12, r13, r14, r15;
    asm volatile("ds_read_b64_tr_b16 %0, %16 offset:%c17+0\n\t"
        "ds_read_b64_tr_b16 %1, %16 offset:%c17+576\n\t"
        "ds_read_b64_tr_b16 %2, %16 offset:%c17+32\n\t"
        "ds_read_b64_tr_b16 %3, %16 offset:%c17+608\n\t"
        "ds_read_b64_tr_b16 %4, %16 offset:%c17+64\n\t"
        "ds_read_b64_tr_b16 %5, %16 offset:%c17+640\n\t"
        "ds_read_b64_tr_b16 %6, %16 offset:%c17+96\n\t"
        "ds_read_b64_tr_b16 %7, %16 offset:%c17+672\n\t"
        "ds_read_b64_tr_b16 %8, %16 offset:%c17+4608\n\t"
        "ds_read_b64_tr_b16 %9, %16 offset:%c17+5184\n\t"
        "ds_read_b64_tr_b16 %10, %16 offset:%c17+4640\n\t"
        "ds_read_b64_tr_b16 %11, %16 offset:%c17+5216\n\t"
        "ds_read_b64_tr_b16 %12, %16 offset:%c17+4672\n\t"
        "ds_read_b64_tr_b16 %13, %16 offset:%c17+5248\n\t"
        "ds_read_b64_tr_b16 %14, %16 offset:%c17+4704\n\t"
        "ds_read_b64_tr_b16 %15, %16 offset:%c17+5280\n\t"
        "s_waitcnt lgkmcnt(0)"
        : "=&v"(r0), "=&v"(r1), "=&v"(r2), "=&v"(r3), "=&v"(r4), "=&v"(r5), "=&v"(r6), "=&v"(r7), "=&v"(r8), "=&v"(r9), "=&v"(r10), "=&v"(r11), "=&v"(r12), "=&v"(r13), "=&v"(r14), "=&v"(r15) : "v"(base), "i"(OFF0) : "memory");
    vf[0] = (bf16x8){r0[0], r0[1], r0[2], r0[3], r1[0], r1[1], r1[2], r1[3]};
    vf[1] = (bf16x8){r2[0], r2[1], r2[2], r2[3], r3[0], r3[1], r3[2], r3[3]};
    vf[2] = (bf16x8){r4[0], r4[1], r4[2], r4[3], r5[0], r5[1], r5[2], r5[3]};
    vf[3] = (bf16x8){r6[0], r6[1], r6[2], r6[3], r7[0], r7[1], r7[2], r7[3]};
    vf[4] = (bf16x8){r8[0], r8[1], r8[2], r8[3], r9[0], r9[1], r9[2], r9[3]};
    vf[5] = (bf16x8){r10[0], r10[1], r10[2], r10[3], r11[0], r11[1], r11[2], r11[3]};
    vf[6] = (bf16x8){r12[0], r12[1], r12[2], r12[3], r13[0], r13[1], r13[2], r13[3]};
    vf[7] = (bf16x8){r14[0], r14[1], r14[2], r14[3], r15[0], r15[1], r15[2], r15[3]};
}
template <int OFF0> __device__ __forceinline__ void tr_read16_glav(unsigned base, bf16x8 (&vf)[8]) {
    s16x4 r0, r1, r2, r3, r4, r5, r6, r7, r8, r9, r10, r11, r12, r13, r14, r15;
    asm volatile("ds_read_b64_tr_b16 %0, %16 offset:%c17+0\n\t"
        "ds_read_b64_tr_b16 %1, %16 offset:%c17+4352\n\t"
        "ds_read_b64_tr_b16 %2, %16 offset:%c17+32\n\t"
        "ds_read_b64_tr_b16 %3, %16 offset:%c17+4384\n\t"
        "ds_read_b64_tr_b16 %4, %16 offset:%c17+64\n\t"
        "ds_read_b64_tr_b16 %5, %16 offset:%c17+4416\n\t"
        "ds_read_b64_tr_b16 %6, %16 offset:%c17+96\n\t"
        "ds_read_b64_tr_b16 %7, %16 offset:%c17+4448\n\t"
        "ds_read_b64_tr_b16 %8, %16 offset:%c17+8704\n\t"
        "ds_read_b64_tr_b16 %9, %16 offset:%c17+13056\n\t"
        "ds_read_b64_tr_b16 %10, %16 offset:%c17+8736\n\t"
        "ds_read_b64_tr_b16 %11, %16 offset:%c17+13088\n\t"
        "ds_read_b64_tr_b16 %12, %16 offset:%c17+8768\n\t"
        "ds_read_b64_tr_b16 %13, %16 offset:%c17+13120\n\t"
        "ds_read_b64_tr_b16 %14, %16 offset:%c17+8800\n\t"
        "ds_read_b64_tr_b16 %15, %16 offset:%c17+13152\n\t"
        "s_waitcnt lgkmcnt(0)"
        : "=&v"(r0), "=&v"(r1), "=&v"(r2), "=&v"(r3), "=&v"(r4), "=&v"(r5), "=&v"(r6), "=&v"(r7), "=&v"(r8), "=&v"(r9), "=&v"(r10), "=&v"(r11), "=&v"(r12), "=&v"(r13), "=&v"(r14), "=&v"(r15) : "v"(base), "i"(OFF0) : "memory");
    vf[0] = (bf16x8){r0[0], r0[1], r0[2], r0[3], r1[0], r1[1], r1[2], r1[3]};
    vf[1] = (bf16x8){r2[0], r2[1], r2[2], r2[3], r3[0], r3[1], r3[2], r3[3]};
    vf[2] = (bf16x8){r4[0], r4[1], r4[2], r4[3], r5[0], r5[1], r5[2], r5[3]};
    vf[3] = (bf16x8){r6[0], r6[1], r6[2], r6[3], r7[0], r7[1], r7[2], r7[3]};
    vf[4] = (bf16x8){r8[0], r8[1], r8[2], r8[3], r9[0], r9[1], r9[2], r9[3]};
    vf[5] = (bf16x8){r10[0], r10[1], r10[2], r10[3], r11[0], r11[1], r11[2], r11[3]};
    vf[6] = (bf16x8){r12[0], r12[1], r12[2], r12[3], r13[0], r13[1], r13[2], r13[3]};
    vf[7] = (bf16x8){r14[0], r14[1], r14[2], r14[3], r15[0], r15[1], r15[2], r15[3]};
}
template <int OFF0> __device__ __forceinline__ void tr_read8_attn(unsigned base, bf16x8 (&vf)[4]) {
    s16x4 r0, r1, r2, r3, r4, r5, r6, r7;
    asm volatile("ds_read_b64_tr_b16 %0, %8 offset:%c9+0\n\t"
        "ds_read_b64_tr_b16 %1, %8 offset:%c9+4352\n\t"
        "ds_read_b64_tr_b16 %2, %8 offset:%c9+32\n\t"
        "ds_read_b64_tr_b16 %3, %8 offset:%c9+4384\n\t"
        "ds_read_b64_tr_b16 %4, %8 offset:%c9+64\n\t"
        "ds_read_b64_tr_b16 %5, %8 offset:%c9+4416\n\t"
        "ds_read_b64_tr_b16 %6, %8 offset:%c9+96\n\t"
        "ds_read_b64_tr_b16 %7, %8 offset:%c9+4448\n\t"
        "s_waitcnt lgkmcnt(0)"
        : "=&v"(r0), "=&v"(r1), "=&v"(r2), "=&v"(r3), "=&v"(r4), "=&v"(r5), "=&v"(r6), "=&v"(r7) : "v"(base), "i"(OFF0) : "memory");
    vf[0] = (bf16x8){r0[0], r0[1], r0[2], r0[3], r1[0], r1[1], r1[2], r1[3]};
    vf[1] = (bf16x8){r2[0], r2[1], r2[2], r2[3], r3[0], r3[1], r3[2], r3[3]};
    vf[2] = (bf16x8){r4[0], r4[1], r4[2], r4[3], r5[0], r5[1], r5[2], r5[3]};
    vf[3] = (bf16x8){r6[0], r6[1], r6[2], r6[3], r7[0], r7[1], r7[2], r7[3]};
}
constexpr int AT_PITCH = 272;
constexpr int AT_TILE = 64 * AT_PITCH;
__device__ __forceinline__ void attn_item(const Frame& F, int l, int qrow0  , int qpos0  , int hp  , int b, int kc_lo, int nlat) {
    const bf16_t* __restrict__ proj = WSP(bf16_t, WS_R1); bf16_t* __restrict__ mix = WSP(bf16_t, WS_R3);
    const int lane = F.lane, i16 = lane & 15, g4 = lane >> 4, w = F.wave >> 1  , h = hp * 2 + (F.wave & 1), kvh = hp >> 1;
    LAS unsigned char* lds = F.lds;
    const int nchunk = nlat + 4;
    bf16x8 qf[2][4];
#pragma unroll
    for (int u = 0; u < 2; ++u) { const bf16_t* qp = proj + (size_t)(qrow0 + w * 32 + u * 16 + i16) * NINP + C_Q + h * 128 + 8 * g4;
#pragma unroll
        for (int ks = 0; ks < 4; ++ks) qf[u][ks] = *(const bf16x8*)(qp + ks * 32); }
    const float sink = F.in[7][l * 8 + h];
    const float SC = 0.08838834764831845f, C2 = SC * 1.4426950408889634f;
    float m_run[2] = {sink / SC, sink / SC}, l_run[2] = {(g4 == 0) ? 1.0f : 0.0f, (g4 == 0) ? 1.0f : 0.0f};
    f32x4 o[2][8];
#pragma unroll
    for (int u = 0; u < 2; ++u)
#pragma unroll
        for (int d = 0; d < 8; ++d) o[u][d] = (f32x4){0.f, 0.f, 0.f, 0.f};
    const int skey = F.tid >> 3, sseg = F.tid & 7;
    u32x4 rk0, rk1, rv0, rv1;
#define AT_CROW(c) (((c) < nlat) ? (b * SEQ + (kc_lo + (c)) * 64) : (NLAT + b * CTXL + ((c) - nlat) * 64))
#define AT_GLOAD(c) do { const bf16_t* kp_ = proj + (size_t)(AT_CROW(c) + skey) * NINP + C_K + kvh * 128 + sseg * 8; rk0 = *(const u32x4*)kp_; rk1 = *(const u32x4*)(kp_ + 64); rv0 = *(const u32x4*)(kp_ + 256); rv1 = *(const u32x4*)(kp_ + 256 + 64); } while (0)
#define AT_LSTORE(buf) do { LAS unsigned char* kb_ = lds + (buf) * 2 * AT_TILE + skey * AT_PITCH + sseg * 16; *(LAS u32x4*)kb_ = rk0; *(LAS u32x4*)(kb_ + 128) = rk1; *(LAS u32x4*)(kb_ + AT_TILE) = rv0; *(LAS u32x4*)(kb_ + AT_TILE + 128) = rv1; } while (0)
    AT_GLOAD(0); AT_LSTORE(0); __syncthreads();
    const int wq0 = qpos0 + w * 32;
    for (int c = 0; c < nchunk; ++c) {
        const int buf = c & 1;
        if (c + 1 < nchunk) AT_GLOAD(c + 1);
        const int k0 = (kc_lo + c) * 64; const bool lat = c < nlat;
        const bool skip = lat && (k0 > wq0 + 31 + 128 || k0 + 63 < wq0 - 128);
        const bool need_mask = lat && !(k0 >= wq0 + 31 - 128 && k0 + 63 <= wq0 + 128);
        if (!skip) {
        const LAS unsigned char* kb = lds + buf * 2 * AT_TILE; const LAS unsigned char* vb = kb + AT_TILE;
        f32x4 st[2][4];
#pragma unroll
        for (int kt = 0; kt < 4; ++kt) { st[0][kt] = (f32x4){0.f, 0.f, 0.f, 0.f}; st[1][kt] = (f32x4){0.f, 0.f, 0.f, 0.f};
#pragma unroll
            for (int ks = 0; ks < 4; ++ks) { const bf16x8 kf = *(const LAS bf16x8*)(kb + (kt * 16 + i16) * AT_PITCH + (ks * 32 + 8 * g4) * 2); st[0][kt] = MFMA16(kf, qf[0][ks], st[0][kt]); st[1][kt] = MFMA16(kf, qf[1][ks], st[1][kt]); } }
        if (need_mask) {
#pragma unroll
            for (int u = 0; u < 2; ++u) { const int qp = wq0 + u * 16 + i16; const int kp0 = k0 + 4 * g4;
#pragma unroll
                for (int kt = 0; kt < 4; ++kt)
#pragma unroll
                    for (int r = 0; r < 4; ++r) { const int dlt = qp - (kp0 + kt * 16 + r); if (dlt > 128 || dlt < -128) st[u][kt][r] = -1e30f; } } }
        bf16x8 pf[2][2];
#pragma unroll
        for (int u = 0; u < 2; ++u) {
            float mx = st[u][0][0];
#pragma unroll
            for (int kt = 0; kt < 4; ++kt)
#pragma unroll
                for (int r = 0; r < 4; ++r) mx = fmaxf(mx, st[u][kt][r]);
            mx = fmaxf(mx, shx<16>(mx)); mx = fmaxf(mx, shx<32>(mx));
            const float m_new = fmaxf(m_run[u], mx); const float alpha = __builtin_amdgcn_exp2f((m_run[u] - m_new) * C2); m_run[u] = m_new;
            const float mc = m_new * C2; float ps = 0.f;
#pragma unroll
            for (int kt = 0; kt < 4; ++kt)
#pragma unroll
                for (int r = 0; r < 4; ++r) { const float p = __builtin_amdgcn_exp2f(st[u][kt][r] * C2 - mc); st[u][kt][r] = p; ps += p; }
            l_run[u] = l_run[u] * alpha + ps;
            if (__any(alpha != 1.0f)) {
#pragma unroll
                for (int d = 0; d < 8; ++d) o[u][d] *= alpha; }
#pragma unroll
            for (int ks2 = 0; ks2 < 2; ++ks2) { u32x4 t4; t4.x = cvt_pk_bf16(st[u][2 * ks2][0], st[u][2 * ks2][1]); t4.y = cvt_pk_bf16(st[u][2 * ks2][2], st[u][2 * ks2][3]); t4.z = cvt_pk_bf16(st[u][2 * ks2 + 1][0], st[u][2 * ks2 + 1][1]); t4.w = cvt_pk_bf16(st[u][2 * ks2 + 1][2], st[u][2 * ks2 + 1][3]); pf[u][ks2] = __builtin_bit_cast(bf16x8, t4); }
        }
        const unsigned vaddr = lds_addr_of(vb) + (unsigned)((4 * g4 + (i16 >> 2)) * AT_PITCH + (4 * (i16 & 3)) * 2);
#pragma unroll
        for (int ks2 = 0; ks2 < 2; ++ks2) {
#pragma unroll
            for (int dh = 0; dh < 2; ++dh) { bf16x8 vf[4];
                if (ks2 == 0) { if (dh == 0) tr_read8_attn<0>(vaddr, vf); else tr_read8_attn<128>(vaddr, vf); } else { if (dh == 0) tr_read8_attn<32 * AT_PITCH>(vaddr, vf); else tr_read8_attn<32 * AT_PITCH + 128>(vaddr, vf); }
#pragma unroll
                for (int d = 0; d < 4; ++d) { o[0][dh * 4 + d] = MFMA16(vf[d], pf[0][ks2], o[0][dh * 4 + d]); o[1][dh * 4 + d] = MFMA16(vf[d], pf[1][ks2], o[1][dh * 4 + d]); } }
        }
        }
        if (c + 1 < nchunk) AT_LSTORE(buf ^ 1);
        __syncthreads();
    }
#undef AT_CROW
#undef AT_GLOAD
#undef AT_LSTORE
#pragma unroll
    for (int u = 0; u < 2; ++u) {
        float lr = l_run[u]; lr += shx<16>(lr); lr += shx<32>(lr);
        const float inv = 1.0f / lr;
        bf16_t* op = mix + (size_t)(qrow0 + w * 32 + u * 16 + i16) * DM + h * 128 + 4 * g4;
#pragma unroll
        for (int d = 0; d < 8; ++d) { u32x2 wv; wv.x = cvt_pk_bf16(o[u][d][0] * inv, o[u][d][1] * inv); wv.y = cvt_pk_bf16(o[u][d][2] * inv, o[u][d][3] * inv); *(u32x2*)(op + d * 16) = wv; } }
}
__device__ __forceinline__ void attn_items(const Frame& F, int l, int first, int stride) {
    const int nitem = 512 + (l == 0 ? 32 : 0);
    for (int it = first; it < nitem; it += stride) {
        if (it < 512) { const int hp = it & 3, qb = (it >> 2) & 31, b = it >> 7; const int kc_lo = qb > 0 ? qb * 2 - 2 : 0, kc_hi = qb < 31 ? qb * 2 + 3 : 63;
            attn_item(F, l, b * SEQ + qb * 128, qb * 128, hp, b, kc_lo, kc_hi - kc_lo + 1);
        } else { const int j = it - 512; const int hp = j & 3, half = (j >> 2) & 1, b = j >> 3;
            attn_item(F, l, NLAT + b * CTXL + half * 128, 0, hp, b, 0, 0); }
    }
}
constexpr int S5_APITCH = (768 + 8) * 2;
template <int NT, int KT, int MTL>
__device__ __forceinline__ void s5_mm(const LAS unsigned char* A, const bf16_t* __restrict__ Bt, int lane, int wave, f32x4 (&acc)[MTL][NT]) {
    const int i16 = lane & 15, g4 = lane >> 4;
#pragma unroll
    for (int m = 0; m < MTL; ++m)
#pragma unroll
        for (int n = 0; n < NT; ++n) acc[m][n] = (f32x4){0.f, 0.f, 0.f, 0.f};
    const bf16_t* bp = Bt + ((size_t)(wave * NT) * (KT / 32) * 64 + lane) * 8;
    const LAS unsigned char* ap = A + i16 * S5_APITCH + 16 * g4;
    constexpr int KB = (MTL >= 4 && NT >= 4) ? 1 : 4;
    for (int ks0 = 0; ks0 < KT / 32; ks0 += KB) {
        bf16x8 bf[KB][NT];
#pragma unroll
        for (int q = 0; q < KB; ++q)
#pragma unroll
            for (int n = 0; n < NT; ++n) bf[q][n] = *(const bf16x8*)(bp + (size_t)(n * (KT / 32) + ks0 + q) * 512);
#pragma unroll
        for (int q = 0; q < KB; ++q) {
#pragma unroll
            for (int m = 0; m < MTL; ++m) { const bf16x8 am = *(const LAS bf16x8*)(ap + m * 16 * S5_APITCH + (ks0 + q) * 64);
#pragma unroll
                for (int n = 0; n < NT; ++n) acc[m][n] = MFMA16(am, bf[q][n], acc[m][n]); } }
    }
}
__device__ __forceinline__ void s5a_items(const Frame& F, int l, int xcd, int first, int stride) {
    const bf16_t* __restrict__ su = WSP(bf16_t, WS_SU); float* __restrict__ S = WSP(float, WS_S5S);
    for (int li = first; li < (xcd < 0 ? 256 : 32); li += stride) { const int g = (xcd < 0) ? (li >> 3) : (xcd + 8 * (li >> 3)), rb = li & 7;
        __syncthreads();
        { u32x4 ta[10];
#pragma unroll
          for (int q = 0; q < 10; ++q) { const int e = F.tid + q * NTHR, r = e >> 6, sg = e & 63; ta[q] = *(const u32x4*)(su + ((size_t)g * MT + (size_t)(rb * 68 + r) * 32) * 16 + sg * 8); }
#pragma unroll
          for (int q = 0; q < 10; ++q) { const int e = F.tid + q * NTHR, r = e >> 6, sg = e & 63; *(LAS u32x4*)(F.lds + r * S5_APITCH + sg * 16) = ta[q]; } }
        __syncthreads();
        f32x4 acc[5][2]; s5_mm<2, 512, 5>(F.lds, WSP(bf16_t, WS_S5A) + (size_t)(l * 32 + g) * 256 * 512, F.lane, F.wave, acc);
        const int i16 = F.lane & 15, g4 = F.lane >> 4;
#pragma unroll
        for (int m = 0; m < 5; ++m)
#pragma unroll
            for (int r = 0; r < 4; ++r) { const int lr = m * 16 + 4 * g4 + r, cr = rb * 68 + lr; if (lr < 68) {
#pragma unroll
                for (int n = 0; n < 2; ++n) S[((size_t)cr * 32 + g) * 256 + F.wave * 32 + n * 16 + i16] = acc[m][n][r]; } }
    }
}
__device__ __forceinline__ void s5_scan(const Frame& F, int l, int first_thread, int nthreads) {
    const float* S = WSP(float, WS_S5S); bf16_t* SI = WSP(bf16_t, WS_S5IN);
    for (int e = first_thread; e < 4 * 32 * 128; e += nthreads) { const int p = e & 63, d = (e >> 6) & 1, g = (e >> 7) & 31, b = e >> 12;
        const f32x2 lt = WSP(f32x2, WS_LAMT)[((size_t)(l * 32 + g) * 2 + d) * 64 + p];
        float sx = 0.f, sy = 0.f; const size_t co = (size_t)g * 256 + d * 128 + p * 2;
#pragma unroll 8
        for (int i = 0; i < 136; ++i) { int r; if (i < 8) r = 512 + b * 8 + (d == 0 ? i : 7 - i); else r = b * 128 + (d == 0 ? (i - 8) : 127 - (i - 8));
            const f32x2 sv = *(const f32x2*)(S + (size_t)r * 8192 + co);
            *(unsigned*)(SI + (size_t)r * 8192 + co) = cvt_pk_bf16(sx, sy);
            const float nx = lt.x * sx - lt.y * sy + sv.x, ny = lt.x * sy + lt.y * sx + sv.y; sx = nx; sy = ny; }
    }
}
__device__ __forceinline__ void s5c_items(const Frame& F, int l, int xcd, int first, int stride) {
    const bf16_t* __restrict__ su = WSP(bf16_t, WS_SU); const bf16_t* __restrict__ SI = WSP(bf16_t, WS_S5IN); bf16_t* __restrict__ zb = WSP(bf16_t, WS_R3 + (size_t)MT * DM * 2);
    for (int li = first; li < (xcd < 0 ? 256 : 32); li += stride) { const int g = (xcd < 0) ? (li >> 3) : (xcd + 8 * (li >> 3)), rb = li & 7;
        __syncthreads();
#pragma unroll
        for (int hq = 0; hq < 2; ++hq) { u32x4 ta[5];
#pragma unroll
          for (int q = 0; q < 5; ++q) { const int e = F.tid + (hq * 5 + q) * NTHR, r = e >> 6, sg = e & 63; ta[q] = *(const u32x4*)(su + ((size_t)g * MT + (size_t)(rb * 68 + r) * 32) * 16 + sg * 8); }
#pragma unroll
          for (int q = 0; q < 5; ++q) { const int e = F.tid + (hq * 5 + q) * NTHR, r = e >> 6, sg = e & 63; *(LAS u32x4*)(F.lds + r * S5_APITCH + sg * 16) = ta[q]; } }
        { u32x4 tb[5];
#pragma unroll
          for (int q = 0; q < 5; ++q) { const int e = F.tid + q * NTHR, r = e >> 5, sg = e & 31; tb[q] = *(const u32x4*)(SI + ((size_t)(rb * 68 + r) * 32 + g) * 256 + sg * 8); }
#pragma unroll
          for (int q = 0; q < 5; ++q) { const int e = F.tid + q * NTHR, r = e >> 5, sg = e & 31; *(LAS u32x4*)(F.lds + r * S5_APITCH + 1024 + sg * 16) = tb[q]; } }
        __syncthreads();
        f32x4 acc[5][4]; s5_mm<4, 768, 5>(F.lds, WSP(bf16_t, WS_S5C) + (size_t)(l * 32 + g) * 512 * 768, F.lane, F.wave, acc);
        const int i16 = F.lane & 15, g4 = F.lane >> 4; const float dd = F.in[15][l * 512 + g * 16 + i16];
        __syncthreads();
#pragma unroll
        for (int m = 0; m < 5; ++m)
#pragma unroll
            for (int n = 0; n < 4; ++n)
#pragma unroll
                for (int r = 0; r < 4; ++r) { LAS bf16_t* up = (LAS bf16_t*)(F.lds + (m * 16 + 4 * g4 + r) * S5_APITCH) + (F.wave * 4 + n) * 16 + i16; *up = f2bf(gelu_tanh(acc[m][n][r] + dd * bf2f(*up))); }
        __syncthreads();
#pragma unroll
        for (int hq = 0; hq < 3; ++hq) { u32x4 tz[3];
#pragma unroll
          for (int q = 0; q < 3; ++q) { const int e = F.tid + (hq * 3 + q) * NTHR, r = e >> 6, sg = e & 63; tz[q] = *(const LAS u32x4*)(F.lds + r * S5_APITCH + sg * 16); }
#pragma unroll
          for (int q = 0; q < 3; ++q) { const int e = F.tid + (hq * 3 + q) * NTHR, r = e >> 6, sg = e & 63; if (r < 68) *(u32x4*)(zb + ((size_t)g * MT + (size_t)(rb * 68 + r) * 32) * 16 + sg * 8) = tz[q]; } }
    }
}
constexpr int GL_GB = 0  , GL_KD = 32768  , GL_VT = 51200  , GL_GZ = 68608  , GL_WG = 76800  ,
              GL_BL = 84992  , GL_TOT = 85504  ;
constexpr int G3_Q = 0  , G3_K = 18432, G3_V = 36864  , G3_S = 54272  , G3_SSQ = 91136  ;
constexpr int GL_P64 = 144, GL_P128 = 272;
__device__ __forceinline__ int gla_row0(int b, int j) { return j < 4 ? NLAT + b * CTXL + j * 64 : b * SEQ + (j - 4) * 64; }
__device__ __forceinline__ void gla1_items(const Frame& F, int l, int first, int stride) {
    const bf16_t* __restrict__ proj = WSP(bf16_t, WS_R1); float* __restrict__ upd = WSP(float, WS_R3 + (size_t)MT * DM * 2 + (size_t)MT * 512 * 2); float* __restrict__ dec = WSP(float, WS_GDEC);
    bf16_t* __restrict__ gqin = WSP(bf16_t, WS_GQIN); bf16_t* __restrict__ gkp = WSP(bf16_t, WS_GKP);
    LAS float* gb = (LAS float*)(F.lds + GL_GB); LAS float* gz = (LAS float*)(F.lds + GL_GZ); LAS float* wg = (LAS float*)(F.lds + GL_WG); LAS float* bl = (LAS float*)(F.lds + GL_BL); LAS float* tot = (LAS float*)(F.lds + GL_TOT);
    const int t = F.tid, tk = t >> 3, k0 = (t & 7) * 8;
    u32x2 gzr; u32x4 qv, kv, vv0, vv1; f32x4 wgr; f32x4 bg[2][2];
#define GL1_LOAD_A(IT) do { const int j_ = (IT) % 68, bh_ = (IT) / 68, h_ = bh_ & 3, b_ = bh_ >> 2; const bf16_t* rp_ = proj + (size_t)(gla_row0(b_, j_) + tk) * NINP; \
        gzr = *(const u32x2*)(rp_ + C_GZ + (t & 7) * 4); vv0 = *(const u32x4*)(rp_ + C_GV + h_ * 128 + (t & 7) * 8); vv1 = *(const u32x4*)(rp_ + C_GV + h_ * 128 + 64 + (t & 7) * 8); \
        { const int e4 = t * 4, d = e4 >> 10, r = (e4 >> 6) & 15, k = e4 & 63; wgr = *(const f32x4*)(F.in[18] + ((size_t)(l * 2 + d) * 16 + r) * 256 + h_ * 64 + k); } } while (0)
#define GL1_LOAD_B(IT) do { const int h_ = ((IT) / 68) & 3; _Pragma("unroll") for (int d = 0; d < 2; ++d) { bg[d][0] = *(const f32x4*)(F.in[19] + (l * 2 + d) * 256 + h_ * 64 + k0); bg[d][1] = *(const f32x4*)(F.in[19] + (l * 2 + d) * 256 + h_ * 64 + k0 + 4); } } while (0)
#define GL1_LOAD_C(IT) do { const int j_ = (IT) % 68, bh_ = (IT) / 68, h_ = bh_ & 3, b_ = bh_ >> 2; const bf16_t* rp_ = proj + (size_t)(gla_row0(b_, j_) + tk) * NINP; \
        qv = *(const u32x4*)(rp_ + C_GQ + h_ * 64 + k0); kv = *(const u32x4*)(rp_ + C_GK + h_ * 64 + k0); } while (0)
    if (first < 16 * 68) { GL1_LOAD_A(first); GL1_LOAD_B(first); GL1_LOAD_C(first); }
    for (int it = first; it < 16 * 68; it += stride) { const int j = it % 68, bh = it / 68, h = bh & 3, b = bh >> 2; const bool more = it + stride < 16 * 68;
        __syncthreads();
        { const int c0 = (t & 7) * 4; gz[tk * 32 + c0] = bflo(gzr.x); gz[tk * 32 + c0 + 1] = bfhi(gzr.x); gz[tk * 32 + c0 + 2] = bflo(gzr.y); gz[tk * 32 + c0 + 3] = bfhi(gzr.y); *(LAS f32x4*)(wg + t * 4) = wgr;
          *(LAS u32x4*)(F.lds + GL_VT + tk * GL_P128 + (t & 7) * 16) = vv0; *(LAS u32x4*)(F.lds + GL_VT + tk * GL_P128 + 128 + (t & 7) * 16) = vv1; }
        __syncthreads();
        if (more) GL1_LOAD_A(it + stride);
#pragma unroll
        for (int d = 0; d < 2; ++d) { float a[8] = {bg[d][0][0], bg[d][0][1], bg[d][0][2], bg[d][0][3], bg[d][1][0], bg[d][1][1], bg[d][1][2], bg[d][1][3]};
#pragma unroll
            for (int r = 0; r < 16; ++r) { const float zv = gz[tk * 32 + d * 16 + r]; const f32x4 w0 = *(const LAS f32x4*)(wg + (d * 16 + r) * 64 + k0), w1 = *(const LAS f32x4*)(wg + (d * 16 + r) * 64 + k0 + 4);
                a[0] += zv * w0[0]; a[1] += zv * w0[1]; a[2] += zv * w0[2]; a[3] += zv * w0[3]; a[4] += zv * w1[0]; a[5] += zv * w1[1]; a[6] += zv * w1[2]; a[7] += zv * w1[3]; }
#pragma unroll
            for (int q = 0; q < 8; ++q) gb[(d * 64 + tk) * 64 + k0 + q] = logsigmoidf_(a[q]) * (1.0f / 16.0f); }
        if (more) GL1_LOAD_B(it + stride);
        __syncthreads();
        { const int k = t & 63, seg = t >> 6; float vf[8], vb[8]; float rf = 0.f, rb = 0.f;
#pragma unroll
          for (int q = 0; q < 8; ++q) { rf += gb[(seg * 8 + q) * 64 + k]; vf[q] = rf; }
#pragma unroll
          for (int q = 7; q >= 0; --q) { rb += gb[(64 + seg * 8 + q) * 64 + k]; vb[q] = rb; }
          tot[seg * 64 + k] = rf; tot[512 + seg * 64 + k] = rb;
          __syncthreads();
          float pf = 0.f, pb = 0.f, af = 0.f, ab = 0.f;
#pragma unroll
          for (int s2 = 0; s2 < 8; ++s2) { const float x = tot[s2 * 64 + k], y = tot[512 + s2 * 64 + k]; af += x; ab += y; if (s2 < seg) pf += x; if (s2 > seg) pb += y; }
#pragma unroll
          for (int q = 0; q < 8; ++q) { gb[(seg * 8 + q) * 64 + k] = vf[q] + pf; gb[(64 + seg * 8 + q) * 64 + k] = vb[q] + pb; }
          if (seg == 0) { bl[k] = af; bl[64 + k] = ab; } }
        __syncthreads();
        { const float qq[8] = {bflo(qv.x), bfhi(qv.x), bflo(qv.y), bfhi(qv.y), bflo(qv.z), bfhi(qv.z), bflo(qv.w), bfhi(qv.w)}, kk[8] = {bflo(kv.x), bfhi(kv.x), bflo(kv.y), bfhi(kv.y), bflo(kv.z), bfhi(kv.z), bflo(kv.w), bfhi(kv.w)};
#pragma unroll
          for (int d = 0; d < 2; ++d) { float qo[8], ko[8], kd[8];
#pragma unroll
              for (int q = 0; q < 8; ++q) { const float bv = gb[(d * 64 + tk) * 64 + k0 + q]; qo[q] = qq[q] * 0.125f * __expf(bv); ko[q] = kk[q] * __expf(-bv); kd[q] = kk[q] * __expf(bl[d * 64 + k0 + q] - bv); }
              const size_t go = ((size_t)(((b * 4 + h) * 2 + d) * 68 + j) * 64 + tk) * 64 + k0; u32x4 w;
              w.x = cvt_pk_bf16(qo[0], qo[1]); w.y = cvt_pk_bf16(qo[2], qo[3]); w.z = cvt_pk_bf16(qo[4], qo[5]); w.w = cvt_pk_bf16(qo[6], qo[7]); *(u32x4*)(gqin + go) = w;
              w.x = cvt_pk_bf16(ko[0], ko[1]); w.y = cvt_pk_bf16(ko[2], ko[3]); w.z = cvt_pk_bf16(ko[4], ko[5]); w.w = cvt_pk_bf16(ko[6], ko[7]); *(u32x4*)(gkp + go) = w;
              w.x = cvt_pk_bf16(kd[0], kd[1]); w.y = cvt_pk_bf16(kd[2], kd[3]); w.z = cvt_pk_bf16(kd[4], kd[5]); w.w = cvt_pk_bf16(kd[6], kd[7]); *(LAS u32x4*)(F.lds + GL_KD + (d * 64 + tk) * GL_P64 + k0 * 2) = w; }
          if (t < 128) dec[(size_t)((((b * 4 + h) * 2 + (t >> 6)) * 68) + j) * 64 + (t & 63)] = __expf(bl[t]); }
        if (more) GL1_LOAD_C(it + stride);
        __syncthreads();
        const int i16 = F.lane & 15, g4 = F.lane >> 4, w = F.wave;
        const unsigned va = lds_addr_of(F.lds + GL_VT) + (unsigned)((8 * g4 + (i16 >> 2)) * GL_P128 + (w * 16 + 4 * (i16 & 3)) * 2);
        const unsigned ka = lds_addr_of(F.lds + GL_KD) + (unsigned)((8 * g4 + (i16 >> 2)) * GL_P64 + (4 * (i16 & 3)) * 2);
        const bf16x8 af0 = tr_read2(va, va + 4 * GL_P128), af1 = tr_read2(va + 32 * GL_P128, va + 32 * GL_P128 + 4 * GL_P128);
#pragma unroll
        for (int d = 0; d < 2; ++d) { bf16x8 kf[8]; if (d == 0) tr_read16_kdec<0>(ka, kf); else tr_read16_kdec<64 * GL_P64>(ka, kf);
            float* up = upd + (size_t)((((b * 4 + h) * 2 + d) * 68) + j) * 8192;
#pragma unroll
            for (int kt = 0; kt < 4; ++kt) { f32x4 acc = (f32x4){0.f, 0.f, 0.f, 0.f}; acc = MFMA16(af0, kf[kt], acc); acc = MFMA16(af1, kf[4 + kt], acc);
#pragma unroll
                for (int r = 0; r < 4; ++r) up[(w * 16 + 4 * g4 + r) * 64 + kt * 16 + i16] = acc[r]; } }
    }
#undef GL1_LOAD_A
#undef GL1_LOAD_B
#undef GL1_LOAD_C
}
__device__ __forceinline__ void gla3_items(const Frame& F, int l, int first, int stride) {
    const bf16_t* __restrict__ proj = WSP(bf16_t, WS_R1); const bf16_t* __restrict__ gst = WSP(bf16_t, WS_GST); bf16_t* __restrict__ mix = WSP(bf16_t, WS_R3);
    const bf16_t* __restrict__ gqin = WSP(bf16_t, WS_GQIN); const bf16_t* __restrict__ gkp = WSP(bf16_t, WS_GKP);
    const int jlo = (l == 0) ? 0 : 4;
    const int nj = 68 - jlo; const int t = F.tid, tk = t >> 3, sg8 = t & 7;
    const int i16 = F.lane & 15, g4 = F.lane >> 4, w = F.wave, tt = w & 3, vh = w >> 2;
    u32x4 rq[2], rk[2], rs[2][2], rv[2];
#define GL3_LOAD(IT) do { const int j_ = jlo + (IT) % nj, bh_ = (IT) / nj, h_ = bh_ & 3, b_ = bh_ >> 2; const int row0_ = gla_row0(b_, j_); \
        _Pragma("unroll") for (int d = 0; d < 2; ++d) { const size_t cj = (size_t)(((b_ * 4 + h_) * 2 + d) * 68 + j_); rq[d] = *(const u32x4*)(gqin + (cj * 64 + tk) * 64 + sg8 * 8); rk[d] = *(const u32x4*)(gkp + (cj * 64 + tk) * 64 + sg8 * 8); \
            _Pragma("unroll") for (int q = 0; q < 2; ++q) { const int e = t + q * NTHR; rs[d][q] = *(const u32x4*)(gst + cj * 8192 + (size_t)(e >> 3) * 64 + (e & 7) * 8); } } \
        _Pragma("unroll") for (int q = 0; q < 2; ++q) rv[q] = *(const u32x4*)(proj + (size_t)(row0_ + tk) * NINP + C_GV + h_ * 128 + (sg8 + 8 * q) * 8); } while (0)
    if (first < 16 * nj) GL3_LOAD(first);
    for (int it = first; it < 16 * nj; it += stride) { const int j = jlo + it % nj, bh = it / nj, h = bh & 3, b = bh >> 2; const int row0 = gla_row0(b, j);
        const size_t orow = (size_t)(row0 + tt * 16 + i16);
        u32x2 rr[4]; f32x4 ng[4];
#pragma unroll
        for (int v4 = 0; v4 < 4; ++v4) { const int v = (vh * 4 + v4) * 16 + 4 * g4; rr[v4] = *(const u32x2*)(proj + orow * NINP + C_GR + h * 128 + v); ng[v4] = *(const f32x4*)(F.in[20] + l * 128 + v); }
        __syncthreads();
#pragma unroll
        for (int d = 0; d < 2; ++d) { *(LAS u32x4*)(F.lds + G3_Q + (d * 64 + tk) * GL_P64 + sg8 * 16) = rq[d]; *(LAS u32x4*)(F.lds + G3_K + (d * 64 + tk) * GL_P64 + sg8 * 16) = rk[d];
#pragma unroll
            for (int q = 0; q < 2; ++q) { const int e = t + q * NTHR; *(LAS u32x4*)(F.lds + G3_S + (d * 128 + (e >> 3)) * GL_P64 + (e & 7) * 16) = rs[d][q]; } }
#pragma unroll
        for (int q = 0; q < 2; ++q) *(LAS u32x4*)(F.lds + G3_V + tk * GL_P128 + (sg8 + 8 * q) * 16) = rv[q];
        __syncthreads();
        if (it + stride < 16 * nj) GL3_LOAD(it + stride);
        f32x4 o[4];
#pragma unroll
        for (int v4 = 0; v4 < 4; ++v4) o[v4] = (f32x4){0.f, 0.f, 0.f, 0.f};
        bf16x8 vf[8];
        tr_read16_glav<0>(lds_addr_of(F.lds + G3_V) + (unsigned)((4 * g4 + (i16 >> 2)) * GL_P128 + (vh * 64 + 4 * (i16 & 3)) * 2), vf);
#pragma unroll
        for (int d = 0; d < 2; ++d) {
            const LAS unsigned char* qb_ = F.lds + G3_Q + d * 64 * GL_P64; const LAS unsigned char* kb_ = F.lds + G3_K + d * 64 * GL_P64; const LAS unsigned char* sb_ = F.lds + G3_S + d * 128 * GL_P64;
            bf16x8 qf[2];
#pragma unroll
            for (int ks = 0; ks < 2; ++ks) qf[ks] = *(const LAS bf16x8*)(qb_ + (tt * 16 + i16) * GL_P64 + (ks * 32 + 8 * g4) * 2);
            f32x4 st[4];
#pragma unroll
            for (int s4 = 0; s4 < 4; ++s4) { st[s4] = (f32x4){0.f, 0.f, 0.f, 0.f};
#pragma unroll
                for (int ks = 0; ks < 2; ++ks) { const bf16x8 kf = *(const LAS bf16x8*)(kb_ + (s4 * 16 + i16) * GL_P64 + (ks * 32 + 8 * g4) * 2); st[s4] = MFMA16(kf, qf[ks], st[s4]); }
#pragma unroll
                for (int r = 0; r < 4; ++r) { const int s = s4 * 16 + 4 * g4 + r, tq = tt * 16 + i16; if (d == 0 ? (s > tq) : (s < tq)) st[s4][r] = 0.f; } }
#pragma unroll
            for (int ks2 = 0; ks2 < 2; ++ks2) {
                bf16x8 pf; { u32x4 t4; t4.x = cvt_pk_bf16(st[2 * ks2][0], st[2 * ks2][1]); t4.y = cvt_pk_bf16(st[2 * ks2][2], st[2 * ks2][3]); t4.z = cvt_pk_bf16(st[2 * ks2 + 1][0], st[2 * ks2 + 1][1]); t4.w = cvt_pk_bf16(st[2 * ks2 + 1][2], st[2 * ks2 + 1][3]); pf = __builtin_bit_cast(bf16x8, t4); }
#pragma unroll
                for (int v4 = 0; v4 < 4; ++v4) o[v4] = MFMA16(vf[ks2 * 4 + v4], pf, o[v4]);
            }
#pragma unroll
            for (int v4 = 0; v4 < 4; ++v4)
#pragma unroll
                for (int ks = 0; ks < 2; ++ks) { const bf16x8 sf = *(const LAS bf16x8*)(sb_ + ((vh * 4 + v4) * 16 + i16) * GL_P64 + (ks * 32 + 8 * g4) * 2); o[v4] = MFMA16(sf, qf[ks], o[v4]); }
        }
        float ss = 0.f;
#pragma unroll
        for (int v4 = 0; v4 < 4; ++v4)
#pragma unroll
            for (int r = 0; r < 4; ++r) ss += o[v4][r] * o[v4][r];
        ss += shx<16>(ss); ss += shx<32>(ss);
        LAS float* ssq = (LAS float*)(F.lds + G3_SSQ);
        if (g4 == 0) ssq[vh * 64 + tt * 16 + i16] = ss;
        __syncthreads();
        const float rinv = rsqrtf((ssq[tt * 16 + i16] + ssq[64 + tt * 16 + i16]) * (1.0f / 128.0f) + LN_EPS);
#pragma unroll
        for (int v4 = 0; v4 < 4; ++v4) { const int v = (vh * 4 + v4) * 16 + 4 * g4; const float r0 = bflo(rr[v4].x), r1 = bfhi(rr[v4].x), r2 = bflo(rr[v4].y), r3 = bfhi(rr[v4].y);
            u32x2 wv; wv.x = cvt_pk_bf16(o[v4][0] * rinv * ng[v4][0] * siluf_(r0), o[v4][1] * rinv * ng[v4][1] * siluf_(r1)); wv.y = cvt_pk_bf16(o[v4][2] * rinv * ng[v4][2] * siluf_(r2), o[v4][3] * rinv * ng[v4][3] * siluf_(r3));
            *(u32x2*)(mix + orow * DM + 1536 + h * 128 + v) = wv; }
    }
#undef GL3_LOAD
}
__device__ __forceinline__ void row_stats1(const float (&v)[32], float& mu, float& rstd) {
    float s = 0.f, q = 0.f;
#pragma unroll
    for (int i = 0; i < 32; ++i) { s += v[i]; q += v[i] * v[i]; }
    s = wave_sum_dpp(s); q = wave_sum_dpp(q);
    mu = s * (1.0f / 2048.0f); const float var = fmaxf(q * (1.0f / 2048.0f) - mu * mu, 0.f); rstd = rsqrtf(var + LN_EPS);
}
__device__ __forceinline__ void phase_ln_mid(const Frame& F, int l) {
    float alpha_ = ALPHA; asm volatile("" : "+v"(alpha_));
    const int nrows = (l == 0) ? MT : NLAT;
    const float* __restrict__ mod = WSP(float, WS_MOD) + (size_t)l * 5 * 12288; const bf16_t* __restrict__ Y = WSP(bf16_t, WS_R2);
    LAS float* Rt = (LAS float*)F.lds;
    { const float* __restrict__ rp = F.in[26] + (size_t)l * 2048 * 16; f32x4 rv[16];
#pragma unroll
      for (int q = 0; q < 16; ++q) rv[q] = *(const f32x4*)(rp + (size_t)(F.tid + NTHR * q) * 4);
#pragma unroll
      for (int q = 0; q < 16; ++q) { const int e4 = F.tid + NTHR * q, c = e4 >> 2, x4 = (e4 & 3) * 4; Rt[(x4 + 0) * 2048 + c] = rv[q][0]; Rt[(x4 + 1) * 2048 + c] = rv[q][1]; Rt[(x4 + 2) * 2048 + c] = rv[q][2]; Rt[(x4 + 3) * 2048 + c] = rv[q][3]; } }
    __syncthreads();
    const float* __restrict__ g1 = F.in[22] + l * DM; const float* __restrict__ b1 = F.in[23] + l * DM;
    bf16_t* __restrict__ X1 = WSP(bf16_t, WS_X1); bf16_t* __restrict__ H = WSP(bf16_t, WS_H);
#define LNM_XIN(r) ((r) < NLAT ? F.in[0] + (size_t)(r) * DM : F.in[2] + (size_t)((r) - NLAT) * DM)
#define LNM_XLOAD(r) do { if (l == 0) { const float* __restrict__ xin = LNM_XIN(r); _Pragma("unroll") for (int i = 0; i < 8; ++i) xa[i] = *(const f32x4*)(xin + (i * 64 + F.lane) * 4); } \
        else { const bf16_t* __restrict__ xin = WSP(bf16_t, WS_X2B) + (size_t)(r) * DM; _Pragma("unroll") for (int i = 0; i < 8; ++i) { const u32x2 t_ = *(const u32x2*)(xin + (i * 64 + F.lane) * 4); xa[i][0] = __uint_as_float(t_.x); xa[i][1] = __uint_as_float(t_.y); } } \
        _Pragma("unroll") for (int i = 0; i < 8; ++i) ya[i] = *(const u32x2*)(Y + (size_t)(r) * DM + (i * 64 + F.lane) * 4); } while (0)
    f32x4 xa[8]; u32x2 ya[8];
#pragma unroll
    for (int i = 0; i < 8; ++i) xa[i] = (f32x4){0.f, 0.f, 0.f, 0.f};
    const int ntrip = ROWMAP_NTRIP(nrows);
    { const int row = ROWMAP_ROW(0, nrows); if (row >= 0) LNM_XLOAD(row); }
    LAS float* Vgt1 = (LAS float*)(F.lds + 131072); LAS float* Vsc2 = Vgt1 + 2048; LAS float* Vsh2 = Vsc2 + 2048;
    int bcur = -1;
    for (int k = 0; k < ntrip; ++k) {
        const int row = ROWMAP_ROW(k, nrows), b = ROWMAP_BATCH(k);
        if (b != bcur) { bcur = b; __syncthreads();
            { const float* mb = mod + (size_t)b * 12288; const int c0 = F.tid * 4; *(LAS f32x4*)(Vgt1 + c0) = *(const f32x4*)(mb + 4096 + c0); *(LAS f32x4*)(Vsc2 + c0) = *(const f32x4*)(mb + 8192 + c0); *(LAS f32x4*)(Vsh2 + c0) = *(const f32x4*)(mb + 6144 + c0); }
            __syncthreads(); }
        float v[32];
        { f32x4 ga[8];
#pragma unroll
          for (int i = 0; i < 8; ++i) ga[i] = *(const LAS f32x4*)(Vgt1 + (i * 64 + F.lane) * 4);
#pragma unroll
          for (int i = 0; i < 8; ++i) { float x0 = xa[i][0], x1 = xa[i][1], x2 = xa[i][2], x3 = xa[i][3];
              if (l != 0) { const unsigned p0 = __float_as_uint(xa[i][0]), p1 = __float_as_uint(xa[i][1]); x0 = bflo(p0); x1 = bfhi(p0); x2 = bflo(p1); x3 = bfhi(p1); }
              v[i * 4] = alpha_ * x0 + ga[i][0] * bflo(ya[i].x); v[i * 4 + 1] = alpha_ * x1 + ga[i][1] * bfhi(ya[i].x); v[i * 4 + 2] = alpha_ * x2 + ga[i][2] * bflo(ya[i].y); v[i * 4 + 3] = alpha_ * x3 + ga[i][3] * bfhi(ya[i].y); } }
        { const int nrow = (k + 1 < ntrip) ? ROWMAP_ROW(k + 1, nrows) : -1; if (nrow >= 0) LNM_XLOAD(nrow); }
        if (row < 0) continue;
        f32x4 gg[8], bb[8];
#pragma unroll
        for (int i = 0; i < 8; ++i) { const int c0 = (i * 64 + F.lane) * 4; gg[i] = *(const f32x4*)(g1 + c0); bb[i] = *(const f32x4*)(b1 + c0); }
        float mu, rstd; row_stats1(v, mu, rstd);
#pragma unroll
        for (int i = 0; i < 8; ++i) { const int c0 = (i * 64 + F.lane) * 4; f32x4 o;
#pragma unroll
            for (int c = 0; c < 4; ++c) { o[c] = (v[i * 4 + c] - mu) * rstd * gg[i][c] + bb[i][c]; v[i * 4 + c] = o[c]; }
            u32x2 w1; w1.x = cvt_pk_bf16(o[0], o[1]); w1.y = cvt_pk_bf16(o[2], o[3]); *(u32x2*)(X1 + (size_t)row * DM + c0) = w1; }
#pragma unroll
        for (int i = 0; i < 8; ++i) { const int c0 = (i * 64 + F.lane) * 4; gg[i] = *(const LAS f32x4*)(Vsc2 + c0); bb[i] = *(const LAS f32x4*)(Vsh2 + c0); }
        row_stats1(v, mu, rstd);
#pragma unroll
        for (int i = 0; i < 8; ++i) { const int c0 = (i * 64 + F.lane) * 4;
#pragma unroll
            for (int c = 0; c < 4; ++c) v[i * 4 + c] = (v[i * 4 + c] - mu) * rstd * (1.f + gg[i][c]) + bb[i][c];
            u32x2 w; w.x = cvt_pk_bf16(v[i * 4], v[i * 4 + 1]); w.y = cvt_pk_bf16(v[i * 4 + 2], v[i * 4 + 3]); *(u32x2*)(H + (size_t)row * DM + c0) = w; }
        float s16[16];
#pragma unroll
        for (int x = 0; x < 16; ++x) { float s = 0.f;
#pragma unroll
            for (int i = 0; i < 8; ++i) { const f32x4 r = *(const LAS f32x4*)(Rt + x * 2048 + (i * 64 + F.lane) * 4); s += v[i * 4] * r[0] + v[i * 4 + 1] * r[1] + v[i * 4 + 2] * r[2] + v[i * 4 + 3] * r[3]; }
            s16[x] = s; if ((x & 3) == 3) __builtin_amdgcn_sched_barrier(0); }
        float t8[8], t4[4], t2[2], t1;
        { const bool hi = (F.lane & 32) != 0;
#pragma unroll
          for (int j = 0; j < 8; ++j) { const float send = hi ? s16[j] : s16[8 + j], keep = hi ? s16[8 + j] : s16[j]; t8[j] = keep + shx<32>(send); } }
        { const bool hi = (F.lane & 16) != 0;
#pragma unroll
          for (int j = 0; j < 4; ++j) { const float send = hi ? t8[j] : t8[4 + j], keep = hi ? t8[4 + j] : t8[j]; t4[j] = keep + shx<16>(send); } }
        { const bool hi = (F.lane & 8) != 0;
#pragma unroll
          for (int j = 0; j < 2; ++j) { const float send = hi ? t4[j] : t4[2 + j], keep = hi ? t4[2 + j] : t4[j]; t2[j] = keep + shx<8>(send); } }
        { const bool hi = (F.lane & 4) != 0; const float send = hi ? t2[0] : t2[1], keep = hi ? t2[1] : t2[0]; t1 = keep + shx<4>(send); }
        t1 += shx<2>(t1); t1 += shx<1>(t1);
        const int xid = ((F.lane >> 5) & 1) * 8 + ((F.lane >> 4) & 1) * 4 + ((F.lane >> 3) & 1) * 2 + ((F.lane >> 2) & 1);
        float mx = t1; mx = fmaxf(mx, shx<4>(mx)); mx = fmaxf(mx, shx<8>(mx)); mx = fmaxf(mx, shx<16>(mx)); mx = fmaxf(mx, shx<32>(mx));
        const float ex = __expf(t1 - mx); float sm = ex; sm += shx<4>(sm); sm += shx<8>(sm); sm += shx<16>(sm); sm += shx<32>(sm);
        if ((F.lane & 3) == 0) WSP(float, WS_AFF)[(size_t)row * 16 + xid] = ex / sm;
    }
#undef LNM_XIN
#undef LNM_XLOAD
    __syncthreads();
}
__device__ __forceinline__ void phase_topk(const Frame& F, int l) {
    LAS unsigned* keys = (LAS unsigned*)F.lds;
    LAS unsigned* hist = keys + 4096;
    LAS unsigned* misc = hist + 256;
    const float* aff = WSP(float, WS_AFF); int* tokslot = WSP(int, WS_TOKSLOT); int* seltok = WSP(int, WS_SELTOK); unsigned short* vt16 = WSP(unsigned short, WS_VT);
    const int nitem = (l == 0) ? 128 : 64;
    if (l == 0 && F.bid >= F.G - NE) { const int e = F.bid - (F.G - NE), kr2 = F.tid >> 5, c42 = F.tid & 31; *(unsigned*)(vt16 + ((e * 9 + 8) * 4096 + kr2 * 256 + 8 * (c42 ^ pg8::g8swz_(kr2))) / 2 + 2) = 0u; }
    for (int it = F.bid; it < nitem; it += F.G) { const int set = it >> 6, b = (it >> 4) & 3, e = it & 15;
        const int n = set == 0 ? SEQ : CTXL, cap = set == 0 ? 512 : 32, base = set == 0 ? b * SEQ : NLAT + b * CTXL;
        __syncthreads();
        for (int i = F.tid; i < n; i += NTHR) keys[i] = __float_as_uint(aff[(size_t)(base + i) * 16 + e]);
        if (F.tid == 0) { misc[0] = 0u; misc[1] = (unsigned)cap; }
        __syncthreads();
        for (int pass = 0; pass < 4; ++pass) { const int shift = 24 - 8 * pass; const unsigned himask = pass == 0 ? 0u : (0xffffffffu << (shift + 8));
            if (F.tid < 256) hist[F.tid] = 0u;
            __syncthreads();
            const unsigned prefix = misc[0];
            for (int i = F.tid; i < n; i += NTHR) { const unsigned k = keys[i]; if ((k & himask) == prefix) __hip_atomic_fetch_add(&hist[(k >> shift) & 255u], 1u, __ATOMIC_RELAXED, __HIP_MEMORY_SCOPE_WORKGROUP); }
            __syncthreads();
            { const unsigned rem = misc[1];
              unsigned hc = (F.tid < 256) ? hist[255 - F.tid] : 0u, inc = hc;
              for (int o = 1; o < 64; o <<= 1) { const unsigned a = __shfl_up(inc, o); if (F.lane >= o) inc += a; }
              if (F.lane == 63) misc[40 + F.wave] = inc;
              __syncthreads();
              unsigned off = 0; for (int w2 = 0; w2 < F.wave; ++w2) off += misc[40 + w2];
              inc += off;
              if (F.tid < 256 && inc >= rem && inc - hc < rem) { misc[0] = prefix | ((unsigned)(255 - F.tid) << shift); misc[1] = rem - (inc - hc); } }
            __syncthreads();
        }
        const unsigned thr = misc[0], take_eq = misc[1];
        const int per = n / NTHR; unsigned cg = 0, ce = 0;
        const int i0 = per ? F.tid * per : F.tid, cnt = per ? per : (F.tid < n ? 1 : 0);
        for (int q = 0; q < cnt; ++q) { const unsigned k = keys[i0 + q]; cg += (k > thr); ce += (k == thr); }
        unsigned sg = cg, se = ce;
        for (int o = 1; o < 64; o <<= 1) { const unsigned a = __shfl_up(sg, o), c2 = __shfl_up(se, o); if (F.lane >= o) { sg += a; se += c2; } }
        if (F.lane == 63) { misc[8 + F.wave] = sg; misc[24 + F.wave] = se; }
        __syncthreads();
        unsigned og = 0, oe = 0; for (int w2 = 0; w2 < F.wave; ++w2) { og += misc[8 + w2]; oe += misc[24 + w2]; }
        unsigned pg = og + sg - cg, pe = oe + se - ce;
        for (int q = 0; q < cnt; ++q) { const int i = i0 + q; const unsigned k = keys[i]; const bool sel = (k > thr) || (k == thr && pe < take_eq);
            const unsigned slot = pg + (pe < take_eq ? pe : take_eq);
            const int erow = set == 0 ? b * 512 + (int)slot : 2048 + b * 32 + (int)slot;
            tokslot[(size_t)(base + i) * 16 + e] = sel ? erow : -1;
            if (sel) { seltok[e * ER + erow] = base + i;
                const int pm = e * 9 + (erow >> 8), rr = erow & 255, R = rr & 63, sl = (rr >> 7) * 2 + ((rr >> 6) & 1);
#pragma unroll
                for (int q8 = 0; q8 < 8; ++q8) { const int t2 = ((R >> 4) * 2 + (q8 >> 2)) * 64 + (R & 15) * 4 + (q8 & 3), kr2 = t2 >> 5, c42 = t2 & 31;
                    vt16[(pm * 4096 + kr2 * 256 + 8 * (c42 ^ pg8::g8swz_(kr2))) / 2 + sl] = (unsigned short)(base + i); } }
            pg += (k > thr); pe += (k == thr); }
    }
    __syncthreads();
}
__device__ __forceinline__ void phase_gather(const Frame& F, int l) {
    const int valid = (l == 0) ? 2176 : 2048, rows = (l == 0) ? ER : 2048;
    const int* __restrict__ seltok = WSP(int, WS_SELTOK); const bf16_t* __restrict__ H = WSP(bf16_t, WS_H); bf16_t* __restrict__ xe = WSP(bf16_t, WS_R2);
    const int n = NE * rows, step = F.G * 8;
    for (int it = F.bid * 8 + F.wave; it < n; it += 4 * step) {
        int tok[4]; bf16_t* dst[4];
#pragma unroll
        for (int u = 0; u < 4; ++u) { const int i = it + u * step; tok[u] = -1; dst[u] = xe;
            if (i < n) { const int e = i / rows, r = i % rows; dst[u] = xe + (size_t)(e * ER + r) * DM; tok[u] = (r < valid) ? seltok[e * ER + r] : -2; } }
        u32x4 v[4][4];
#pragma unroll
        for (int u = 0; u < 4; ++u) { const bf16_t* src = H + (size_t)(tok[u] >= 0 ? tok[u] : 0) * DM;
#pragma unroll
            for (int q = 0; q < 4; ++q) v[u][q] = *(const u32x4*)(src + (q * 64 + F.lane) * 8); }
#pragma unroll
        for (int u = 0; u < 4; ++u) if (tok[u] != -1) {
#pragma unroll
            for (int q = 0; q < 4; ++q) *(u32x4*)(dst[u] + (q * 64 + F.lane) * 8) = (tok[u] >= 0) ? v[u][q] : (u32x4){0u, 0u, 0u, 0u}; }
    }
}
__device__ __forceinline__ void phase_combine(const Frame& F, int l) {
    float alpha_ = ALPHA; asm volatile("" : "+v"(alpha_));
    const int nrows = (l == 0) ? MT : NLAT;
    const float* mod = WSP(float, WS_MOD) + (size_t)l * 5 * 12288; const float* modn = WSP(float, WS_MOD) + (size_t)5 * 12288;
    const float* aff = WSP(float, WS_AFF); const int* tokslot = WSP(int, WS_TOKSLOT); const bf16_t* ye = WSP(bf16_t, WS_R3);
    const float* g2 = F.in[24] + l * DM; const float* b2 = F.in[25] + l * DM;
    LAS float* Vg2 = (LAS float*)F.lds; LAS float* Vb2 = Vg2 + 2048; LAS float* Vgt2 = Vb2 + 2048; LAS float* Vsh = Vgt2 + 2048; LAS float* Vsc = Vsh + 2048;
    __syncthreads();
    { const int c0 = F.tid * 4; *(LAS f32x4*)(Vg2 + c0) = *(const f32x4*)(g2 + c0); *(LAS f32x4*)(Vb2 + c0) = *(const f32x4*)(b2 + c0); }
    int bcur = -1;
    int myslot = -1; float myg = 0.f; u32x4 xv[4];
    const int ntrip = ROWMAP_NTRIP(nrows);
    { const int row = ROWMAP_ROW(0, nrows); if (row >= 0) { if (F.lane < 16) { myslot = tokslot[(size_t)row * 16 + F.lane]; myg = aff[(size_t)row * 16 + F.lane]; }
        const bf16_t* xp = WSP(bf16_t, WS_X1) + (size_t)row * DM;
#pragma unroll
        for (int i = 0; i < 4; ++i) xv[i] = *(const u32x4*)(xp + (i * 64 + F.lane) * 8); } }
    for (int k = 0; k < ntrip; ++k) {
        const int row = ROWMAP_ROW(k, nrows), b = ROWMAP_BATCH(k);
        if (b != bcur) { bcur = b; __syncthreads();
            { const int c0 = F.tid * 4; *(LAS f32x4*)(Vgt2 + c0) = *(const f32x4*)(mod + (size_t)b * 12288 + 10240 + c0);
              if (l == 0) { *(LAS f32x4*)(Vsh + c0) = *(const f32x4*)(modn + (size_t)b * 12288 + c0); *(LAS f32x4*)(Vsc + c0) = *(const f32x4*)(modn + (size_t)b * 12288 + 2048 + c0); } }
            __syncthreads(); }
        float v[32];
#pragma unroll
        for (int i = 0; i < 4; ++i) { v[i * 8] = bflo(xv[i].x); v[i * 8 + 1] = bfhi(xv[i].x); v[i * 8 + 2] = bflo(xv[i].y); v[i * 8 + 3] = bfhi(xv[i].y); v[i * 8 + 4] = bflo(xv[i].z); v[i * 8 + 5] = bfhi(xv[i].z); v[i * 8 + 6] = bflo(xv[i].w); v[i * 8 + 7] = bfhi(xv[i].w); }
        const int cslot = myslot; const float cg = myg;
        { const int nrow = (k + 1 < ntrip) ? ROWMAP_ROW(k + 1, nrows) : -1; if (nrow >= 0) {
            if (F.lane < 16) { myslot = tokslot[(size_t)nrow * 16 + F.lane]; myg = aff[(size_t)nrow * 16 + F.lane]; }
            const bf16_t* xp = WSP(bf16_t, WS_X1) + (size_t)nrow * DM;
#pragma unroll
            for (int i = 0; i < 4; ++i) xv[i] = *(const u32x4*)(xp + (i * 64 + F.lane) * 8); } }
        if (row < 0) continue;
        float f[32];
#pragma unroll
        for (int i = 0; i < 32; ++i) f[i] = 0.f;
        unsigned long long msk = __ballot(cslot >= 0);
        while (msk) {
            const int e0 = __builtin_ctzll(msk); msk &= msk - 1; const int e1 = msk ? __builtin_ctzll(msk) : e0; const bool two = msk != 0; msk &= msk - 1;
            const int s0 = __builtin_amdgcn_readlane(cslot, e0), s1 = __builtin_amdgcn_readlane(cslot, e1);
            const float w0 = __int_as_float(__builtin_amdgcn_readlane(__float_as_int(cg), e0)), w1 = two ? __int_as_float(__builtin_amdgcn_readlane(__float_as_int(cg), e1)) : 0.f;
            const bf16_t* y0 = ye + (size_t)(e0 * ER + s0) * DM; const bf16_t* y1 = ye + (size_t)(e1 * ER + s1) * DM;
            u32x4 a[4], c[4];
#pragma unroll
            for (int i = 0; i < 4; ++i) { a[i] = *(const u32x4*)(y0 + (i * 64 + F.lane) * 8); c[i] = *(const u32x4*)(y1 + (i * 64 + F.lane) * 8); }
#pragma unroll
            for (int i = 0; i < 4; ++i) {
                f[i * 8 + 0] += w0 * bflo(a[i].x) + w1 * bflo(c[i].x); f[i * 8 + 1] += w0 * bfhi(a[i].x) + w1 * bfhi(c[i].x);
                f[i * 8 + 2] += w0 * bflo(a[i].y) + w1 * bflo(c[i].y); f[i * 8 + 3] += w0 * bfhi(a[i].y) + w1 * bfhi(c[i].y);
                f[i * 8 + 4] += w0 * bflo(a[i].z) + w1 * bflo(c[i].z); f[i * 8 + 5] += w0 * bfhi(a[i].z) + w1 * bfhi(c[i].z);
                f[i * 8 + 6] += w0 * bflo(a[i].w) + w1 * bflo(c[i].w); f[i * 8 + 7] += w0 * bfhi(a[i].w) + w1 * bfhi(c[i].w); }
        }
#pragma unroll
        for (int i = 0; i < 4; ++i) { const f32x4 ga = *(const LAS f32x4*)(Vgt2 + (i * 64 + F.lane) * 8), gc = *(const LAS f32x4*)(Vgt2 + (i * 64 + F.lane) * 8 + 4);
#pragma unroll
            for (int c = 0; c < 4; ++c) { v[i * 8 + c] = alpha_ * v[i * 8 + c] + ga[c] * f[i * 8 + c]; v[i * 8 + 4 + c] = alpha_ * v[i * 8 + 4 + c] + gc[c] * f[i * 8 + 4 + c]; } }
        float mu, rstd; row_stats1(v, mu, rstd);
        float* xo = F.out + (size_t)row * DM; bf16_t* xb = WSP(bf16_t, WS_X2B) + (size_t)row * DM;
#pragma unroll
        for (int i = 0; i < 4; ++i) { const int c0 = (i * 64 + F.lane) * 8;
#pragma unroll
            for (int hh = 0; hh < 2; ++hh) { const f32x4 gg = *(const LAS f32x4*)(Vg2 + c0 + hh * 4), bb = *(const LAS f32x4*)(Vb2 + c0 + hh * 4); f32x4 o;
#pragma unroll
                for (int c = 0; c < 4; ++c) { o[c] = (v[i * 8 + hh * 4 + c] - mu) * rstd * gg[c] + bb[c]; v[i * 8 + hh * 4 + c] = o[c]; }
                if (l != 0) *(f32x4*)(xo + c0 + hh * 4) = o; }
            if (l == 0 && row < NLAT) { u32x4 w; w.x = cvt_pk_bf16(v[i * 8], v[i * 8 + 1]); w.y = cvt_pk_bf16(v[i * 8 + 2], v[i * 8 + 3]); w.z = cvt_pk_bf16(v[i * 8 + 4], v[i * 8 + 5]); w.w = cvt_pk_bf16(v[i * 8 + 6], v[i * 8 + 7]); *(u32x4*)(xb + c0) = w; } }
        if (l == 0) { row_stats1(v, mu, rstd); bf16_t* hd = WSP(bf16_t, WS_H) + (size_t)row * DM;
#pragma unroll
            for (int i = 0; i < 4; ++i) { const int c0 = (i * 64 + F.lane) * 8; float o[8];
#pragma unroll
                for (int hh = 0; hh < 2; ++hh) { const f32x4 a = *(const LAS f32x4*)(Vsc + c0 + hh * 4), bq = *(const LAS f32x4*)(Vsh + c0 + hh * 4);
#pragma unroll
                    for (int c = 0; c < 4; ++c) o[hh * 4 + c] = (v[i * 8 + hh * 4 + c] - mu) * rstd * (1.f + a[c]) + bq[c]; }
                u32x4 w; w.x = cvt_pk_bf16(o[0], o[1]); w.y = cvt_pk_bf16(o[2], o[3]); w.z = cvt_pk_bf16(o[4], o[5]); w.w = cvt_pk_bf16(o[6], o[7]); *(u32x4*)(hd + c0) = w; } }
    }
    __syncthreads();
}
#ifndef PROBE_SUB
#define PROBE_SUB 0
#endif
__device__ __forceinline__ void s5_scan2(const Frame& F, int l, int first_thread, int nthreads) {
    const float* __restrict__ S = WSP(float, WS_S5S); bf16_t* __restrict__ SI = WSP(bf16_t, WS_S5IN);
    for (int e = first_thread; e < 4 * 32 * 128; e += nthreads) { const int p = e & 63, d = (e >> 6) & 1, g = (e >> 7) & 31, b = e >> 12;
        const f32x2 lt = WSP(f32x2, WS_LAMT)[((size_t)(l * 32 + g) * 2 + d) * 64 + p];
        float sx = 0.f, sy = 0.f; const size_t co = (size_t)g * 256 + d * 128 + p * 2;
#define S5S_ROW(i) (((i) < 8) ? (512 + b * 8 + (d == 0 ? (i) : 7 - (i))) : (b * 128 + (d == 0 ? ((i) - 8) : 127 - ((i) - 8))))
        for (int i0 = 0; i0 < 136; i0 += 34) { f32x2 sv[34];
#pragma unroll
            for (int q = 0; q < 34; ++q) { const int r = S5S_ROW(i0 + q); sv[q] = *(const f32x2*)(S + ((unsigned)r * 8192u + (unsigned)co)); }
#pragma unroll
            for (int q = 0; q < 34; ++q) { const int r = S5S_ROW(i0 + q); *(unsigned*)(SI + ((unsigned)r * 8192u + (unsigned)co)) = cvt_pk_bf16(sx, sy);
                const float nx = lt.x * sx - lt.y * sy + sv[q].x, ny = lt.x * sy + lt.y * sx + sv[q].y; sx = nx; sy = ny; } }
#undef S5S_ROW
    }
}
template <int NEL>
__device__ __forceinline__ void gla_scan_n(const float* __restrict__ upd, const float* __restrict__ dec, bf16_t* __restrict__ st, int e0, int es) {
    int el[NEL], bhd[NEL], d[NEL], k[NEL]; float s[NEL];
#pragma unroll
    for (int a = 0; a < NEL; ++a) { const int e = e0 + a * es; el[a] = e & 8191; bhd[a] = e >> 13; d[a] = bhd[a] & 1; k[a] = el[a] & 63; s[a] = 0.f; }
    for (int p0 = 0; p0 < 68; p0 += 17) { float u[NEL][17], dc[NEL][17];
#pragma unroll
        for (int q = 0; q < 17; ++q)
#pragma unroll
            for (int a = 0; a < NEL; ++a) { const int pos = p0 + q; const int j = d[a] == 0 ? pos : (pos < 4 ? 3 - pos : 71 - pos); const unsigned base = (unsigned)(bhd[a] * 68 + j); u[a][q] = upd[base * 8192u + (unsigned)el[a]]; dc[a][q] = dec[base * 64u + (unsigned)k[a]]; }
#pragma unroll
        for (int q = 0; q < 17; ++q)
#pragma unroll
            for (int a = 0; a < NEL; ++a) { const int pos = p0 + q; const int j = d[a] == 0 ? pos : (pos < 4 ? 3 - pos : 71 - pos); const unsigned base = (unsigned)(bhd[a] * 68 + j); st[base * 8192u + (unsigned)el[a]] = f2bf(s[a]); s[a] = dc[a][q] * s[a] + u[a][q]; } }
}
__device__ __forceinline__ void gla_scan2(const Frame& F, int first_thread, int nthreads) {
    const float* __restrict__ upd = WSP(float, WS_R3 + (size_t)MT * DM * 2 + (size_t)MT * 512 * 2); const float* __restrict__ dec = WSP(float, WS_GDEC); bf16_t* __restrict__ st = WSP(bf16_t, WS_GST);
    const int N = 32 * 8192;
    for (int e = first_thread; e < N; e += 3 * nthreads) {
        if (e + 2 * nthreads < N) gla_scan_n<3>(upd, dec, st, e, nthreads);
        else if (e + nthreads < N) gla_scan_n<2>(upd, dec, st, e, nthreads);
        else gla_scan_n<1>(upd, dec, st, e, nthreads); }
}

#define XB_TMO      128
#define XB_XCNT(j)  (256  + 64 * (j))
#define XB_XSUB(j)  (1280 + 64 * (j))
#define XB_XGEN(j)  (2304 + 64 * (j))
#define XB_TOP      3328
#define XB_TOPGEN   3392
#define XCD_BAR_WORDS 3456
#define XB_SPIN_CAP (1u << 18)

__device__ __forceinline__ unsigned xb_ld(unsigned* p)              { return __hip_atomic_load(p, __ATOMIC_RELAXED, __HIP_MEMORY_SCOPE_AGENT); }
__device__ __forceinline__ unsigned xb_add(unsigned* p, unsigned v) { return __hip_atomic_fetch_add(p, v, __ATOMIC_RELAXED, __HIP_MEMORY_SCOPE_AGENT); }
__device__ __forceinline__ unsigned xb_xcc_id() { return (unsigned)__builtin_amdgcn_s_getreg((3 << 11) | 20) & 0xFu; }
#define XB_SPIN(cond, bar) do { unsigned _sp = 0; while (cond) { __builtin_amdgcn_s_sleep(1); \
    if ((++_sp & 255u) == 0u) { if (xb_ld(&(bar)[XB_TMO])) break; if (_sp > XB_SPIN_CAP) { atomicAdd(&(bar)[XB_TMO], 1u); break; } } } } while (0)

struct XcdBarrier {
    unsigned* bar; unsigned x;
    volatile LAS unsigned* st;
};

__device__ __forceinline__ XcdBarrier xcd_barrier_post(unsigned* bar, volatile LAS unsigned* st) {
    XcdBarrier b; b.bar = bar; b.x = xb_xcc_id(); b.st = st;
    if (threadIdx.x == 0) (void)xb_add(&bar[XB_XCNT(b.x)], 1u);
    return b;
}
__device__ __forceinline__ void xcd_barrier_complete(unsigned* bar, unsigned x, unsigned& nloc, unsigned& nx) {
    const unsigned G = gridDim.x * gridDim.y * gridDim.z;
    unsigned sum, cnt, mine, sp = 0u;
    for (;;) {
        sum = 0u; cnt = 0u; mine = 0u;
#pragma unroll
        for (unsigned j = 0; j < 16; ++j) { const unsigned c = xb_ld(&bar[XB_XCNT(j)]); sum += c; cnt += (c > 0u) ? 1u : 0u; mine = (j == x) ? c : mine; }
        if (sum == G) break;
        __builtin_amdgcn_s_sleep(1);
        if ((++sp & 255u) == 0u) { if (xb_ld(&bar[XB_TMO])) break; if (sp > XB_SPIN_CAP) { atomicAdd(&bar[XB_TMO], 1u); break; } }
    }
    nloc = mine > 0u ? mine : 1u; nx = cnt > 0u ? cnt : 1u;
}

__device__ __forceinline__ void xcd_barrier(const XcdBarrier& b) {
    asm volatile("s_waitcnt vmcnt(0)" ::: "memory");
    __syncthreads();
    if (threadIdx.x == 0) {
        unsigned* bar = b.bar;
        __builtin_amdgcn_s_waitcnt(0);
        unsigned nloc = b.st[0], nx = b.st[1];
        if (nloc == 0u) { xcd_barrier_complete(bar, b.x, nloc, nx); b.st[0] = nloc; b.st[1] = nx; }
        const unsigned old = xb_add(&bar[XB_XSUB(b.x)], 1u);
        const unsigned gen = old / nloc;
        if (old + 1u == (gen + 1u) * nloc) {
            __builtin_amdgcn_fence(__ATOMIC_RELEASE, "agent");
            asm volatile("s_waitcnt vmcnt(0)" ::: "memory");
            const unsigned og = xb_add(&bar[XB_TOP], 1u);
            const unsigned tg = og / nx;
            if (og + 1u == (tg + 1u) * nx) xb_add(&bar[XB_TOPGEN], 1u);
            else XB_SPIN(xb_ld(&bar[XB_TOPGEN]) == tg, bar);
            __builtin_amdgcn_fence(__ATOMIC_ACQUIRE, "agent");
            xb_add(&bar[XB_XGEN(b.x)], 1u);
            asm volatile("s_waitcnt vmcnt(0)" ::: "memory");
        } else {
            XB_SPIN(xb_ld(&bar[XB_XGEN(b.x)]) == gen, bar);
            __builtin_amdgcn_fence(__ATOMIC_ACQUIRE, "agent");
            asm volatile("s_waitcnt vmcnt(0)" ::: "memory");
        }
    }
    __syncthreads();
}


__device__ __forceinline__ int wrapadd(int a, int b, int n) { int x = a + (b < n ? b : 0); return x >= n ? x - n : x; }
__device__ __forceinline__ void conv_share(int c, int G, int NU, int& q0, int& q1) { int g_; asm volatile("v_mov_b32 %0, %1" : "=v"(g_) : "s"(G)); q0 = __builtin_amdgcn_readfirstlane((int)((long)c * NU / g_)); q1 = __builtin_amdgcn_readfirstlane((int)((long)(c + 1) * NU / g_)); }
constexpr int N_PHASES = 27;
__global__ void __launch_bounds__(NTHR, 2) mega_fwd(Args args) {
    extern __shared__ __attribute__((aligned(16))) unsigned char lds_raw[];
    Frame F; F.in = args.in; F.out = args.out; F.ws = args.ws; F.lds = (LAS unsigned char*)lds_raw;
    F.tid = threadIdx.x; F.lane = F.tid & 63; F.wave = __builtin_amdgcn_readfirstlane(F.tid >> 6); F.G = gridDim.x; F.bid = blockIdx.x;
    const int wave0_ = __builtin_amdgcn_readfirstlane((int)threadIdx.x >> 6);
#define FRESH() do { int t_; asm volatile("v_mbcnt_lo_u32_b32 %0, -1, 0\n\tv_mbcnt_hi_u32_b32 %0, -1, %0" : "=v"(t_)); t_ |= (wave0_ << 6); F.tid = t_; F.lane = t_ & 63; F.wave = __builtin_amdgcn_readfirstlane(t_ >> 6); { const void* ka_ = (const void*)__builtin_amdgcn_kernarg_segment_ptr(); unsigned char* w_; float* o_; asm volatile("s_load_dwordx2 %0, %2, 0xf8\n\ts_load_dwordx2 %1, %2, 0xf0\n\ts_waitcnt lgkmcnt(0)" : "=&s"(w_), "=&s"(o_) : "s"(ka_) : "memory"); F.ws = w_; F.out = o_; F.bid = blockIdx.x; } } while (0)
    const int lo = args.ph_lo, hi = args.ph_hi;
    const bool fused = (hi - lo) > 1;
    if (F.tid == 0) *(LAS u32x4*)(F.lds + LDS_BAR_OFF) = (u32x4){0u, 0u, 0u, 0u};
    __syncthreads();
    XcdBarrier bar; bar.bar = (unsigned*)(F.ws + WS_CTL); bar.x = 0; bar.st = nullptr;
    if (fused) bar = xcd_barrier_post((unsigned*)(F.ws + WS_CTL), (volatile LAS unsigned*)(F.lds + LDS_BAR_OFF));
#ifdef ONLY_PHASE
#define IN(k) (((k) == ONLY_PHASE || (k) == ONLY_PHASE + 12) && lo <= (k) && (k) < hi)
#else
#define IN(k) (lo <= (k) && (k) < hi)
#endif
#define SEAM(k) do { if (IN((k) + 1)) xcd_barrier(bar); } while (0)
#ifndef PROBE_REP
#define PROBE_REP 0
#endif
#define NREP(bit) (((PROBE_REP >> (bit)) & 1) ? 2 : 1)
    if (IN(0)) { FRESH(); phase_prologue(F); SEAM(0); }
    if (IN(1)) { FRESH(); phase_mod_reduce(F); SEAM(1); }
    if (IN(2)) { FRESH(); phase_ln1_first(F); SEAM(2); }
    for (int l = 0; l < 2; ++l) {
        const int pb = 3 + l * 12;
        if (IN(pb + 0)) { FRESH();
            pg8::Gemm g{WSP(bf16_t, WS_H), WSP(bf16_t, WS_WIN) + (size_t)l * NINP * DM, MT, NINP, DM}; pg8::StaticOrder S; S.init(MT, NINP, F.G, F.bid);
            pg8::EpiProj E{WSP(bf16_t, WS_R1), WSP(bf16_t, WS_SU), WSP(float, WS_ROPE)};
            pg8::gemm_phase<pg8::EpiProj, pg8::StaticOrder>(F.lds, g, S, E, F.tid); SEAM(pb + 0); }
        if (IN(pb + 1)) { FRESH(); for (int r_ = 0; r_ < (PROBE_SUB == 1 ? 2 : 1); ++r_) attn_items(F, l, F.bid, F.G); for (int r_ = 0; r_ < (PROBE_SUB == 2 ? 2 : 1); ++r_) if ((F.G & 7) == 0) s5a_items(F, l, F.bid & 7, wrapadd(F.bid >> 3, F.G >> 4, F.G >> 3), F.G >> 3); else s5a_items(F, l, -1, F.bid, F.G); for (int r_ = 0; r_ < (PROBE_SUB == 3 ? 2 : 1); ++r_) gla1_items(F, l, wrapadd(F.bid, 96, F.G), F.G); SEAM(pb + 1); }
        if (IN(pb + 2)) { FRESH(); if (F.bid < 32) s5_scan2(F, l, F.bid * NTHR + F.tid, 32 * NTHR); else gla_scan2(F, (F.bid - 32) * NTHR + F.tid, (F.G - 32) * NTHR); SEAM(pb + 2); }
        if (IN(pb + 3)) { FRESH(); for (int r_ = 0; r_ < (PROBE_SUB == 4 ? 2 : 1); ++r_) if ((F.G & 7) == 0) s5c_items(F, l, F.bid & 7, F.bid >> 3, F.G >> 3); else s5c_items(F, l, -1, F.bid, F.G); for (int r_ = 0; r_ < (PROBE_SUB == 5 ? 2 : 1); ++r_) gla3_items(F, l, wrapadd(F.bid, 32, F.G), F.G); SEAM(pb + 3); }
        if (IN(pb + 4)) { FRESH();
            pg8::Gemm g{WSP(bf16_t, WS_R3 + (size_t)MT * DM * 2), WSP(bf16_t, WS_WGLU) + (size_t)l * 512 * 512, MT, 512, 512}; pg8::StaticOrder S; S.init(MT, 512, F.G, F.bid);
            pg8::EpiGlu E{WSP(bf16_t, WS_R3 + (size_t)MT * DM * 2), F.in[17] + l * 512, WSP(bf16_t, WS_R3)};
            pg8::gemm_phase<pg8::EpiGlu, pg8::StaticOrder, MT>(F.lds, g, S, E, F.tid); SEAM(pb + 4); }
        if (IN(pb + 5)) { FRESH();
            pg8::Gemm g{WSP(bf16_t, WS_R3), WSP(bf16_t, WS_WOUT) + (size_t)l * DM * DM, NLAT, DM, DM};
            pg8::EpiBf16 E{WSP(bf16_t, WS_R2), DM};
            const bool qtail = (F.G >= 128);
            { const int split = 0;     pg8::OutOrder0 S; S.S0.init((l == 0 && !split && !qtail) ? MT : NLAT, DM, F.G, F.bid); S.G = F.G; S.c = F.bid; S.split = split; pg8::gemm_phase<pg8::EpiBf16, pg8::OutOrder0>(F.lds, g, S, E, F.tid); }
            if (l == 0 && qtail) { FRESH(); if (F.bid < 128) pg8::gemm_quarter<pg8::EpiBf16>(F.lds, g, 64 + (F.bid >> 5), (F.bid >> 2) & 7, (F.bid >> 1) & 1, F.bid & 1, E, F.tid); }
            SEAM(pb + 5); }
        if (IN(pb + 6)) { FRESH(); phase_ln_mid(F, l); SEAM(pb + 6); }
        if (IN(pb + 7)) { FRESH(); phase_topk(F, l); SEAM(pb + 7); }
        if (IN(pb + 9)) { FRESH();
            pg8::GemmF g{WSP(bf16_t, WS_H), F.in[27] + (size_t)l * NE * DM * DM, F.in[28] + (size_t)l * NE * DM * DM, (size_t)DM * DM, 128, DM, DM, nullptr, WSP(unsigned, WS_VT)};
            pg8::GroupedOrder S{NE, (l == 0) ? 9 : 8, 16, 9, F.G, F.bid, 0};
            pg8::EpiGateUp E{WSP(bf16_t, WS_R1)};
            pg8::gemm_phase_fb<pg8::EpiGateUp, pg8::GroupedOrder, 0, false, true>(F.lds, g, S, E, F.tid); SEAM(pb + 9); }
        if (IN(pb + 10)) { FRESH();
            pg8::GemmF g{WSP(bf16_t, WS_R1), F.in[29] + (size_t)l * NE * DM * DM, F.in[29] + (size_t)l * NE * DM * DM + 128, (size_t)DM * DM, 256, DM, DM, nullptr};
            pg8::GroupedOrder S{NE, (l == 0) ? 9 : 8, 8, 9, F.G, F.bid, 0};
            pg8::EpiBf16 E{WSP(bf16_t, WS_R3), DM};
            pg8::gemm_phase_fb<pg8::EpiBf16, pg8::GroupedOrder>(F.lds, g, S, E, F.tid); SEAM(pb + 10); }
        if (IN(pb + 11)) { FRESH(); phase_combine(F, l); SEAM(pb + 11); }
    }
#undef IN
#undef SEAM
}

#ifndef PROBE_NREP
#define PROBE_NREP 2
#endif
#ifndef PROBE_REP_MASK
#define PROBE_REP_MASK 0ull
#endif
#ifndef MK_MULTI
#define MK_MULTI 0
#endif
extern "C" void kernel_launch(void* const* d_in, const int* in_sizes, int n_in, void* d_out, int out_size, void* d_ws, size_t ws_size, hipStream_t stream) {
    static int grid = 0;
    if (grid == 0) {
        if (n_in != 30 || out_size != NLAT * DM || ws_size < WS_END) { fprintf(stderr, "kernel_launch: unexpected shapes (n_in %d, out %d, ws %zu, need %zu)\n", n_in, out_size, ws_size, (size_t)WS_END); grid = -1; return; }
        int dev = 0, cus = 0, per_cu = 0;
        if (hipGetDevice(&dev) != hipSuccess || hipDeviceGetAttribute(&cus, hipDeviceAttributeMultiprocessorCount, dev) != hipSuccess) { grid = -1; return; }
        if (hipFuncSetAttribute((const void*)mega_fwd, hipFuncAttributeMaxDynamicSharedMemorySize, LDS_BYTES) != hipSuccess) { fprintf(stderr, "kernel_launch: hipFuncSetAttribute failed\n"); grid = -1; return; }
        if (hipOccupancyMaxActiveBlocksPerMultiprocessor(&per_cu, (const void*)mega_fwd, NTHR, LDS_BYTES) != hipSuccess || per_cu < 1) fprintf(stderr, "kernel_launch: occupancy query says %d\n", per_cu);
        (void)hipGetLastError();
        grid = cus;
    }
    if (grid < 0) return;
    (void)hipMemsetAsync((char*)d_ws + WS_CTL, 0, CTL_BYTES, stream);
    Args a{};
    for (int i = 0; i < 30; ++i) a.in[i] = (const float*)d_in[i];
    a.out = (float*)d_out; a.ws = (unsigned char*)d_ws;
#if MK_MULTI
    for (int p = 0; p < N_PHASES; ++p) { const int nrep = ((PROBE_REP_MASK >> p) & 1ull) ? PROBE_NREP : 1; for (int r = 0; r < nrep; ++r) { a.ph_lo = p; a.ph_hi = p + 1; hipLaunchKernelGGL(mega_fwd, dim3(grid), dim3(NTHR), LDS_BYTES, stream, a); } }
#else
    a.ph_lo = 0; a.ph_hi = N_PHASES; hipLaunchKernelGGL(mega_fwd, dim3(grid), dim3(NTHR), LDS_BYTES, stream, a);
#endif
}
```

```cpp
#include <hip/hip_runtime.h>
#ifndef PROBE_SUB
#define PROBE_SUB 0
#endif
#include <cstdio>
#include <cstdint>

#define LAS __attribute__((address_space(3)))
typedef unsigned short bf16_t;
typedef short bf16x8 __attribute__((ext_vector_type(8)));
typedef short s16x4 __attribute__((ext_vector_type(4)));
typedef float f32x4 __attribute__((ext_vector_type(4)));
typedef float f32x2 __attribute__((ext_vector_type(2)));
typedef unsigned u32x4 __attribute__((ext_vector_type(4)));
typedef unsigned u32x2 __attribute__((ext_vector_type(2)));

constexpr int NB = 4, SEQ = 4096, CTXL = 256, DM = 2048;
constexpr int NLAT = NB * SEQ, NCTX = NB * CTXL, MT = NLAT + NCTX;
constexpr int NIN = 3616, NINP = 3840;
constexpr int C_Q = 0, C_K = 1024, C_V = 1280, C_SU = 1536, C_GQ = 2048, C_GK = 2304, C_GV = 2560, C_GR = 3072, C_GZ = 3584;
constexpr int NE = 16, ER = 2304;
constexpr float ALPHA = 1.41421356237309515f;
constexpr float LN_EPS = 1e-6f;
constexpr int NTHR = 512;
constexpr int LDS_BYTES = 163840;
constexpr int LDS_BAR_OFF = 163840 - 64;

constexpr size_t al256(size_t x) { return (x + 255) & ~(size_t)255; }
constexpr size_t WS_CTL = 0, CTL_BYTES = 1u << 20;
constexpr size_t WS_MODP = WS_CTL + CTL_BYTES;
constexpr size_t WS_MOD = WS_MODP + (size_t)2 * 32 * 5 * 12288 * 4;
constexpr size_t WS_ROPE = WS_MOD + (size_t)2 * 5 * 12288 * 4;
constexpr size_t WS_LAMT = WS_ROPE + 64 * 32 * 8;
constexpr size_t WS_WIN = al256(WS_LAMT + 2 * 32 * 2 * 64 * 8);
constexpr size_t WS_WOUT = WS_WIN + (size_t)2 * NINP * DM * 2;
constexpr size_t WS_WGLU = WS_WOUT + (size_t)2 * DM * DM * 2;
constexpr size_t WS_WGU = WS_WGLU + (size_t)2 * 512 * 512 * 2;
constexpr size_t WS_X2B = WS_WGU;
constexpr size_t WS_WDN = WS_WGU + (size_t)2 * NE * 4096 * DM * 2;
constexpr size_t WS_S5A = WS_WDN + (size_t)2 * NE * 2048 * DM * 2;
constexpr size_t WS_S5C = WS_S5A + (size_t)2 * 32 * 256 * 512 * 2;
constexpr size_t WS_X1 = WS_S5C + (size_t)2 * 32 * 512 * 768 * 2;
constexpr size_t WS_X2C = WS_X1 + (size_t)MT * DM * 4;
constexpr size_t WS_H = WS_X2C + (size_t)NCTX * DM * 4;
constexpr size_t WS_R1 = WS_H + (size_t)MT * DM * 2;
constexpr size_t R_BYTES = (size_t)NE * ER * DM * 2;
constexpr size_t WS_R2 = WS_R1 + R_BYTES;
constexpr size_t WS_R3 = WS_R2 + R_BYTES;
constexpr size_t R3_BYTES = (size_t)MT * DM * 2 + (size_t)MT * 512 * 2 + (size_t)32 * 68 * 8192 * 4;
constexpr size_t WS_SU = WS_R3 + R3_BYTES;
constexpr size_t WS_AFF = WS_SU + (size_t)32 * MT * 16 * 2;
constexpr size_t WS_TOKSLOT = WS_AFF + (size_t)MT * 16 * 4;
constexpr size_t WS_SELTOK = WS_TOKSLOT + (size_t)MT * 16 * 4;
constexpr size_t WS_S5S = WS_SELTOK + (size_t)NE * ER * 4;
constexpr size_t WS_S5IN = WS_S5S + (size_t)544 * 32 * 256 * 4;
constexpr size_t WS_GDEC = WS_S5IN + (size_t)544 * 32 * 256 * 2;
constexpr size_t WS_GST = WS_GDEC + (size_t)32 * 68 * 64 * 4;
constexpr size_t WS_GQIN = WS_GST + (size_t)32 * 68 * 8192 * 2;
constexpr size_t WS_GKP = WS_GQIN + (size_t)32 * 68 * 4096 * 2;
constexpr size_t WS_VT = WS_GKP + (size_t)32 * 68 * 4096 * 2;
constexpr size_t WS_END = WS_VT + (size_t)NE * 9 * 4096;
static_assert(R3_BYTES >= R_BYTES, "YE must fit in R3");
static_assert((size_t)MT * NINP * 2 <= R_BYTES && (size_t)MT * DM * 4 <= R_BYTES, "PROJ / Y fit");
static_assert(WS_END < (size_t)2000 * 1000 * 1000, "workspace budget");

__device__ __forceinline__ unsigned cvt_pk_bf16(float lo, float hi) { unsigned r; asm volatile("v_cvt_pk_bf16_f32 %0, %1, %2" : "=v"(r) : "v"(lo), "v"(hi)); return r; }
typedef _Float16 h2_t __attribute__((ext_vector_type(2)));
__device__ __forceinline__ unsigned cvt_pk_f16(float lo, float hi) { h2_t h; h.x = (_Float16)lo; h.y = (_Float16)hi; return __builtin_bit_cast(unsigned, h); }
__device__ __forceinline__ bf16_t f2bf(float x) { return (bf16_t)(cvt_pk_bf16(x, 0.f) & 0xffffu); }
__device__ __forceinline__ float bf2f(bf16_t b) { return __uint_as_float(((unsigned)b) << 16); }
__device__ __forceinline__ float bflo(unsigned w) { return __uint_as_float(w << 16); }
__device__ __forceinline__ float bfhi(unsigned w) { return __uint_as_float(w & 0xffff0000u); }
template <int O>
__device__ __forceinline__ float shx(float v) {
    const int x = __float_as_int(v);
    if constexpr (O == 1) return __int_as_float(__builtin_amdgcn_update_dpp(0, x, 0xB1, 0xF, 0xF, true));
    else if constexpr (O == 2) return __int_as_float(__builtin_amdgcn_update_dpp(0, x, 0x4E, 0xF, 0xF, true));
    else if constexpr (O == 4) { const int t = __builtin_amdgcn_update_dpp(0, x, 0x1B, 0xF, 0xF, true); return __int_as_float(__builtin_amdgcn_update_dpp(0, t, 0x141, 0xF, 0xF, true)); }
    else if constexpr (O == 8) return __int_as_float(__builtin_amdgcn_update_dpp(0, x, 0x128, 0xF, 0xF, true));
    else { const unsigned lane_ = __builtin_amdgcn_mbcnt_hi(~0u, __builtin_amdgcn_mbcnt_lo(~0u, 0u));
        if constexpr (O == 16) { const auto r = __builtin_amdgcn_permlane16_swap((unsigned)x, (unsigned)x, false, false); return __int_as_float((int)((lane_ & 16u) ? r[0] : r[1])); }
        else { static_assert(O == 32, "shx: power-of-two offsets below 64"); const auto r = __builtin_amdgcn_permlane32_swap((unsigned)x, (unsigned)x, false, false); return __int_as_float((int)((lane_ & 32u) ? r[0] : r[1])); } }
}
__device__ __forceinline__ float wave_sum_dpp(float x) {
    x += __int_as_float(__builtin_amdgcn_update_dpp(0, __float_as_int(x), 0xB1, 0xF, 0xF, true));
    x += __int_as_float(__builtin_amdgcn_update_dpp(0, __float_as_int(x), 0x4E, 0xF, 0xF, true));
    x += __int_as_float(__builtin_amdgcn_update_dpp(0, __float_as_int(x), 0x141, 0xF, 0xF, true));
    x += __int_as_float(__builtin_amdgcn_update_dpp(0, __float_as_int(x), 0x140, 0xF, 0xF, true));
    const int xi = __float_as_int(x);
    return __int_as_float(__builtin_amdgcn_readlane(xi, 0)) + __int_as_float(__builtin_amdgcn_readlane(xi, 16)) + __int_as_float(__builtin_amdgcn_readlane(xi, 32)) + __int_as_float(__builtin_amdgcn_readlane(xi, 48));
}
__device__ __forceinline__ float wave_sum(float v) { return wave_sum_dpp(v); }
__device__ __forceinline__ float wave_max(float v) { v = fmaxf(v, shx<1>(v)); v = fmaxf(v, shx<2>(v)); v = fmaxf(v, shx<4>(v)); v = fmaxf(v, shx<8>(v)); v = fmaxf(v, shx<16>(v)); return fmaxf(v, shx<32>(v)); }
__device__ __forceinline__ float sigmoidf_(float x) { return __builtin_amdgcn_rcpf(1.0f + __expf(-x)); }
__device__ __forceinline__ float siluf_(float x) { return x * __builtin_amdgcn_rcpf(1.0f + __expf(-x)); }
__device__ __forceinline__ float gelu_tanh(float x) { const float u = 0.7978845608028654f * (x + 0.044715f * x * x * x); const float e = __expf(-2.0f * fabsf(u)); const float t = (1.0f - e) * __builtin_amdgcn_rcpf(1.0f + e); return 0.5f * x * (1.0f + (u < 0.f ? -t : t)); }
__device__ __forceinline__ float logsigmoidf_(float x) { return fminf(x, 0.f) - __logf(1.0f + __expf(-fabsf(x))); }
__device__ __forceinline__ s16x4 tr_read(unsigned lds_addr) { s16x4 r; asm volatile("ds_read_b64_tr_b16 %0, %1\n\ts_waitcnt lgkmcnt(0)" : "=&v"(r) : "v"(lds_addr) : "memory"); return r; }
__device__ __forceinline__ bf16x8 tr_read2(unsigned a0, unsigned a1) { s16x4 r0, r1; asm volatile("ds_read_b64_tr_b16 %0, %2\n\tds_read_b64_tr_b16 %1, %3\n\ts_waitcnt lgkmcnt(0)" : "=&v"(r0), "=&v"(r1) : "v"(a0), "v"(a1) : "memory");
    bf16x8 o; o[0] = r0[0]; o[1] = r0[1]; o[2] = r0[2]; o[3] = r0[3]; o[4] = r1[0]; o[5] = r1[1]; o[6] = r1[2]; o[7] = r1[3]; return o; }
__device__ __forceinline__ unsigned lds_addr_of(const LAS void* p) { return (unsigned)(uintptr_t)p; }
#define MFMA16(a, b, c) __builtin_amdgcn_mfma_f32_16x16x32_bf16((a), (b), (c), 0, 0, 0)
namespace pg8 {
#define PG8_LAS __attribute__((address_space(3)))
constexpr int BM = 256, BK = 64, HALF = 128, HTB = HALF * BK * 2  , STAGE_BYTES = 8 * HTB, NXCD = 8, WGM = 8;

__host__ __device__ __forceinline__ int lds_byte(int r, int c) { const int st = (r >> 4) * 2 + (c >> 5), rr = r & 15, cc = c & 31, ob = rr * 64 + cc * 2; return st * 1024 + (ob ^ (((ob >> 9) & 1) << 5)); }
__host__ __device__ __forceinline__ void stage_rc(int b, int& R, int& C) { const int st = b / 1024, sb = b % 1024, swz = sb ^ (((sb >> 9) & 1) << 5); R = (st >> 1) * 16 + swz / 64; C = (st & 1) * 32 + (swz % 64) / 2; }
__host__ __device__ __forceinline__ int perm32(int rho) { const int n = rho >> 4, i = rho & 15; return 8 * (i >> 2) + 4 * n + (i & 3); }

struct Unit { int pm, pn, pb, e, fl; };
struct Gemm { const bf16_t* A; const bf16_t* Bt; int M, N, K; };

struct StaticOrder {
    int nM, nN, nwg, G, c;
    __host__ __device__ void init(int M, int N, int G_, int c_) { nM = M / BM; nN = N / BM; nwg = nM * nN; G = G_; c = c_; }
    __host__ __device__ bool next(int i, Unit& u) const {
        const long L = (long)i * G + c; if (L >= nwg) return false;
        int wgid = (int)L; { const int q = nwg / NXCD, r = nwg % NXCD, xcd = wgid % NXCD, off = wgid / NXCD; wgid = (xcd < r ? xcd * (q + 1) : r * (q + 1) + (xcd - r) * q) + off; }
        const int nig = WGM * nN, gid = wgid / nig, fm = gid * WGM, gsz = (nM - fm) < WGM ? (nM - fm) : WGM;
        u.pm = fm + ((wgid % nig) % gsz); u.pn = (wgid % nig) / gsz; u.pb = u.pn; u.e = 0; u.fl = 0; return true;
    }
    __device__ __forceinline__ void a_ready(const Unit&) const {}
    __device__ __forceinline__ void done(const Unit&) const {}
    __device__ __forceinline__ void after_unit(int, int) const {}
    __device__ __forceinline__ void finish(int, int) const {}
};
template <class Epi, class Sched, int AGRP = 0  >
__device__ __forceinline__ void gemm_phase(PG8_LAS unsigned char* lds, const Gemm g, const Sched& S, const Epi& E, const int tid) {
    const int wid = __builtin_amdgcn_readfirstlane(tid >> 6), lane = tid & 63, wr = wid >> 2, wc = wid & 3, fr = lane & 15, fq = lane >> 4;
    const int K = g.K, nt = K / BK;
    unsigned voffA[2], voffB[2];
#pragma unroll
    for (int i = 0; i < 2; ++i) { int R, C; stage_rc(tid * 16 + i * 8192, R, C); const int Rb = Epi::PERM ? ((R & ~31) + perm32(R & 31)) : R;
        voffA[i] = AGRP ? (unsigned)((C >> 4) * AGRP * 16 + R * 16 + (C & 15)) * 2u : (unsigned)(R * K + C) * 2u; voffB[i] = (unsigned)(Rb * K + C) * 2u; }
    const size_t kstepB = (size_t)(BK * 2), hstepB = (size_t)HALF * K * 2, tstepB = 2 * hstepB;
    const size_t kstepA = AGRP ? (size_t)4 * AGRP * 32 : kstepB, hstepA = AGRP ? (size_t)HALF * 32 : hstepB, tstepA = 2 * hstepA;
    const unsigned ldsw = (unsigned)wid * 1024u;
    const int aoff = lds_byte(wr * 64 + fr, fq * 8), boff = lds_byte(wc * 32 + fr, fq * 8);
#define PG8_SA(b, h) (((b) * 2 + (h)) * HTB)
#define PG8_SB(b, h) ((4 + (b) * 2 + (h)) * HTB)
#define PG8_STAGE(bufoff, gbase, voff) do { _Pragma("unroll") for (int _i = 0; _i < 2; ++_i) \
        __builtin_amdgcn_global_load_lds((const unsigned*)((const char*)(gbase) + (voff)[_i]), (PG8_LAS unsigned*)(lds + (bufoff) + ldsw + _i * 8192), 16, 0, 0); } while (0)
#define PG8_LDA(dst, b, h) do { _Pragma("unroll") for (int m = 0; m < 4; ++m) _Pragma("unroll") for (int k = 0; k < 2; ++k) dst[m][k] = *(const PG8_LAS bf16x8*)(lds + PG8_SA(b, h) + aoff + m * 2048 + k * 1024); } while (0)
#define PG8_LDB(dst, b, h) do { _Pragma("unroll") for (int n = 0; n < 2; ++n) _Pragma("unroll") for (int k = 0; k < 2; ++k) dst[n][k] = *(const PG8_LAS bf16x8*)(lds + PG8_SB(b, h) + boff + n * 2048 + k * 1024); } while (0)
#define PG8_MMA(ai, bj, At, Bt) do { __builtin_amdgcn_s_setprio(1); _Pragma("unroll") for (int m = 0; m < 4; ++m) _Pragma("unroll") for (int n = 0; n < 2; ++n) _Pragma("unroll") for (int k = 0; k < 2; ++k) \
        acc[ai][bj][m][n] = __builtin_amdgcn_mfma_f32_16x16x32_bf16(Bt[n][k], At[m][k], acc[ai][bj][m][n], 0, 0, 0); __builtin_amdgcn_s_setprio(0); } while (0)
#define PG8_WAIT_V(n) asm volatile("s_waitcnt vmcnt(" #n ")" ::: "memory")
#define PG8_WAIT_L(n) asm volatile("s_waitcnt lgkmcnt(" #n ")" ::: "memory")
#define PG8_BAR __builtin_amdgcn_s_barrier()
#define PG8_SCHED __builtin_amdgcn_sched_barrier(0)
    Unit cur, nxt; int ui = 0;
#define PG8_UNI(u) do { (u).pm = __builtin_amdgcn_readfirstlane((u).pm); (u).pn = __builtin_amdgcn_readfirstlane((u).pn); (u).pb = __builtin_amdgcn_readfirstlane((u).pb); (u).e = __builtin_amdgcn_readfirstlane((u).e); (u).fl = __builtin_amdgcn_readfirstlane((u).fl); } while (0)
    if (!S.next(0, cur)) { S.finish(-1, tid); return; } PG8_UNI(cur);
    f32x4 acc[2][2][4][2];
#pragma unroll
    for (int a = 0; a < 2; ++a)
#pragma unroll
        for (int b = 0; b < 2; ++b)
#pragma unroll
            for (int m = 0; m < 4; ++m)
#pragma unroll
                for (int n = 0; n < 2; ++n) acc[a][b][m][n] = (f32x4){0.f, 0.f, 0.f, 0.f};
    bf16x8 At[4][2], B0[2][2], B1[2][2];
    const char* cA = (const char*)g.A + (size_t)cur.pm * tstepA; const char* cB = (const char*)g.Bt + (size_t)cur.pb * tstepB;
    S.a_ready(cur);
    PG8_STAGE(PG8_SB(0, 0), cB, voffB); PG8_STAGE(PG8_SA(0, 0), cA, voffA); PG8_STAGE(PG8_SB(0, 1), cB + hstepB, voffB); PG8_STAGE(PG8_SA(0, 1), cA + hstepA, voffA);
    if (wr == 1) PG8_BAR;
    PG8_WAIT_V(4); PG8_BAR;
    PG8_STAGE(PG8_SB(1, 0), cB + kstepB, voffB); PG8_STAGE(PG8_SA(1, 0), cA + kstepA, voffA); PG8_STAGE(PG8_SB(1, 1), cB + hstepB + kstepB, voffB);
    PG8_WAIT_V(6); PG8_BAR;
    for (;;) {
        const bool has_next = S.next(ui + 1, nxt); PG8_UNI(nxt);
        const char* nA = has_next ? (const char*)g.A + (size_t)nxt.pm * tstepA : cA; const char* nB = has_next ? (const char*)g.Bt + (size_t)nxt.pb * tstepB : cB;
        for (int t = 0; t < nt; t += 2) {
            const bool last = (t == nt - 2);
            const char* a1 = cA + (size_t)(t + 1) * kstepA;
            const char* a2 = last ? nA : cA + (size_t)(t + 2) * kstepA; const char* b2 = last ? nB : cB + (size_t)(t + 2) * kstepB;
            const char* a3 = a2 + kstepA; const char* b3 = b2 + kstepB;
            if (last && has_next) S.a_ready(nxt);
            PG8_LDB(B0, 0, 0); PG8_SCHED; PG8_LDA(At, 0, 0); PG8_STAGE(PG8_SA(1, 1), a1 + hstepA, voffA);
            PG8_WAIT_L(8); PG8_BAR; PG8_WAIT_L(0); PG8_MMA(0, 0, At, B0); PG8_BAR; PG8_SCHED;
            PG8_LDB(B1, 0, 1); PG8_STAGE(PG8_SB(0, 0), b2, voffB);
            PG8_BAR; PG8_WAIT_L(0); PG8_MMA(0, 1, At, B1); PG8_BAR;
            PG8_LDA(At, 0, 1); PG8_STAGE(PG8_SA(0, 0), a2, voffA);
            PG8_BAR; PG8_WAIT_L(0); PG8_MMA(1, 0, At, B0); PG8_BAR; PG8_SCHED;
            PG8_STAGE(PG8_SB(0, 1), b2 + hstepB, voffB);
            PG8_WAIT_V(6); PG8_BAR; PG8_MMA(1, 1, At, B1); PG8_BAR;
            PG8_LDB(B0, 1, 0); PG8_SCHED; PG8_LDA(At, 1, 0); PG8_STAGE(PG8_SA(0, 1), a2 + hstepA, voffA);
            PG8_WAIT_L(8); PG8_BAR; PG8_WAIT_L(0); PG8_MMA(0, 0, At, B0); PG8_BAR; PG8_SCHED;
            PG8_LDB(B1, 1, 1); PG8_STAGE(PG8_SB(1, 0), b3, voffB);
            PG8_BAR; PG8_WAIT_L(0); PG8_MMA(0, 1, At, B1); PG8_BAR;
            PG8_LDA(At, 1, 1); PG8_STAGE(PG8_SA(1, 0), a3, voffA);
            PG8_BAR; PG8_WAIT_L(0); PG8_MMA(1, 0, At, B0); PG8_BAR; PG8_SCHED;
            PG8_STAGE(PG8_SB(1, 1), b3 + hstepB, voffB);
            PG8_WAIT_V(6); PG8_BAR; PG8_MMA(1, 1, At, B1); PG8_BAR;
        }
        if constexpr (!Epi::AFTER_DRAIN) { for (int r_ = 0; r_ < (PROBE_SUB == 9 ? 2 : 1); ++r_) E(acc, cur, wr, wc, fr, fq); S.done(cur); S.after_unit(ui, tid); }
        if (!has_next) break;
#pragma unroll
        for (int a = 0; a < 2; ++a)
#pragma unroll
            for (int b = 0; b < 2; ++b)
#pragma unroll
                for (int m = 0; m < 4; ++m)
#pragma unroll
                    for (int n = 0; n < 2; ++n) acc[a][b][m][n] = (f32x4){0.f, 0.f, 0.f, 0.f};
        cur = nxt; cA = nA; cB = nB; ++ui;
    }
    S.finish(ui, tid);
    PG8_WAIT_V(0);
    if (wr == 0) PG8_BAR;
    PG8_BAR;
    if constexpr (Epi::AFTER_DRAIN) { E.fused(acc, cur, wr, wc, fr, fq, lds, wid, lane); S.done(cur); }
#undef PG8_SA
#undef PG8_SB
#undef PG8_STAGE
#undef PG8_LDA
#undef PG8_LDB
#undef PG8_MMA
#undef PG8_WAIT_V
#undef PG8_WAIT_L
#undef PG8_BAR
#undef PG8_SCHED
#undef PG8_UNI
}
template <class Epi>
__device__ __forceinline__ void gemm_quarter(PG8_LAS unsigned char* lds, const Gemm g, const int pm, const int pn, const int mh, const int nh, const Epi& E, const int tid) {
    const int wid = __builtin_amdgcn_readfirstlane(tid >> 6), lane = tid & 63, wr = wid >> 2, wc = wid & 3, fr = lane & 15, fq = lane >> 4;
    const int K = g.K, nt = K / BK;
    unsigned voffA[2], voffB[2];
#pragma unroll
    for (int i = 0; i < 2; ++i) { int R, C; stage_rc(tid * 16 + i * 8192, R, C); const int Rb = Epi::PERM ? ((R & ~31) + perm32(R & 31)) : R; voffA[i] = (unsigned)(R * K + C) * 2u; voffB[i] = (unsigned)(Rb * K + C) * 2u; }
    const char* cA = (const char*)g.A + ((size_t)pm * BM + (size_t)mh * HALF) * K * 2; const char* cB = (const char*)g.Bt + ((size_t)pn * BM + (size_t)nh * HALF) * K * 2;
    const unsigned ldsw = (unsigned)wid * 1024u;
    const int aoff = lds_byte(wr * 64 + fr, fq * 8), boff = lds_byte(wc * 32 + fr, fq * 8);
#define PQ_SA(b) (((b) * 2) * HTB)
#define PQ_SB(b) ((4 + (b) * 2) * HTB)
#define PQ_STAGE(bufoff, gbase, voff) do { _Pragma("unroll") for (int _i = 0; _i < 2; ++_i) \
        __builtin_amdgcn_global_load_lds((const unsigned*)((const char*)(gbase) + (voff)[_i]), (PG8_LAS unsigned*)(lds + (bufoff) + ldsw + _i * 8192), 16, 0, 0); } while (0)
    f32x4 acc[2][2][4][2];
#pragma unroll
    for (int a = 0; a < 2; ++a)
#pragma unroll
        for (int b = 0; b < 2; ++b)
#pragma unroll
            for (int m = 0; m < 4; ++m)
#pragma unroll
                for (int n = 0; n < 2; ++n) acc[a][b][m][n] = (f32x4){0.f, 0.f, 0.f, 0.f};
    PQ_STAGE(PQ_SA(0), cA, voffA); PQ_STAGE(PQ_SB(0), cB, voffB);
    for (int t = 0; t < nt; ++t) { const int b = t & 1;
        if (t + 1 < nt) { PQ_STAGE(PQ_SA(b ^ 1), cA + (size_t)(t + 1) * (BK * 2), voffA); PQ_STAGE(PQ_SB(b ^ 1), cB + (size_t)(t + 1) * (BK * 2), voffB); asm volatile("s_waitcnt vmcnt(4)" ::: "memory"); }
        else asm volatile("s_waitcnt vmcnt(0)" ::: "memory");
        __builtin_amdgcn_s_barrier();
        bf16x8 At[4][2], B0[2][2];
#pragma unroll
        for (int m = 0; m < 4; ++m)
#pragma unroll
            for (int k = 0; k < 2; ++k) At[m][k] = *(const PG8_LAS bf16x8*)(lds + (b ? PQ_SA(1) : PQ_SA(0)) + aoff + m * 2048 + k * 1024);
#pragma unroll
        for (int n = 0; n < 2; ++n)
#pragma unroll
            for (int k = 0; k < 2; ++k) B0[n][k] = *(const PG8_LAS bf16x8*)(lds + (b ? PQ_SB(1) : PQ_SB(0)) + boff + n * 2048 + k * 1024);
        asm volatile("s_waitcnt lgkmcnt(0)" ::: "memory");
#pragma unroll
        for (int m = 0; m < 4; ++m)
#pragma unroll
            for (int n = 0; n < 2; ++n)
#pragma unroll
                for (int k = 0; k < 2; ++k) acc[0][0][m][n] = __builtin_amdgcn_mfma_f32_16x16x32_bf16(B0[n][k], At[m][k], acc[0][0][m][n], 0, 0, 0);
        __builtin_amdgcn_s_barrier();
    }
    Unit u; u.pm = pm; u.pn = pn; u.pb = pn; u.e = 0; u.fl = 1 | 2 | (mh ? 8 : 0) | (nh ? 16 : 0);
    E(acc, u, wr, wc, fr, fq);
#undef PQ_SA
#undef PQ_SB
#undef PQ_STAGE
}
}
namespace pg8 {
struct GemmF { const bf16_t* A; const float* Bf0; const float* Bf1; size_t estride; int ncstep; int ldb; int K; bf16_t* img; const unsigned* vt = nullptr; };
__device__ __forceinline__ int g8swz(int k) { return (k & 1) | (((k >> 1) & 1) << 3) | (((k >> 3) & 1) << 4); }
template <class Epi, class Sched, int VAR = 0, bool IMG = false, bool GATH = false  >
__device__ __forceinline__ void gemm_phase_fb(PG8_LAS unsigned char* lds, const GemmF g, const Sched& S, const Epi& E, const int tid) {
    static_assert(Epi::PERM && !Epi::AFTER_DRAIN, "f32-B body: 2-byte-output epilogues only");
    const int wid = __builtin_amdgcn_readfirstlane(tid >> 6), lane = tid & 63, wr = wid >> 2, wc = wid & 3, fr = lane & 15, fq = lane >> 4;
    const int K = g.K, nt = K / BK;
    unsigned voffA0; { int R, C; stage_rc(tid * 16, R, C); voffA0 = (unsigned)(R * K + C) * 2u; }
    const unsigned kstepA = (unsigned)(BK * 2), hstepA = (unsigned)HALF * K * 2, tstepA = 2 * hstepA;
    const unsigned kstepB = (unsigned)BK * (unsigned)g.ldb * 4u;
    const unsigned ldsw = (unsigned)wid * 1024u;
    const int aoff = lds_byte(wr * 64 + fr, fq * 8);
    const int kr = tid >> 5, c4 = tid & 31;
    const unsigned voffBf = (unsigned)(kr * g.ldb + c4 * 4) * 4u; const unsigned jstepB = 16u * (unsigned)g.ldb * 4u;
    u32x4 rs0, rs1;
    { const unsigned long long p0 = (unsigned long long)(uintptr_t)g.Bf0, p1 = (unsigned long long)(uintptr_t)g.Bf1;
      rs0.x = __builtin_amdgcn_readfirstlane((unsigned)p0); rs0.y = __builtin_amdgcn_readfirstlane((unsigned)(p0 >> 32) & 0xffffu); rs0.z = 0x7fffffffu; rs0.w = 0x00020000u;
      rs1.x = __builtin_amdgcn_readfirstlane((unsigned)p1); rs1.y = __builtin_amdgcn_readfirstlane((unsigned)(p1 >> 32) & 0xffffu); rs1.z = 0x7fffffffu; rs1.w = 0x00020000u; }
    const __amdgpu_buffer_rsrc_t rsA = __builtin_amdgcn_make_buffer_rsrc((void*)g.A, 0, 0x7fffffff, 0x00020000);
    const __amdgpu_buffer_rsrc_t rsI = __builtin_amdgcn_make_buffer_rsrc((void*)g.img, 0, 0x7fffffff, 0x00020000);
    const unsigned istepI = (unsigned)(K / BK) * 32768u;
    const unsigned woffB = (unsigned)(kr * 256 + 8 * (c4 ^ g8swz(kr)));
    u32x2 vt = {0u, 0u}, vn = {0u, 0u}; unsigned c2 = 0; u32x4 rsV = {0u, 0u, 0u, 0u};
    if constexpr (GATH) { int R, C; stage_rc(tid * 16, R, C); c2 = (unsigned)C * 2u; const unsigned long long pv = (unsigned long long)(uintptr_t)g.vt;
        rsV.x = __builtin_amdgcn_readfirstlane((unsigned)pv); rsV.y = __builtin_amdgcn_readfirstlane((unsigned)(pv >> 32) & 0xffffu); rsV.z = 0x7fffffffu; rsV.w = 0x00020000u; }
    const unsigned lds0 = (unsigned)(uintptr_t)lds;
    unsigned btb0; { const int q = fr >> 2, p = fr & 3, krow = 8 * fq + q; btb0 = lds0 + (unsigned)(krow * 256 + 8 * ((8 * wc + 2 * p) ^ g8swz(krow))); }
#define PG8_SA(b, h) (((b) * 2 + (h)) * HTB)
#define PG8_SB(b, h) ((4 + (b) * 2 + (h)) * HTB)
#define PG8_STAGEA(b, h, base) do { if constexpr (GATH) { const unsigned _p = (h) ? vt.y : vt.x; \
        __builtin_amdgcn_raw_ptr_buffer_load_lds(rsA, (PG8_LAS void*)(lds + PG8_SA(b, h) + ldsw), 16, ((_p & 0xffffu) << 12) + c2, (base), 0, 0); \
        __builtin_amdgcn_raw_ptr_buffer_load_lds(rsA, (PG8_LAS void*)(lds + PG8_SA(b, h) + ldsw + 8192), 16, ((_p >> 16) << 12) + c2, (base), 0, 0); } else { _Pragma("unroll") for (int _i = 0; _i < 2; ++_i) \
        __builtin_amdgcn_raw_ptr_buffer_load_lds(rsA, (PG8_LAS void*)(lds + PG8_SA(b, h) + ldsw + _i * 8192), 16, voffA0, (base) + (unsigned)(h) * hstepA + (unsigned)_i * 128u * (unsigned)K, 0, 0); } } while (0)
#define PG8_BISSUE(R, rs, soff) do { if constexpr (VAR == 2 || VAR == 3 || VAR == 4) break; _Pragma("unroll") for (int _j = 0; _j < 4; ++_j) { const unsigned _so = (VAR == 5) ? (unsigned)__builtin_amdgcn_readfirstlane(_j * jstepB) : (unsigned)__builtin_amdgcn_readfirstlane((soff) + _j * jstepB); \
        asm volatile("buffer_load_dwordx4 %0, %1, %2, %3 offen" : "=v"(R[_j]) : "v"(voffBf), "s"(rs), "s"(_so) : "memory"); } } while (0)
#define PG8_RPIN(R) asm volatile("" : "+v"(R[0]), "+v"(R[1]), "+v"(R[2]), "+v"(R[3]))
#define PG8_BCOMMIT(R, bufoff, imgoff) do { if constexpr (VAR == 1 || VAR == 3 || VAR == 4) break; _Pragma("unroll") for (int _j = 0; _j < 4; ++_j) { u32x2 _w; _w.x = cvt_pk_bf16(R[_j][0], R[_j][1]); _w.y = cvt_pk_bf16(R[_j][2], R[_j][3]); \
        *(PG8_LAS u32x2*)(lds + (bufoff) + woffB + _j * 4096) = _w; \
        if constexpr (IMG) __builtin_amdgcn_raw_buffer_store_b64(_w, rsI, woffB, (unsigned)__builtin_amdgcn_readfirstlane((int)((imgoff) + _j * 4096)), 0); } } while (0)
#define PG8_WAIT_VC() do { if constexpr (IMG) asm volatile("s_waitcnt vmcnt(10)" ::: "memory"); else asm volatile("s_waitcnt vmcnt(6)" ::: "memory"); } while (0)
#define PG8_LDA(dst, b, h) do { _Pragma("unroll") for (int m = 0; m < 4; ++m) _Pragma("unroll") for (int k = 0; k < 2; ++k) dst[m][k] = *(const PG8_LAS bf16x8*)(lds + PG8_SA(b, h) + aoff + m * 2048 + k * 1024); } while (0)
#define PG8_LDBT(dst, b, h) do { if constexpr (VAR == 4) break; const unsigned _a0 = btb0 + PG8_SB(b, h), _a1 = (btb0 ^ 8u) + PG8_SB(b, h); s16x4 _r0, _r1, _r2, _r3, _r4, _r5, _r6, _r7; \
        asm volatile("ds_read_b64_tr_b16 %0, %8\n\tds_read_b64_tr_b16 %1, %8 offset:1024\n\tds_read_b64_tr_b16 %2, %8 offset:8192\n\tds_read_b64_tr_b16 %3, %8 offset:9216\n\t" \
                     "ds_read_b64_tr_b16 %4, %9\n\tds_read_b64_tr_b16 %5, %9 offset:1024\n\tds_read_b64_tr_b16 %6, %9 offset:8192\n\tds_read_b64_tr_b16 %7, %9 offset:9216" \
                     : "=&v"(_r0), "=&v"(_r1), "=&v"(_r2), "=&v"(_r3), "=&v"(_r4), "=&v"(_r5), "=&v"(_r6), "=&v"(_r7) : "v"(_a0), "v"(_a1) : "memory"); \
        dst[0][0] = (bf16x8){_r0[0], _r0[1], _r0[2], _r0[3], _r1[0], _r1[1], _r1[2], _r1[3]}; dst[0][1] = (bf16x8){_r2[0], _r2[1], _r2[2], _r2[3], _r3[0], _r3[1], _r3[2], _r3[3]}; \
        dst[1][0] = (bf16x8){_r4[0], _r4[1], _r4[2], _r4[3], _r5[0], _r5[1], _r5[2], _r5[3]}; dst[1][1] = (bf16x8){_r6[0], _r6[1], _r6[2], _r6[3], _r7[0], _r7[1], _r7[2], _r7[3]}; } while (0)
#define PG8_BPIN(Bt) asm volatile("" : "+v"(Bt[0][0]), "+v"(Bt[0][1]), "+v"(Bt[1][0]), "+v"(Bt[1][1]))
#define PG8_MMA(ai, bj, At, Bt) do { __builtin_amdgcn_s_setprio(1); _Pragma("unroll") for (int m = 0; m < 4; ++m) _Pragma("unroll") for (int n = 0; n < 2; ++n) _Pragma("unroll") for (int k = 0; k < 2; ++k) \
        acc[ai][bj][m][n] = __builtin_amdgcn_mfma_f32_16x16x32_bf16(Bt[n][k], At[m][k], acc[ai][bj][m][n], 0, 0, 0); __builtin_amdgcn_s_setprio(0); } while (0)
#define PG8_WAIT_V(n) asm volatile("s_waitcnt vmcnt(" #n ")" ::: "memory")
#define PG8_WAIT_L(n) asm volatile("s_waitcnt lgkmcnt(" #n ")" ::: "memory")
#define PG8_BAR __builtin_amdgcn_s_barrier()
#define PG8_SCHED __builtin_amdgcn_sched_barrier(0)
#define PG8_BOFF(u) ((unsigned)__builtin_amdgcn_readfirstlane((int)(((size_t)(u).e * g.estride + (size_t)(u).pn * g.ncstep) * 4)))
    Unit cur, nxt; int ui = 0;
#define PG8_UNI(u) do { (u).pm = __builtin_amdgcn_readfirstlane((u).pm); (u).pn = __builtin_amdgcn_readfirstlane((u).pn); (u).pb = __builtin_amdgcn_readfirstlane((u).pb); (u).e = __builtin_amdgcn_readfirstlane((u).e); (u).fl = __builtin_amdgcn_readfirstlane((u).fl); } while (0)
    if (!S.next(0, cur)) { S.finish(-1, tid); return; } PG8_UNI(cur);
    f32x4 acc[2][2][4][2];
#pragma unroll
    for (int a = 0; a < 2; ++a)
#pragma unroll
        for (int b = 0; b < 2; ++b)
#pragma unroll
            for (int m = 0; m < 4; ++m)
#pragma unroll
                for (int n = 0; n < 2; ++n) acc[a][b][m][n] = (f32x4){0.f, 0.f, 0.f, 0.f};
    bf16x8 At[4][2], B0[2][2], B1[2][2];
    f32x4 bp[4], bq[4];
    unsigned cA = GATH ? 0u : (unsigned)cur.pm * tstepA, cB = PG8_BOFF(cur), cI = (unsigned)cur.pb * istepI;
    if constexpr (GATH) { vt = *(const u32x2*)((const char*)g.vt + (size_t)cur.pm * 4096 + woffB); vn = vt; }
    S.a_ready(cur);
    PG8_BISSUE(bq, rs0, cB); PG8_STAGEA(0, 0, cA); PG8_BISSUE(bp, rs1, cB); PG8_STAGEA(0, 1, cA);
    if (wr == 1) PG8_BAR;
    PG8_WAIT_V(6); PG8_RPIN(bq); PG8_BCOMMIT(bq, PG8_SB(0, 0), cI); PG8_WAIT_L(0); PG8_BAR;
    PG8_BISSUE(bq, rs0, cB + kstepB); PG8_STAGEA(1, 0, cA + kstepA);
    PG8_WAIT_VC(); PG8_RPIN(bp); PG8_BCOMMIT(bp, PG8_SB(0, 1), cI + 16384u);
    PG8_BISSUE(bp, rs1, cB + kstepB);
    PG8_WAIT_VC(); PG8_RPIN(bq); PG8_BCOMMIT(bq, PG8_SB(1, 0), cI + 32768u);
    PG8_BISSUE(bq, rs0, cB + 2 * kstepB);
    PG8_WAIT_L(0); PG8_BAR;
    for (;;) {
        const bool has_next = S.next(ui + 1, nxt); PG8_UNI(nxt);
        const unsigned nA = GATH ? 0u : (has_next ? (unsigned)nxt.pm * tstepA : cA);
        const unsigned nV = (unsigned)__builtin_amdgcn_readfirstlane((has_next ? nxt.pm : cur.pm) * 4096);
        const unsigned nB = has_next ? PG8_BOFF(nxt) : cB; const unsigned nI = has_next ? (unsigned)nxt.pb * istepI : cI;
        for (int t = 0; t < nt; t += 2) {
            const bool last = (t == nt - 2);
            const unsigned a1 = cA + (unsigned)(t + 1) * kstepA, a2 = last ? nA : cA + (unsigned)(t + 2) * kstepA, a3 = a2 + kstepA;
            const unsigned b2 = last ? nB : cB + (unsigned)(t + 2) * kstepB, b3 = b2 + kstepB;
            const unsigned i2 = last ? nI : cI + (unsigned)(t + 2) * 32768u, i3 = i2 + 32768u;
            const unsigned b4 = (t + 4 < nt) ? cB + (unsigned)(t + 4) * kstepB : nB + (unsigned)(t + 4 - nt) * kstepB;
            if (last && has_next) S.a_ready(nxt);
            PG8_LDBT(B0, 0, 0); PG8_SCHED; PG8_LDA(At, 0, 0); PG8_STAGEA(1, 1, a1); if constexpr (GATH) { vt.x = last ? vn.x : vt.x; vt.y = last ? vn.y : vt.y; }
            PG8_WAIT_L(8); PG8_BAR; PG8_WAIT_L(0); PG8_BPIN(B0); PG8_MMA(0, 0, At, B0); PG8_BAR; PG8_SCHED;
            PG8_LDBT(B1, 0, 1); PG8_WAIT_VC(); PG8_RPIN(bp); if constexpr (GATH) asm volatile("buffer_load_dwordx2 %0, %1, %2, %3 offen" : "=v"(vn) : "v"(woffB), "s"(rsV), "s"(nV) : "memory");
            PG8_BCOMMIT(bp, PG8_SB(1, 1), cI + (unsigned)(t + 1) * 32768u + 16384u); PG8_BISSUE(bp, rs1, b2);
            PG8_BAR; PG8_WAIT_L(0); PG8_BPIN(B1); PG8_MMA(0, 1, At, B1); PG8_BAR;
            PG8_LDA(At, 0, 1); PG8_STAGEA(0, 0, a2);
            PG8_BAR; PG8_WAIT_L(0); PG8_MMA(1, 0, At, B0); PG8_BAR; PG8_SCHED;
            PG8_WAIT_VC(); PG8_RPIN(bq); PG8_BCOMMIT(bq, PG8_SB(0, 0), i2); PG8_BISSUE(bq, rs0, b3);
            PG8_BAR; PG8_MMA(1, 1, At, B1); PG8_BAR;
            PG8_LDBT(B0, 1, 0); PG8_SCHED; PG8_LDA(At, 1, 0); PG8_STAGEA(0, 1, a2);
            PG8_WAIT_L(8); PG8_BAR; PG8_WAIT_L(0); PG8_BPIN(B0); PG8_MMA(0, 0, At, B0); PG8_BAR; PG8_SCHED;
            PG8_LDBT(B1, 1, 1); PG8_WAIT_VC(); PG8_RPIN(bp); PG8_BCOMMIT(bp, PG8_SB(0, 1), i2 + 16384u); PG8_BISSUE(bp, rs1, b3);
            PG8_BAR; PG8_WAIT_L(0); PG8_BPIN(B1); PG8_MMA(0, 1, At, B1); PG8_BAR;
            PG8_LDA(At, 1, 1); PG8_STAGEA(1, 0, a3);
            PG8_BAR; PG8_WAIT_L(0); PG8_MMA(1, 0, At, B0); PG8_BAR; PG8_SCHED;
            PG8_WAIT_VC(); PG8_RPIN(bq); PG8_BCOMMIT(bq, PG8_SB(1, 0), i3); PG8_BISSUE(bq, rs0, b4);
            PG8_BAR; PG8_MMA(1, 1, At, B1); PG8_BAR;
        }
        int ln_; asm volatile("v_mbcnt_lo_u32_b32 %0, -1, 0\n\tv_mbcnt_hi_u32_b32 %0, -1, %0" : "=v"(ln_));
        { int fr_ = ln_ & 15, fq_ = ln_ >> 4;
          for (int r_ = 0; r_ < (PROBE_SUB == 8 ? 2 : 1); ++r_) E(acc, cur, wr, wc, fr_, fq_); }
        S.done(cur);
        if (!has_next) break;
#pragma unroll
        for (int a = 0; a < 2; ++a)
#pragma unroll
            for (int b = 0; b < 2; ++b)
#pragma unroll
                for (int m = 0; m < 4; ++m)
#pragma unroll
                    for (int n = 0; n < 2; ++n) acc[a][b][m][n] = (f32x4){0.f, 0.f, 0.f, 0.f};
        cur = nxt; cA = nA; cB = nB; cI = nI; ++ui;
    }
    PG8_WAIT_V(0); PG8_WAIT_L(0);
    asm volatile("" :: "v"(bp[0]), "v"(bp[1]), "v"(bp[2]), "v"(bp[3]), "v"(bq[0]), "v"(bq[1]), "v"(bq[2]), "v"(bq[3]));
    if (wr == 0) PG8_BAR;
    PG8_BAR;
#undef PG8_SA
#undef PG8_SB
#undef PG8_STAGEA
#undef PG8_BISSUE
#undef PG8_BCOMMIT
#undef PG8_RPIN
#undef PG8_WAIT_VC
#undef PG8_LDA
#undef PG8_LDBT
#undef PG8_BPIN
#undef PG8_MMA
#undef PG8_WAIT_V
#undef PG8_WAIT_L
#undef PG8_BAR
#undef PG8_SCHED
#undef PG8_UNI
#undef PG8_BOFF
}
}
namespace pg8 {
struct GroupedOrder {
    int nE, nMt, nNt, ERT, G, c, mt0;
    __device__ __forceinline__ bool next(int i, Unit& u) const {
        const int nwg = nE * nMt * nNt; const long L = (long)i * G + c; if (L >= nwg) return false;
        int wgid = (int)L; { const int q = nwg / NXCD, r = nwg % NXCD, xcd = wgid % NXCD, off = wgid / NXCD; wgid = (xcd < r ? xcd * (q + 1) : r * (q + 1) + (xcd - r) * q) + off; }
        const int per = nMt * nNt, e = wgid / per, rem = wgid % per, mt = rem % nMt, nt = rem / nMt;
        u.e = e; u.pm = e * ERT + mt0 + mt; u.pn = nt; u.pb = e * nNt + nt; u.fl = 0; return true;
    }
    __device__ __forceinline__ void a_ready(const Unit&) const {}
    __device__ __forceinline__ void done(const Unit&) const {}
    __device__ __forceinline__ void after_unit(int, int) const {}
    __device__ __forceinline__ void finish(int, int) const {}
};
struct OutOrder0 {
    StaticOrder S0; int G, c, split;
    __device__ __forceinline__ bool next(int i, Unit& u) const {
        const long L = (long)i * G + c; if (!split || L < 512) return S0.next(i, u);
        const int h = (int)L - 512; if (h >= 64) return false;
        u.pm = 64 + (h >> 4); u.pn = (h >> 1) & 7; u.pb = u.pn; u.e = 0; u.fl = (h & 1) ? 4 : 2; return true;
    }
    __device__ __forceinline__ void a_ready(const Unit&) const {}
    __device__ __forceinline__ void done(const Unit&) const {}
    __device__ __forceinline__ void after_unit(int, int) const {}
    __device__ __forceinline__ void finish(int, int) const {}
};

__device__ __forceinline__ int g8swz_(int k) { return (k & 1) | (((k >> 1) & 1) << 3) | (((k >> 3) & 1) << 4); }
struct ConvJob {
    const float* W0; const float* W1; size_t estride; int ncstep, ldb, nNt; bf16_t* img; int q0, q1, slot;
    __device__ __forceinline__ void run(int tid) const {
        const int kr = tid >> 5, c4 = tid & 31; const unsigned woff = (unsigned)(kr * 256 + 8 * (c4 ^ g8swz_(kr)));
        for (int q = q0; q < q1; q += 2) {
            f32x4 v[2][2][4];
#pragma unroll
            for (int u = 0; u < 2; ++u) { const int qq = (q + u < q1) ? q + u : q; const int pb = qq >> 5, kt = qq & 31, e = pb / nNt, nt = pb % nNt;
#pragma unroll
                for (int h = 0; h < 2; ++h) { const float* src = (h ? W1 : W0) + (size_t)e * estride + (size_t)nt * ncstep + (size_t)(kt * 64 + kr) * ldb + 4 * c4;
#pragma unroll
                    for (int j = 0; j < 4; ++j) v[u][h][j] = *(const f32x4*)(src + (size_t)(16 * j) * ldb); } }
#pragma unroll
            for (int u = 0; u < 2; ++u) { if (q + u >= q1) break; const int qq = q + u; const int pb = qq >> 5, kt = qq & 31;
                unsigned char* dst = (unsigned char*)img + (size_t)pb * 1048576 + (size_t)kt * 32768 + woff;
#pragma unroll
                for (int h = 0; h < 2; ++h)
#pragma unroll
                    for (int j = 0; j < 4; ++j) { u32x2 w; w.x = cvt_pk_bf16(v[u][h][j][0], v[u][h][j][1]); w.y = cvt_pk_bf16(v[u][h][j][2], v[u][h][j][3]); *(u32x2*)(dst + h * 16384 + j * 4096) = w; } }
        }
        asm volatile("s_waitcnt vmcnt(0)" ::: "memory");
    }
};
struct StaticOrderConv : StaticOrder { ConvJob job;
    __device__ __forceinline__ void after_unit(int ui, int tid) const { if (ui == job.slot) job.run(tid); }
    __device__ __forceinline__ void finish(int last, int tid) const { if (last < job.slot) job.run(tid); } };
struct GroupedOrderConv : GroupedOrder { ConvJob job;
    __device__ __forceinline__ void after_unit(int ui, int tid) const { if (ui == job.slot) job.run(tid); }
    __device__ __forceinline__ void finish(int last, int tid) const { if (last < job.slot) job.run(tid); } };
struct EpiProj {
    static constexpr bool PERM = true, AFTER_DRAIN = false;
    bf16_t* proj; bf16_t* su; const float* rope;
    __device__ __forceinline__ void operator()(const f32x4 (&acc)[2][2][4][2], const Unit& u, int wr, int wc, int fr, int fq) const {
        const int row0 = u.pm * BM + wr * 64 + fr; const int colt = u.pn * BM;
        const bool do_rope = (u.pn < 5) && (u.pm < 64);
        const bool is_su = (u.pn == 6) || (u.pn == 7);
#pragma unroll
        for (int ai = 0; ai < 2; ++ai)
#pragma unroll
            for (int m = 0; m < 4; ++m) {
                const int row = row0 + ai * HALF + m * 16;
#pragma unroll
                for (int bj = 0; bj < 2; ++bj) {
                    const int col = colt + bj * HALF + wc * 32 + 8 * fq;
                    f32x4 v0 = acc[ai][bj][m][0], v1 = acc[ai][bj][m][1];
                    if (do_rope) {
                        const int jj = col & 127, t = row & 4095; const int pos = (jj < 64) ? (t >> 6) : (t & 63); const int i0 = (jj & 63) >> 1;
                        const f32x4 cs0 = *(const f32x4*)(rope + (pos * 32 + i0) * 2), cs1 = *(const f32x4*)(rope + (pos * 32 + i0 + 2) * 2);
                        f32x4 o0, o1;
                        o0[0] = v0[0] * cs0[0] - v0[1] * cs0[1]; o0[1] = v0[1] * cs0[0] + v0[0] * cs0[1];
                        o0[2] = v0[2] * cs0[2] - v0[3] * cs0[3]; o0[3] = v0[3] * cs0[2] + v0[2] * cs0[3];
                        o1[0] = v1[0] * cs1[0] - v1[1] * cs1[1]; o1[1] = v1[1] * cs1[0] + v1[0] * cs1[1];
                        o1[2] = v1[2] * cs1[2] - v1[3] * cs1[3]; o1[3] = v1[3] * cs1[2] + v1[2] * cs1[3];
                        v0 = o0; v1 = o1;
                    }
                    u32x4 w; w.x = cvt_pk_bf16(v0[0], v0[1]); w.y = cvt_pk_bf16(v0[2], v0[3]); w.z = cvt_pk_bf16(v1[0], v1[1]); w.w = cvt_pk_bf16(v1[2], v1[3]);
                    if (is_su) { const int g = (col - C_SU) >> 4, h0 = col & 15; *(u32x4*)(su + ((size_t)g * MT + row) * 16 + h0) = w; }
                    else *(u32x4*)(proj + (size_t)row * NINP + col) = w;
                }
            }
    }
};
struct EpiGlu {
    static constexpr bool PERM = true, AFTER_DRAIN = false;
    const bf16_t* z; const float* bias; bf16_t* mix;
    __device__ __forceinline__ void operator()(const f32x4 (&acc)[2][2][4][2], const Unit& u, int wr, int wc, int fr, int fq) const {
        const int row0 = u.pm * BM + wr * 64 + fr; const int colt = u.pn * BM;
#pragma unroll
        for (int ai = 0; ai < 2; ++ai)
#pragma unroll
            for (int m = 0; m < 4; ++m) {
                const int row = row0 + ai * HALF + m * 16;
#pragma unroll
                for (int bj = 0; bj < 2; ++bj) {
                    const int col = colt + bj * HALF + wc * 32 + 8 * fq;
                    const f32x4 b0 = *(const f32x4*)(bias + col), b1 = *(const f32x4*)(bias + col + 4);
                    const u32x4 zz = *(const u32x4*)(z + ((size_t)(col >> 4) * MT + row) * 16 + (col & 15));
                    const f32x4 v0 = acc[ai][bj][m][0] + b0, v1 = acc[ai][bj][m][1] + b1;
                    float o[8];
                    o[0] = bflo(zz.x) * sigmoidf_(v0[0]); o[1] = bfhi(zz.x) * sigmoidf_(v0[1]); o[2] = bflo(zz.y) * sigmoidf_(v0[2]); o[3] = bfhi(zz.y) * sigmoidf_(v0[3]);
                    o[4] = bflo(zz.z) * sigmoidf_(v1[0]); o[5] = bfhi(zz.z) * sigmoidf_(v1[1]); o[6] = bflo(zz.w) * sigmoidf_(v1[2]); o[7] = bfhi(zz.w) * sigmoidf_(v1[3]);
                    u32x4 w; w.x = cvt_pk_bf16(o[0], o[1]); w.y = cvt_pk_bf16(o[2], o[3]); w.z = cvt_pk_bf16(o[4], o[5]); w.w = cvt_pk_bf16(o[6], o[7]);
                    *(u32x4*)(mix + (size_t)row * DM + 1024 + col) = w;
                }
            }
    }
};
struct EpiF32 {
    static constexpr bool PERM = false, AFTER_DRAIN = false;
    float* C; int ldc;
    __device__ __forceinline__ void operator()(const f32x4 (&acc)[2][2][4][2], const Unit& u, int wr, int wc, int fr, int fq) const {
        const int row0 = u.pm * BM + wr * 64 + fr, col0 = u.pn * BM + wc * 32 + 4 * fq;
#pragma unroll
        for (int ai = 0; ai < 2; ++ai)
#pragma unroll
            for (int m = 0; m < 4; ++m) { float* rowp = C + (size_t)(row0 + ai * HALF + m * 16) * ldc + col0;
#pragma unroll
                for (int bj = 0; bj < 2; ++bj)
#pragma unroll
                    for (int n = 0; n < 2; ++n) *(f32x4*)(rowp + bj * HALF + n * 16) = acc[ai][bj][m][n]; }
    }
};
struct EpiGateUp {
    static constexpr bool PERM = true, AFTER_DRAIN = false;
    bf16_t* hid;
    __device__ __forceinline__ void operator()(const f32x4 (&acc)[2][2][4][2], const Unit& u, int wr, int wc, int fr, int fq) const {
        const int row0 = u.pm * BM + wr * 64 + fr; const int col = u.pn * HALF + wc * 32 + 8 * fq;
#pragma unroll
        for (int ai = 0; ai < 2; ++ai) { if (ai == 1 && (u.fl & 1)) continue;
#pragma unroll
            for (int m = 0; m < 4; ++m) {
                const int row = row0 + ai * HALF + m * 16;
                const f32x4 g0 = acc[ai][0][m][0], g1 = acc[ai][0][m][1], u0 = acc[ai][1][m][0], u1 = acc[ai][1][m][1];
                u32x4 w; w.x = cvt_pk_bf16(siluf_(g0[0]) * u0[0], siluf_(g0[1]) * u0[1]); w.y = cvt_pk_bf16(siluf_(g0[2]) * u0[2], siluf_(g0[3]) * u0[3]);
                w.z = cvt_pk_bf16(siluf_(g1[0]) * u1[0], siluf_(g1[1]) * u1[1]); w.w = cvt_pk_bf16(siluf_(g1[2]) * u1[2], siluf_(g1[3]) * u1[3]);
                *(u32x4*)(hid + (size_t)row * DM + col) = w;
            } }
    }
};
struct EpiBf16 {
    static constexpr bool PERM = true, AFTER_DRAIN = false;
    bf16_t* O; int ldc;
    __device__ __forceinline__ void operator()(const f32x4 (&acc)[2][2][4][2], const Unit& u, int wr, int wc, int fr, int fq) const {
        const int row0 = u.pm * BM + wr * 64 + fr + ((u.fl & 8) ? HALF : 0); const int colt = u.pn * BM + ((u.fl & 16) ? HALF : 0);
#pragma unroll
        for (int ai = 0; ai < 2; ++ai) { if (ai == 1 && (u.fl & 1)) continue;
#pragma unroll
            for (int m = 0; m < 4; ++m) {
                bf16_t* rowp = O + (size_t)(row0 + ai * HALF + m * 16) * ldc + colt + wc * 32 + 8 * fq;
#pragma unroll
                for (int bj = 0; bj < 2; ++bj) { if ((bj == 1 && (u.fl & 2)) || (bj == 0 && (u.fl & 4))) continue; const f32x4 v0 = acc[ai][bj][m][0], v1 = acc[ai][bj][m][1];
                    u32x4 w; w.x = cvt_pk_bf16(v0[0], v0[1]); w.y = cvt_pk_bf16(v0[2], v0[3]); w.z = cvt_pk_bf16(v1[0], v1[1]); w.w = cvt_pk_bf16(v1[2], v1[3]);
                    *(u32x4*)(rowp + bj * HALF) = w; }
            } }
    }
};
}
struct Args { const float* in[30]; float* out; unsigned char* ws; int ph_lo, ph_hi; };
struct Frame {
    const float* const* in; float* out; unsigned char* ws; LAS unsigned char* lds; int tid, lane, wave, G, bid;
};
#define WSP(T, off) ((T*)(F.ws + (off)))

__device__ __forceinline__ int rope_perm(int o) { return (o < 64) ? (2 * (o & 31) + (o >> 5)) : (64 + 2 * ((o - 64) & 31) + ((o - 64) >> 5)); }
struct TileDesc { const float* src; bf16_t* dst; int ldn, nvalid, K, n0, k0, mode, ebase; };
__device__ __forceinline__ void tile_decode(const Frame& F, int q, TileDesc& d) {
    const int l = q / 752; q %= 752;
    if (q < 480) { d.src = F.in[6] + (size_t)l * DM * NIN; d.ldn = NIN; d.nvalid = NIN; d.K = DM; d.n0 = (q >> 3) * 64; d.k0 = (q & 7) * 256; d.dst = WSP(bf16_t, WS_WIN) + (size_t)l * NINP * DM; d.mode = 1; d.ebase = 0; }
    else if (q < 736) { q -= 480; d.src = F.in[21] + (size_t)l * DM * DM; d.ldn = DM; d.nvalid = DM; d.K = DM; d.n0 = (q >> 3) * 64; d.k0 = (q & 7) * 256; d.dst = WSP(bf16_t, WS_WOUT) + (size_t)l * DM * DM; d.mode = 0; d.ebase = 0; }
    else { q -= 736; d.src = F.in[16] + (size_t)l * 512 * 512; d.ldn = 512; d.nvalid = 512; d.K = 512; d.n0 = (q >> 1) * 64; d.k0 = (q & 1) * 256; d.dst = WSP(bf16_t, WS_WGLU) + (size_t)l * 512 * 512; d.mode = 0; d.ebase = 0; }
}
__device__ __forceinline__ void tile_load(const Frame& F, const TileDesc& d, f32x4 (&v)[8]) {
    const int kk = F.tid >> 4, n4 = (F.tid & 15) * 4;
#pragma unroll
    for (int i = 0; i < 8; ++i) { v[i] = (f32x4){0.f, 0.f, 0.f, 0.f}; if (d.n0 + n4 < d.nvalid) v[i] = *(const f32x4*)(d.src + (size_t)(d.k0 + kk + 32 * i) * d.ldn + d.n0 + n4); }
}
__device__ __forceinline__ void tile_to_lds(const Frame& F, const f32x4 (&v)[8]) {
    LAS float* tile = (LAS float*)F.lds; const int kk = F.tid >> 4, n4 = (F.tid & 15) * 4;
#pragma unroll
    for (int i = 0; i < 8; ++i) { const int k = kk + 32 * i; tile[k * 65 + n4 + 0] = v[i][0]; tile[k * 65 + n4 + 1] = v[i][1]; tile[k * 65 + n4 + 2] = v[i][2]; tile[k * 65 + n4 + 3] = v[i][3]; }
}
__device__ __forceinline__ void tile_store(const Frame& F, const TileDesc& d) {
    LAS float* tile = (LAS float*)F.lds; const int t = F.tid; const int n = t >> 3; const int ng = d.n0 + n; int drow;
    if (d.mode == 0) drow = ng;
    else if (d.mode == 1) { if (ng < 1280) drow = (ng & ~127) + rope_perm(ng & 127); else drow = ng; }
    else drow = d.ebase + (ng >> 7) * 256 + (ng & 127);
#pragma unroll
    for (int q = 0; q < 4; ++q) { const int k8 = (t & 7) * 8 + 64 * q; float v[8];
#pragma unroll
        for (int jj = 0; jj < 8; ++jj) v[jj] = tile[(k8 + jj) * 65 + n];
        u32x4 w; w.x = cvt_pk_bf16(v[0], v[1]); w.y = cvt_pk_bf16(v[2], v[3]); w.z = cvt_pk_bf16(v[4], v[5]); w.w = cvt_pk_bf16(v[6], v[7]);
        *(u32x4*)(d.dst + (size_t)drow * d.K + d.k0 + k8) = w; }
}
__device__ __forceinline__ void mod_partial(const Frame& F, int item) {
    const int l = item / 192, rem = item % 192, ks = rem / 6, cb = rem % 6;
    LAS float* sv = (LAS float*)F.lds;
    if (F.tid < 320) { const int r = F.tid >> 6, k = F.tid & 63; const float c = (r < 4) ? F.in[1][r * DM + ks * 64 + k] : F.in[3][ks * 64 + k]; sv[F.tid] = siluf_(c); }
    __syncthreads();
    const int col = cb * 2048 + F.tid * 4;
    const float* w = F.in[4] + (size_t)l * DM * 12288 + (size_t)(ks * 64) * 12288 + col;
    f32x4 a0 = {0, 0, 0, 0}, a1 = a0, a2 = a0, a3 = a0, a4 = a0;
#pragma unroll 4
    for (int k = 0; k < 64; ++k) { const f32x4 wv = *(const f32x4*)(w + (size_t)k * 12288);
        a0 += wv * sv[k]; a1 += wv * sv[64 + k]; a2 += wv * sv[128 + k]; a3 += wv * sv[192 + k]; a4 += wv * sv[256 + k]; }
    float* p = WSP(float, WS_MODP) + ((size_t)(l * 32 + ks) * 5) * 12288 + col;
    *(f32x4*)(p) = a0; *(f32x4*)(p + 12288) = a1; *(f32x4*)(p + 2 * 12288) = a2; *(f32x4*)(p + 3 * 12288) = a3; *(f32x4*)(p + 4 * 12288) = a4;
    __syncthreads();
}
__device__ __forceinline__ void rope_table(const Frame& F) {
    float* rp = WSP(float, WS_ROPE);
    for (int e = F.tid; e < 2048; e += NTHR) { const int pos = e >> 5, i = e & 31; const float inv = powf(10000.0f, -(float)i / 32.0f); const float ang = (float)pos * inv;
        rp[e * 2] = cosf(ang); rp[e * 2 + 1] = sinf(ang); }
}
__device__ __forceinline__ void s5_weights(const Frame& F, int l, int g, int hq) {
    LAS f32x2* pw = (LAS f32x2*)F.lds;
    LAS f32x2* bb = pw + 2 * 33 * 64;
    LAS f32x2* cc = bb + 2 * 64 * 16;
    LAS f32x2* cf = cc + 2 * 16 * 64;
    LAS float* Kt = (LAS float*)(cf + 128);
    const int t = F.tid;
    if (t < 128) { const int d = t >> 6, p = t & 63; const size_t ix = ((size_t)(l * 2 + d) * 32 + g) * 64 + p;
        const float lre = F.in[8][ix], lim = F.in[9][ix]; const float dt = expf(F.in[10][(l * 2 + d) * 32 + g]);
        const float ar = lre * dt, ai = lim * dt; const float mag = expf(ar); const float c = cosf(ai), s = sinf(ai); const f32x2 lb = {mag * c, mag * s};
        const float sh = sinf(0.5f * ai); const float nx = expm1f(ar) * c - 2.0f * sh * sh, ny = mag * s;
        const float den = lre * lre + lim * lim; cf[t] = (f32x2){(nx * lre + ny * lim) / den, (ny * lre - nx * lim) / den};
        f32x2 cur = {1.f, 0.f}; pw[(d * 33 + 0) * 64 + p] = cur;
        for (int k = 1; k <= 32; ++k) { const f32x2 nx2 = {cur.x * lb.x - cur.y * lb.y, cur.x * lb.y + cur.y * lb.x}; cur = nx2; pw[(d * 33 + k) * 64 + p] = cur; }
        if (hq == 0) WSP(f32x2, WS_LAMT)[((size_t)(l * 32 + g) * 2 + d) * 64 + p] = cur; }
    for (int e = t; e < 2048; e += NTHR) { const int d = e >> 10, h = (e >> 6) & 15, p = e & 63;
        const size_t ic = (((size_t)(l * 2 + d) * 32 + g) * 16 + h) * 64 + p; cc[(d * 16 + h) * 64 + p] = (f32x2){F.in[13][ic], F.in[14][ic]}; }
    __syncthreads();
    for (int e = t; e < 2048; e += NTHR) { const int d = e >> 10, p = (e >> 4) & 63, h = e & 15;
        const size_t ib = (((size_t)(l * 2 + d) * 32 + g) * 64 + p) * 16 + h; const float br = F.in[11][ib], bi = F.in[12][ib]; const f32x2 c = cf[d * 64 + p];
        bb[(d * 64 + p) * 16 + h] = (f32x2){c.x * br - c.y * bi, c.x * bi + c.y * br}; }
    __syncthreads();
    for (int e = t; e < 4096; e += NTHR) { const int d = e >> 11, j = (e >> 6) & 31, hp = 4 * hq + ((e >> 4) & 3), h = e & 15; float acc = 0.f;
#pragma unroll 4
        for (int p = 0; p < 64; ++p) { const f32x2 c = cc[(d * 16 + hp) * 64 + p], w = pw[(d * 33 + j) * 64 + p], b = bb[(d * 64 + p) * 16 + h];
            const float tx = c.x * w.x - c.y * w.y, ty = c.x * w.y + c.y * w.x; acc += tx * b.x - ty * b.y; }
        Kt[((d * 32 + j) * 16 + hp) * 16 + h] = acc; }
    __syncthreads();
    bf16_t* Wa = WSP(bf16_t, WS_S5A) + (size_t)(l * 32 + g) * 256 * 512;
    for (int e = hq * 16384 + t; e < (hq + 1) * 16384; e += NTHR) { const int p2 = e * 2, j = p2 & 7, lane = (p2 >> 3) & 63, f = p2 >> 9, ntile = f >> 4, ks = f & 15; const int n = ntile * 16 + (lane & 15), k2 = ks * 32 + (lane >> 4) * 8 + j;
        const int d = n >> 7, p = (n >> 1) & 63, c = n & 1; const int s = k2 >> 4, h = k2 & 15;
        const f32x2 w = pw[(d * 33 + (d == 0 ? 31 - s : s)) * 64 + p]; const f32x2 b0 = bb[(d * 64 + p) * 16 + h], b1 = bb[(d * 64 + p) * 16 + h + 1];
        const float v0 = c == 0 ? (w.x * b0.x - w.y * b0.y) : (w.x * b0.y + w.y * b0.x), v1 = c == 0 ? (w.x * b1.x - w.y * b1.y) : (w.x * b1.y + w.y * b1.x);
        *(unsigned*)(Wa + p2) = cvt_pk_bf16(v0, v1); }
    bf16_t* Wc = WSP(bf16_t, WS_S5C) + (size_t)(l * 32 + g) * 512 * 768;
    for (int e = t; e < 768 * 64; e += NTHR) { const int jp = e & 3, il = (e >> 2) & 3, g4 = (e >> 4) & 3, f = e >> 6; const int lane = g4 * 16 + 4 * hq + il, j = 2 * jp, p2 = (f * 64 + lane) * 8 + j, ntile = f / 24, ks = f % 24;
        const int n = ntile * 16 + (lane & 15), k2 = ks * 32 + g4 * 8 + j;
        const int tt = n >> 4, hp = n & 15; float v0, v1;
        if (k2 < 512) { const int s = k2 >> 4, h = k2 & 15; v0 = 0.f; v1 = 0.f;
            if (s <= tt) { v0 += Kt[((0 * 32 + (tt - s)) * 16 + hp) * 16 + h]; v1 += Kt[((0 * 32 + (tt - s)) * 16 + hp) * 16 + h + 1]; }
            if (s >= tt) { v0 += Kt[((1 * 32 + (s - tt)) * 16 + hp) * 16 + h]; v1 += Kt[((1 * 32 + (s - tt)) * 16 + hp) * 16 + h + 1]; } }
        else { const int d = (k2 - 512) >> 7, p = ((k2 - 512) >> 1) & 63; const f32x2 c = cc[(d * 16 + hp) * 64 + p], w = pw[(d * 33 + (d == 0 ? tt + 1 : 32 - tt)) * 64 + p];
            v0 = c.x * w.x - c.y * w.y; v1 = -(c.x * w.y + c.y * w.x); }
        *(unsigned*)(Wc + p2) = cvt_pk_bf16(v0, v1); }
    __syncthreads();
}
__device__ __forceinline__ void phase_prologue(const Frame& F) {
    int it = F.bid;
    for (; it < 256; it += F.G) s5_weights(F, it >> 7, (it >> 2) & 31, it & 3);
    for (; it < 256 + 384; it += F.G) mod_partial(F, it - 256);
    if (it == 640) { rope_table(F); it += F.G; }
    const int NT_ALL = 2 * 752;
    int q = it - 641;
    if (q < NT_ALL) {
        TileDesc d0, d1; f32x4 v0[8], v1[8];
        tile_decode(F, q, d0); tile_load(F, d0, v0);
        bool has1 = (q + F.G) < NT_ALL; d1 = d0; if (has1) { tile_decode(F, q + F.G, d1); tile_load(F, d1, v1); }
        for (;;) {
            tile_to_lds(F, v0); __syncthreads();
            const TileDesc c0 = d0; const bool has2 = (q + 2 * F.G) < NT_ALL;
            if (has2) { tile_decode(F, q + 2 * F.G, d0); tile_load(F, d0, v0); }
            tile_store(F, c0); __syncthreads();
            if (!has1) break;
            tile_to_lds(F, v1); __syncthreads();
            const TileDesc c1 = d1; const bool has3 = (q + 3 * F.G) < NT_ALL;
            if (has3) { tile_decode(F, q + 3 * F.G, d1); tile_load(F, d1, v1); }
            tile_store(F, c1); __syncthreads();
            if (!has2) break;
            q += 2 * F.G; has1 = has3;
        }
    }
}
__device__ __forceinline__ void phase_mod_reduce(const Frame& F) {
    for (int e = F.bid * NTHR + F.tid; e < 2 * 5 * 12288; e += F.G * NTHR) { const int l = e / 61440, rem = e % 61440, col = rem % 12288;
        float s = F.in[5][l * 12288 + col]; const float* p = WSP(float, WS_MODP) + (size_t)l * 32 * 61440 + rem;
        float pv[32];
#pragma unroll
        for (int ks = 0; ks < 32; ++ks) pv[ks] = p[(size_t)ks * 61440];
#pragma unroll
        for (int ks = 0; ks < 32; ++ks) s += pv[ks];
        WSP(float, WS_MOD)[e] = s; }
}
__device__ __forceinline__ void row_stats(const float (&v)[32], float& mu, float& rstd) {
    float s = 0.f;
#pragma unroll
    for (int i = 0; i < 32; ++i) s += v[i];
    mu = wave_sum(s) * (1.0f / 2048.0f); float q = 0.f;
#pragma unroll
    for (int i = 0; i < 32; ++i) { const float d = v[i] - mu; q += d * d; }
    rstd = rsqrtf(wave_sum(q) * (1.0f / 2048.0f) + LN_EPS);
}
__device__ __forceinline__ void load_row32(const float* p, int lane, float (&v)[32]) {
#pragma unroll
    for (int i = 0; i < 8; ++i) { const f32x4 t = *(const f32x4*)(p + (i * 64 + lane) * 4); v[i * 4] = t[0]; v[i * 4 + 1] = t[1]; v[i * 4 + 2] = t[2]; v[i * 4 + 3] = t[3]; }
}
__device__ __forceinline__ void mod_store_bf16(const float (&v)[32], float mu, float rstd, const float* sh, const float* sc, bf16_t* dst, int lane) {
#pragma unroll
    for (int i = 0; i < 8; ++i) { const int c = (i * 64 + lane) * 4; const f32x4 a = *(const f32x4*)(sc + c), b = *(const f32x4*)(sh + c);
        const float o0 = (v[i * 4] - mu) * rstd * (1.f + a[0]) + b[0], o1 = (v[i * 4 + 1] - mu) * rstd * (1.f + a[1]) + b[1], o2 = (v[i * 4 + 2] - mu) * rstd * (1.f + a[2]) + b[2], o3 = (v[i * 4 + 3] - mu) * rstd * (1.f + a[3]) + b[3];
        u32x2 w; w.x = cvt_pk_bf16(o0, o1); w.y = cvt_pk_bf16(o2, o3); *(u32x2*)(dst + c) = w; }
}
#define ROWMAP_NTRIP(nrows) (F.G == 256 ? ((nrows) > NLAT ? 9 : 8) : ((nrows) + F.G * 8 - 1) / (F.G * 8))
#define ROWMAP_ROW(k, nrows) (F.G == 256 ? ((k) < 8 ? F.bid * 64 + (k) * 8 + F.wave : (F.wave < 4 ? NLAT + F.bid * 4 + F.wave : -1)) : ((F.bid * 8 + F.wave + (k) * F.G * 8) < (nrows) ? (F.bid * 8 + F.wave + (k) * F.G * 8) : -1))
#define ROWMAP_BATCH(k) (F.G == 256 ? ((k) < 8 ? (F.bid >> 6) : 4) : ((F.bid * 8 + (k) * F.G * 8) < NLAT ? ((F.bid * 8 + (k) * F.G * 8) >> 12) : 4))
__device__ __forceinline__ void phase_ln1_first(const Frame& F) {
    const float* mod = WSP(float, WS_MOD);
    LAS float* Vsh = (LAS float*)F.lds; LAS float* Vsc = Vsh + 2048; int bcur = -1;
    const int ntrip = ROWMAP_NTRIP(MT);
    for (int k = 0; k < ntrip; ++k) { const int row = ROWMAP_ROW(k, MT), b = ROWMAP_BATCH(k); const bool rv = row >= 0; const int rowc = rv ? row : 0;
        const float* xr = rowc < NLAT ? F.in[0] + (size_t)rowc * DM : F.in[2] + (size_t)(rowc - NLAT) * DM;
        float v[32]; load_row32(xr, F.lane, v);
        if (b != bcur) { bcur = b; __syncthreads(); { const int c0 = F.tid * 4; *(LAS f32x4*)(Vsh + c0) = *(const f32x4*)(mod + (size_t)b * 12288 + c0); *(LAS f32x4*)(Vsc + c0) = *(const f32x4*)(mod + (size_t)b * 12288 + 2048 + c0); } __syncthreads(); }
        float mu, rstd; row_stats(v, mu, rstd);
        bf16_t* dst = WSP(bf16_t, WS_H) + (size_t)rowc * DM;
        if (rv)
#pragma unroll
        for (int i = 0; i < 8; ++i) { const int c = (i * 64 + F.lane) * 4; const f32x4 a = *(const LAS f32x4*)(Vsc + c), bq = *(const LAS f32x4*)(Vsh + c);
            const float o0 = (v[i * 4] - mu) * rstd * (1.f + a[0]) + bq[0], o1 = (v[i * 4 + 1] - mu) * rstd * (1.f + a[1]) + bq[1], o2 = (v[i * 4 + 2] - mu) * rstd * (1.f + a[2]) + bq[2], o3 = (v[i * 4 + 3] - mu) * rstd * (1.f + a[3]) + bq[3];
            u32x2 w; w.x = cvt_pk_bf16(o0, o1); w.y = cvt_pk_bf16(o2, o3); *(u32x2*)(dst + c) = w; }
    }
    __syncthreads();
}

template <int OFF0> __device__ __forceinline__ void tr_read16_attn(unsigned base, bf16x8 (&vf)[8]) {
    s16x4 r0, r1, r2, r3, r4, r5, r6, r7, r8, r9, r10, r11, r12, r13, r14, r15;
    asm volatile("ds_read_b64_tr_b16 %0, %16 offset:%c17+0\n\t"
        "ds_read_b64_tr_b16 %1, %16 offset:%c17+4352\n\t"
        "ds_read_b64_tr_b16 %2, %16 offset:%c17+32\n\t"
        "ds_read_b64_tr_b16 %3, %16 offset:%c17+4384\n\t"
        "ds_read_b64_tr_b16 %4, %16 offset:%c17+64\n\t"
        "ds_read_b64_tr_b16 %5, %16 offset:%c17+4416\n\t"
        "ds_read_b64_tr_b16 %6, %16 offset:%c17+96\n\t"
        "ds_read_b64_tr_b16 %7, %16 offset:%c17+4448\n\t"
        "ds_read_b64_tr_b16 %8, %16 offset:%c17+128\n\t"
        "ds_read_b64_tr_b16 %9, %16 offset:%c17+4480\n\t"
        "ds_read_b64_tr_b16 %10, %16 offset:%c17+160\n\t"
        "ds_read_b64_tr_b16 %11, %16 offset:%c17+4512\n\t"
        "ds_read_b64_tr_b16 %12, %16 offset:%c17+192\n\t"
        "ds_read_b64_tr_b16 %13, %16 offset:%c17+4544\n\t"
        "ds_read_b64_tr_b16 %14, %16 offset:%c17+224\n\t"
        "ds_read_b64_tr_b16 %15, %16 offset:%c17+4576\n\t"
        "s_waitcnt lgkmcnt(0)"
        : "=&v"(r0), "=&v"(r1), "=&v"(r2), "=&v"(r3), "=&v"(r4), "=&v"(r5), "=&v"(r6), "=&v"(r7), "=&v"(r8), "=&v"(r9), "=&v"(r10), "=&v"(r11), "=&v"(r12), "=&v"(r13), "=&v"(r14), "=&v"(r15) : "v"(base), "i"(OFF0) : "memory");
    vf[0] = (bf16x8){r0[0], r0[1], r0[2], r0[3], r1[0], r1[1], r1[2], r1[3]};
    vf[1] = (bf16x8){r2[0], r2[1], r2[2], r2[3], r3[0], r3[1], r3[2], r3[3]};
    vf[2] = (bf16x8){r4[0], r4[1], r4[2], r4[3], r5[0], r5[1], r5[2], r5[3]};
    vf[3] = (bf16x8){r6[0], r6[1], r6[2], r6[3], r7[0], r7[1], r7[2], r7[3]};
    vf[4] = (bf16x8){r8[0], r8[1], r8[2], r8[3], r9[0], r9[1], r9[2], r9[3]};
    vf[5] = (bf16x8){r10[0], r10[1], r10[2], r10[3], r11[0], r11[1], r11[2], r11[3]};
    vf[6] = (bf16x8){r12[0], r12[1], r12[2], r12[3], r13[0], r13[1], r13[2], r13[3]};
    vf[7] = (bf16x8){r14[0], r14[1], r14[2], r14[3], r15[0], r15[1], r15[2], r15[3]};
}
template <int OFF0> __device__ __forceinline__ void tr_read16_kdec(unsigned base, bf16x8 (&vf)[8]) {
    s16x4 r0, r1, r2, r3, r4, r5, r6, r7, r8, r9, r10, r11, r12, r13, r14, r15;
    asm volatile("ds_read_b64_tr_b16 %0, %16 offset:%c17+0\n\t"
        "ds_read_b64_tr_b16 %1, %16 offset:%c17+576\n\t"
        "ds_read_b64_tr_b16 %2, %16 offset:%c17+32\n\t"
        "ds_read_b64_tr_b16 %3, %16 offset:%c17+608\n\t"
        "ds_read_b64_tr_b16 %4, %16 offset:%c17+64\n\t"
        "ds_read_b64_tr_b16 %5, %16 offset:%c17+640\n\t"
        "ds_read_b64_tr_b16 %6, %16 offset:%c17+96\n\t"
        "ds_read_b64_tr_b16 %7, %16 offset:%c17+672\n\t"
        "ds_read_b64_tr_b16 %8, %16 offset:%c17+4608\n\t"
        "ds_read_b64_tr_b16 %9, %16 offset:%c17+5184\n\t"
        "ds_read_b64_tr_b16 %10, %16 offset:%c17+4640\n\t"
        "ds_read_b64_tr_b16 %11, %16 offset:%c17+5216\n\t"
        "ds_read_b64_tr_b16 %12, %16 offset:%c17+4672\n\t"
        "ds_read_b64_tr_b16 %13, %16 offset:%c17+5248\n\t"
        "ds_read_b64_tr_b16 %14, %16 offset:%c17+4704\n\t"
        "ds_read_b64_tr_b16 %15, %16 offset:%c17+5280\n\t"
        "s_waitcnt lgkmcnt(0)"
        : "=&v"(r0), "=&v"(r1), "=&v"(r2), "=&v"(r3), "=&v"(r4), "=&v"(r5), "=&v"(r6), "=&v"(r7), "=&v"(r8), "=&v"(r9), "=&v"(r10), "=&v"(r11), "=&v"(r12), "=&v"(r13), "=&v"(r14), "=&v"(r15) : "v"(base), "i"(OFF0) : "memory");
    vf[0] = (bf16x8){r0[0], r0[1], r0[2], r0[3], r1[0], r1[1], r1[2], r1[3]};
    vf[1] = (bf16x8){r2[0], r2[1], r2[2], r2[3], r3[0], r3[1], r3[2], r3[3]};
    vf[2] = (bf16x8){r4[0], r4[1], r4[2], r4[3], r5[0], r5[1], r5[2], r5[3]};
    vf[3] = (bf16x8){r6[0], r6[1], r6[2], r6[3], r7[0], r7[1], r7[2], r7[3]};
    vf[4] = (bf16x8){r8[0], r8[1], r8[2], r8[3], r9[0], r9[1], r9[2], r9[3]};
    vf[5] = (bf16x8){r10[0], r10[1], r10[2], r10[3], r11[0], r11[1], r11[2], r11[3]};
    vf[6] = (bf16x8){r12[0], r12[1], r12[2], r12[3], r13[0], r13[1], r13[2], r13[3]};
    vf[7] = (bf16x8){r14[0], r14[1], r14[2], r14[3], r15[0], r15[1], r15[2], r15[3]};
}
template <int OFF0> __device__ __forceinline__ void tr_read16_glav(unsigned base, bf16x8 (&vf)[8]) {
    s16x4 r0, r1, r2, r3, r4, r5, r6, r7, r8, r9, r10, r11, r12, r13, r14, r15;
    asm volatile("ds_read_b64_tr_b16 %0, %16 offset:%c17+0\n\t"
        "ds_read_b64_tr_b16 %1, %16 offset:%c17+4352\n\t"
        "ds_read_b64_tr_b16 %2, %16 offset:%c17+32\n\t"
        "ds_read_b64_tr_b16 %3, %16 offset:%c17+4384\n\t"
        "ds_read_b64_tr_b16 %4, %16 offset:%c17+64\n\t"
        "ds_read_b64_tr_b16 %5, %16 offset:%c17+4416\n\t"
        "ds_read_b64_tr_b16 %6, %16 offset:%c17+96\n\t"
        "ds_read_b64_tr_b16 %7, %16 offset:%c17+4448\n\t"
        "ds_read_b64_tr_b16 %8, %16 offset:%c17+8704\n\t"
        "ds_read_b64_tr_b16 %9, %16 offset:%c17+13056\n\t"
        "ds_read_b64_tr_b16 %10, %16 offset:%c17+8736\n\t"
        "ds_read_b64_tr_b16 %11, %16 offset:%c17+13088\n\t"
        "ds_read_b64_tr_b16 %12, %16 offset:%c17+8768\n\t"
        "ds_read_b64_tr_b16 %13, %16 offset:%c17+13120\n\t"
        "ds_read_b64_tr_b16 %14, %16 offset:%c17+8800\n\t"
        "ds_read_b64_tr_b16 %15, %16 offset:%c17+13152\n\t"
        "s_waitcnt lgkmcnt(0)"
        : "=&v"(r0), "=&v"(r1), "=&v"(r2), "=&v"(r3), "=&v"(r4), "=&v"(r5), "=&v"(r6), "=&v"(r7), "=&v"(r8), "=&v"(r9), "=&v"(r10), "=&v"(r11), "=&v"(r12), "=&v"(r13), "=&v"(r14), "=&v"(r15) : "v"(base), "i"(OFF0) : "memory");
    vf[0] = (bf16x8){r0[0], r0[1], r0[2], r0[3], r1[0], r1[1], r1[2], r1[3]};
    vf[1] = (bf16x8){r2[0], r2[1], r2[2], r2[3], r3[0], r3[1], r3[2], r3[3]};
    vf[2] = (bf16x8){r4[0], r4[1], r4[2], r4[3], r5[0], r5[1], r5[2], r5[3]};
    vf[3] = (bf16x8){r6[0], r6[1], r6[2], r6[3], r7[0], r7[1], r7[2], r7[3]};
    vf[4] = (bf16x8){r8[0], r8[1], r8[2], r8[3], r9[0], r9[1], r9[2], r9[3]};
    vf[5] = (bf16x8){r10[0], r10[1], r10[2], r10[3], r11[0], r11[1], r11[2], r11[3]};
    vf[6] = (bf16x8){r12[0], r12[1], r12[2], r12[3], r13[0], r13[1], r13[2], r13[3]};
    vf[7] = (bf16x8){r14[0], r14[1], r14[2], r14[3], r15[0], r15[1], r15[2], r15[3]};
}
template <int OFF0> __device__ __forceinline__ void tr_read8_attn(unsigned base, bf16x8 (&vf)[4]) {
    s16x4 r0, r1, r2, r3, r4, r5, r6, r7;
    asm volatile("ds_read_b64_tr_b16 %0, %8 offset:%c9+0\n\t"
        "ds_read_b64_tr_b16 %1, %8 offset:%c9+4352\n\t"
        "ds_read_b64_tr_b16 %2, %8 offset:%c9+32\n\t"
        "ds_read_b64_tr_b16 %3, %8 offset:%c9+4384\n\t"
        "ds_read_b64_tr_b16 %4, %8 offset:%c9+64\n\t"
        "ds_read_b64_tr_b16 %5, %8 offset:%c9+4416\n\t"
        "ds_read_b64_tr_b16 %6, %8 offset:%c9+96\n\t"
        "ds_read_b64_tr_b16 %7, %8 offset:%c9+4448\n\t"
        "s_waitcnt lgkmcnt(0)"
        : "=&v"(r0), "=&v"(r1), "=&v"(r2), "=&v"(r3), "=&v"(r4), "=&v"(r5), "=&v"(r6), "=&v"(r7) : "v"(base), "i"(OFF0) : "memory");
    vf[0] = (bf16x8){r0[0], r0[1], r0[2], r0[3], r1[0], r1[1], r1[2], r1[3]};
    vf[1] = (bf16x8){r2[0], r2[1], r2[2], r2[3], r3[0], r3[1], r3[2], r3[3]};
    vf[2] = (bf16x8){r4[0], r4[1], r4[2], r4[3], r5[0], r5[1], r5[2], r5[3]};
    vf[3] = (bf16x8){r6[0], r6[1], r6[2], r6[3], r7[0], r7[1], r7[2], r7[3]};
}
constexpr int AT_PITCH = 272;
constexpr int AT_TILE = 64 * AT_PITCH;
__device__ __forceinline__ void attn_item(const Frame& F, int l, int qrow0  , int qpos0  , int hp  , int b, int kc_lo, int nlat) {
    const bf16_t* __restrict__ proj = WSP(bf16_t, WS_R1); bf16_t* __restrict__ mix = WSP(bf16_t, WS_R3);
    const int lane = F.lane, i16 = lane & 15, g4 = lane >> 4, w = F.wave >> 1  , h = hp * 2 + (F.wave & 1), kvh = hp >> 1;
    LAS unsigned char* lds = F.lds;
    const int nchunk = nlat + 4;
    bf16x8 qf[2][4];
#pragma unroll
    for (int u = 0; u < 2; ++u) { const bf16_t* qp = proj + (size_t)(qrow0 + w * 32 + u * 16 + i16) * NINP + C_Q + h * 128 + 8 * g4;
#pragma unroll
        for (int ks = 0; ks < 4; ++ks) qf[u][ks] = *(const bf16x8*)(qp + ks * 32); }
    const float sink = F.in[7][l * 8 + h];
    const float SC = 0.08838834764831845f, C2 = SC * 1.4426950408889634f;
    float m_run[2] = {sink / SC, sink / SC}, l_run[2] = {(g4 == 0) ? 1.0f : 0.0f, (g4 == 0) ? 1.0f : 0.0f};
    f32x4 o[2][8];
#pragma unroll
    for (int u = 0; u < 2; ++u)
#pragma unroll
        for (int d = 0; d < 8; ++d) o[u][d] = (f32x4){0.f, 0.f, 0.f, 0.f};
    const int skey = F.tid >> 3, sseg = F.tid & 7;
    u32x4 rk0, rk1, rv0, rv1;
#define AT_CROW(c) (((c) < nlat) ? (b * SEQ + (kc_lo + (c)) * 64) : (NLAT + b * CTXL + ((c) - nlat) * 64))
#define AT_GLOAD(c) do { const bf16_t* kp_ = proj + (size_t)(AT_CROW(c) + skey) * NINP + C_K + kvh * 128 + sseg * 8; rk0 = *(const u32x4*)kp_; rk1 = *(const u32x4*)(kp_ + 64); rv0 = *(const u32x4*)(kp_ + 256); rv1 = *(const u32x4*)(kp_ + 256 + 64); } while (0)
#define AT_LSTORE(buf) do { LAS unsigned char* kb_ = lds + (buf) * 2 * AT_TILE + skey * AT_PITCH + sseg * 16; *(LAS u32x4*)kb_ = rk0; *(LAS u32x4*)(kb_ + 128) = rk1; *(LAS u32x4*)(kb_ + AT_TILE) = rv0; *(LAS u32x4*)(kb_ + AT_TILE + 128) = rv1; } while (0)
    AT_GLOAD(0); AT_LSTORE(0); __syncthreads();
    const int wq0 = qpos0 + w * 32;
    for (int c = 0; c < nchunk; ++c) {
        const int buf = c & 1;
        if (c + 1 < nchunk) AT_GLOAD(c + 1);
        const int k0 = (kc_lo + c) * 64; const bool lat = c < nlat;
        const bool skip = lat && (k0 > wq0 + 31 + 128 || k0 + 63 < wq0 - 128);
        const bool need_mask = lat && !(k0 >= wq0 + 31 - 128 && k0 + 63 <= wq0 + 128);
        if (!skip) {
        const LAS unsigned char* kb = lds + buf * 2 * AT_TILE; const LAS unsigned char* vb = kb + AT_TILE;
        f32x4 st[2][4];
#pragma unroll
        for (int kt = 0; kt < 4; ++kt) { st[0][kt] = (f32x4){0.f, 0.f, 0.f, 0.f}; st[1][kt] = (f32x4){0.f, 0.f, 0.f, 0.f};
#pragma unroll
            for (int ks = 0; ks < 4; ++ks) { const bf16x8 kf = *(const LAS bf16x8*)(kb + (kt * 16 + i16) * AT_PITCH + (ks * 32 + 8 * g4) * 2); st[0][kt] = MFMA16(kf, qf[0][ks], st[0][kt]); st[1][kt] = MFMA16(kf, qf[1][ks], st[1][kt]); } }
        if (need_mask) {
#pragma unroll
            for (int u = 0; u < 2; ++u) { const int qp = wq0 + u * 16 + i16; const int kp0 = k0 + 4 * g4;
#pragma unroll
                for (int kt = 0; kt < 4; ++kt)
#pragma unroll
                    for (int r = 0; r < 4; ++r) { const int dlt = qp - (kp0 + kt * 16 + r); if (dlt > 128 || dlt < -128) st[u][kt][r] = -1e30f; } } }
        bf16x8 pf[2][2];
#pragma unroll
        for (int u = 0; u < 2; ++u) {
            float mx = st[u][0][0];
#pragma unroll
            for (int kt = 0; kt < 4; ++kt)
#pragma unroll
                for (int r = 0; r < 4; ++r) mx = fmaxf(mx, st[u][kt][r]);
            mx = fmaxf(mx, shx<16>(mx)); mx = fmaxf(mx, shx<32>(mx));
            const float m_new = fmaxf(m_run[u], mx); const float alpha = __builtin_amdgcn_exp2f((m_run[u] - m_new) * C2); m_run[u] = m_new;
            const float mc = m_new * C2; float ps = 0.f;
#pragma unroll
            for (int kt = 0; kt < 4; ++kt)
#pragma unroll
                for (int r = 0; r < 4; ++r) { const float p = __builtin_amdgcn_exp2f(st[u][kt][r] * C2 - mc); st[u][kt][r] = p; ps += p; }
            l_run[u] = l_run[u] * alpha + ps;
            if (__any(alpha != 1.0f)) {
#pragma unroll
                for (int d = 0; d < 8; ++d) o[u][d] *= alpha; }
#pragma unroll
            for (int ks2 = 0; ks2 < 2; ++ks2) { u32x4 t4; t4.x = cvt_pk_bf16(st[u][2 * ks2][0], st[u][2 * ks2][1]); t4.y = cvt_pk_bf16(st[u][2 * ks2][2], st[u][2 * ks2][3]); t4.z = cvt_pk_bf16(st[u][2 * ks2 + 1][0], st[u][2 * ks2 + 1][1]); t4.w = cvt_pk_bf16(st[u][2 * ks2 + 1][2], st[u][2 * ks2 + 1][3]); pf[u][ks2] = __builtin_bit_cast(bf16x8, t4); }
        }
        const unsigned vaddr = lds_addr_of(vb) + (unsigned)((4 * g4 + (i16 >> 2)) * AT_PITCH + (4 * (i16 & 3)) * 2);
#pragma unroll
        for (int ks2 = 0; ks2 < 2; ++ks2) {
#pragma unroll
            for (int dh = 0; dh < 2; ++dh) { bf16x8 vf[4];
                if (ks2 == 0) { if (dh == 0) tr_read8_attn<0>(vaddr, vf); else tr_read8_attn<128>(vaddr, vf); } else { if (dh == 0) tr_read8_attn<32 * AT_PITCH>(vaddr, vf); else tr_read8_attn<32 * AT_PITCH + 128>(vaddr, vf); }
#pragma unroll
                for (int d = 0; d < 4; ++d) { o[0][dh * 4 + d] = MFMA16(vf[d], pf[0][ks2], o[0][dh * 4 + d]); o[1][dh * 4 + d] = MFMA16(vf[d], pf[1][ks2], o[1][dh * 4 + d]); } }
        }
        }
        if (c + 1 < nchunk) AT_LSTORE(buf ^ 1);
        __syncthreads();
    }
#undef AT_CROW
#undef AT_GLOAD
#undef AT_LSTORE
#pragma unroll
    for (int u = 0; u < 2; ++u) {
        float lr = l_run[u]; lr += shx<16>(lr); lr += shx<32>(lr);
        const float inv = 1.0f / lr;
        bf16_t* op = mix + (size_t)(qrow0 + w * 32 + u * 16 + i16) * DM + h * 128 + 4 * g4;
#pragma unroll
        for (int d = 0; d < 8; ++d) { u32x2 wv; wv.x = cvt_pk_bf16(o[u][d][0] * inv, o[u][d][1] * inv); wv.y = cvt_pk_bf16(o[u][d][2] * inv, o[u][d][3] * inv); *(u32x2*)(op + d * 16) = wv; } }
}
__device__ __forceinline__ void attn_items(const Frame& F, int l, int first, int stride) {
    const int nitem = 512 + (l == 0 ? 32 : 0);
    for (int it = first; it < nitem; it += stride) {
        if (it < 512) { const int hp = it & 3, qb = (it >> 2) & 31, b = it >> 7; const int kc_lo = qb > 0 ? qb * 2 - 2 : 0, kc_hi = qb < 31 ? qb * 2 + 3 : 63;
            attn_item(F, l, b * SEQ + qb * 128, qb * 128, hp, b, kc_lo, kc_hi - kc_lo + 1);
        } else { const int j = it - 512; const int hp = j & 3, half = (j >> 2) & 1, b = j >> 3;
            attn_item(F, l, NLAT + b * CTXL + half * 128, 0, hp, b, 0, 0); }
    }
}
constexpr int S5_APITCH = (768 + 8) * 2;
template <int NT, int KT, int MTL>
__device__ __forceinline__ void s5_mm(const LAS unsigned char* A, const bf16_t* __restrict__ Bt, int lane, int wave, f32x4 (&acc)[MTL][NT]) {
    const int i16 = lane & 15, g4 = lane >> 4;
#pragma unroll
    for (int m = 0; m < MTL; ++m)
#pragma unroll
        for (int n = 0; n < NT; ++n) acc[m][n] = (f32x4){0.f, 0.f, 0.f, 0.f};
    const bf16_t* bp = Bt + ((size_t)(wave * NT) * (KT / 32) * 64 + lane) * 8;
    const LAS unsigned char* ap = A + i16 * S5_APITCH + 16 * g4;
    constexpr int KB = (MTL >= 4 && NT >= 4) ? 1 : 4;
    for (int ks0 = 0; ks0 < KT / 32; ks0 += KB) {
        bf16x8 bf[KB][NT];
#pragma unroll
        for (int q = 0; q < KB; ++q)
#pragma unroll
            for (int n = 0; n < NT; ++n) bf[q][n] = *(const bf16x8*)(bp + (size_t)(n * (KT / 32) + ks0 + q) * 512);
#pragma unroll
        for (int q = 0; q < KB; ++q) {
#pragma unroll
            for (int m = 0; m < MTL; ++m) { const bf16x8 am = *(const LAS bf16x8*)(ap + m * 16 * S5_APITCH + (ks0 + q) * 64);
#pragma unroll
                for (int n = 0; n < NT; ++n) acc[m][n] = MFMA16(am, bf[q][n], acc[m][n]); } }
    }
}
__device__ __forceinline__ void s5a_items(const Frame& F, int l, int xcd, int first, int stride) {
    const bf16_t* __restrict__ su = WSP(bf16_t, WS_SU); float* __restrict__ S = WSP(float, WS_S5S);
    for (int li = first; li < (xcd < 0 ? 256 : 32); li += stride) { const int g = (xcd < 0) ? (li >> 3) : (xcd + 8 * (li >> 3)), rb = li & 7;
        __syncthreads();
        { u32x4 ta[10];
#pragma unroll
          for (int q = 0; q < 10; ++q) { const int e = F.tid + q * NTHR, r = e >> 6, sg = e & 63; ta[q] = *(const u32x4*)(su + ((size_t)g * MT + (size_t)(rb * 68 + r) * 32) * 16 + sg * 8); }
#pragma unroll
          for (int q = 0; q < 10; ++q) { const int e = F.tid + q * NTHR, r = e >> 6, sg = e & 63; *(LAS u32x4*)(F.lds + r * S5_APITCH + sg * 16) = ta[q]; } }
        __syncthreads();
        f32x4 acc[5][2]; s5_mm<2, 512, 5>(F.lds, WSP(bf16_t, WS_S5A) + (size_t)(l * 32 + g) * 256 * 512, F.lane, F.wave, acc);
        const int i16 = F.lane & 15, g4 = F.lane >> 4;
#pragma unroll
        for (int m = 0; m < 5; ++m)
#pragma unroll
            for (int r = 0; r < 4; ++r) { const int lr = m * 16 + 4 * g4 + r, cr = rb * 68 + lr; if (lr < 68) {
#pragma unroll
                for (int n = 0; n < 2; ++n) S[((size_t)cr * 32 + g) * 256 + F.wave * 32 + n * 16 + i16] = acc[m][n][r]; } }
    }
}
__device__ __forceinline__ void s5_scan(const Frame& F, int l, int first_thread, int nthreads) {
    const float* S = WSP(float, WS_S5S); bf16_t* SI = WSP(bf16_t, WS_S5IN);
    for (int e = first_thread; e < 4 * 32 * 128; e += nthreads) { const int p = e & 63, d = (e >> 6) & 1, g = (e >> 7) & 31, b = e >> 12;
        const f32x2 lt = WSP(f32x2, WS_LAMT)[((size_t)(l * 32 + g) * 2 + d) * 64 + p];
        float sx = 0.f, sy = 0.f; const size_t co = (size_t)g * 256 + d * 128 + p * 2;
#pragma unroll 8
        for (int i = 0; i < 136; ++i) { int r; if (i < 8) r = 512 + b * 8 + (d == 0 ? i : 7 - i); else r = b * 128 + (d == 0 ? (i - 8) : 127 - (i - 8));
            const f32x2 sv = *(const f32x2*)(S + (size_t)r * 8192 + co);
            *(unsigned*)(SI + (size_t)r * 8192 + co) = cvt_pk_bf16(sx, sy);
            const float nx = lt.x * sx - lt.y * sy + sv.x, ny = lt.x * sy + lt.y * sx + sv.y; sx = nx; sy = ny; }
    }
}
__device__ __forceinline__ void s5c_items(const Frame& F, int l, int xcd, int first, int stride) {
    const bf16_t* __restrict__ su = WSP(bf16_t, WS_SU); const bf16_t* __restrict__ SI = WSP(bf16_t, WS_S5IN); bf16_t* __restrict__ zb = WSP(bf16_t, WS_R3 + (size_t)MT * DM * 2);
    for (int li = first; li < (xcd < 0 ? 256 : 32); li += stride) { const int g = (xcd < 0) ? (li >> 3) : (xcd + 8 * (li >> 3)), rb = li & 7;
        __syncthreads();
#pragma unroll
        for (int hq = 0; hq < 2; ++hq) { u32x4 ta[5];
#pragma unroll
          for (int q = 0; q < 5; ++q) { const int e = F.tid + (hq * 5 + q) * NTHR, r = e >> 6, sg = e & 63; ta[q] = *(const u32x4*)(su + ((size_t)g * MT + (size_t)(rb * 68 + r) * 32) * 16 + sg * 8); }
#pragma unroll
          for (int q = 0; q < 5; ++q) { const int e = F.tid + (hq * 5 + q) * NTHR, r = e >> 6, sg = e & 63; *(LAS u32x4*)(F.lds + r * S5_APITCH + sg * 16) = ta[q]; } }
        { u32x4 tb[5];
#pragma unroll
          for (int q = 0; q < 5; ++q) { const int e = F.tid + q * NTHR, r = e >> 5, sg = e & 31; tb[q] = *(const u32x4*)(SI + ((size_t)(rb * 68 + r) * 32 + g) * 256 + sg * 8); }
#pragma unroll
          for (int q = 0; q < 5; ++q) { const int e = F.tid + q * NTHR, r = e >> 5, sg = e & 31; *(LAS u32x4*)(F.lds + r * S5_APITCH + 1024 + sg * 16) = tb[q]; } }
        __syncthreads();
        f32x4 acc[5][4]; s5_mm<4, 768, 5>(F.lds, WSP(bf16_t, WS_S5C) + (size_t)(l * 32 + g) * 512 * 768, F.lane, F.wave, acc);
        const int i16 = F.lane & 15, g4 = F.lane >> 4; const float dd = F.in[15][l * 512 + g * 16 + i16];
        __syncthreads();
#pragma unroll
        for (int m = 0; m < 5; ++m)
#pragma unroll
            for (int n = 0; n < 4; ++n)
#pragma unroll
                for (int r = 0; r < 4; ++r) { LAS bf16_t* up = (LAS bf16_t*)(F.lds + (m * 16 + 4 * g4 + r) * S5_APITCH) + (F.wave * 4 + n) * 16 + i16; *up = f2bf(gelu_tanh(acc[m][n][r] + dd * bf2f(*up))); }
        __syncthreads();
#pragma unroll
        for (int hq = 0; hq < 3; ++hq) { u32x4 tz[3];
#pragma unroll
          for (int q = 0; q < 3; ++q) { const int e = F.tid + (hq * 3 + q) * NTHR, r = e >> 6, sg = e & 63; tz[q] = *(const LAS u32x4*)(F.lds + r * S5_APITCH + sg * 16); }
#pragma unroll
          for (int q = 0; q < 3; ++q) { const int e = F.tid + (hq * 3 + q) * NTHR, r = e >> 6, sg = e & 63; if (r < 68) *(u32x4*)(zb + ((size_t)g * MT + (size_t)(rb * 68 + r) * 32) * 16 + sg * 8) = tz[q]; } }
    }
}
constexpr int GL_GB = 0  , GL_KD = 32768  , GL_VT = 51200  , GL_GZ = 68608  , GL_WG = 76800  ,
              GL_BL = 84992  , GL_TOT = 85504  ;
constexpr int G3_Q = 0  , G3_K = 18432, G3_V = 36864  , G3_S = 54272  , G3_SSQ = 91136  ;
constexpr int GL_P64 = 144, GL_P128 = 272;
__device__ __forceinline__ int gla_row0(int b, int j) { return j < 4 ? NLAT + b * CTXL + j * 64 : b * SEQ + (j - 4) * 64; }
__device__ __forceinline__ void gla1_items(const Frame& F, int l, int first, int stride) {
    const bf16_t* __restrict__ proj = WSP(bf16_t, WS_R1); float* __restrict__ upd = WSP(float, WS_R3 + (size_t)MT * DM * 2 + (size_t)MT * 512 * 2); float* __restrict__ dec = WSP(float, WS_GDEC);
    bf16_t* __restrict__ gqin = WSP(bf16_t, WS_GQIN); bf16_t* __restrict__ gkp = WSP(bf16_t, WS_GKP);
    LAS float* gb = (LAS float*)(F.lds + GL_GB); LAS float* gz = (LAS float*)(F.lds + GL_GZ); LAS float* wg = (LAS float*)(F.lds + GL_WG); LAS float* bl = (LAS float*)(F.lds + GL_BL); LAS float* tot = (LAS float*)(F.lds + GL_TOT);
    const int t = F.tid, tk = t >> 3, k0 = (t & 7) * 8;
    u32x2 gzr; u32x4 qv, kv, vv0, vv1; f32x4 wgr; f32x4 bg[2][2];
#define GL1_LOAD_A(IT) do { const int j_ = (IT) % 68, bh_ = (IT) / 68, h_ = bh_ & 3, b_ = bh_ >> 2; const bf16_t* rp_ = proj + (size_t)(gla_row0(b_, j_) + tk) * NINP; \
        gzr = *(const u32x2*)(rp_ + C_GZ + (t & 7) * 4); vv0 = *(const u32x4*)(rp_ + C_GV + h_ * 128 + (t & 7) * 8); vv1 = *(const u32x4*)(rp_ + C_GV + h_ * 128 + 64 + (t & 7) * 8); \
        { const int e4 = t * 4, d = e4 >> 10, r = (e4 >> 6) & 15, k = e4 & 63; wgr = *(const f32x4*)(F.in[18] + ((size_t)(l * 2 + d) * 16 + r) * 256 + h_ * 64 + k); } } while (0)
#define GL1_LOAD_B(IT) do { const int h_ = ((IT) / 68) & 3; _Pragma("unroll") for (int d = 0; d < 2; ++d) { bg[d][0] = *(const f32x4*)(F.in[19] + (l * 2 + d) * 256 + h_ * 64 + k0); bg[d][1] = *(const f32x4*)(F.in[19] + (l * 2 + d) * 256 + h_ * 64 + k0 + 4); } } while (0)
#define GL1_LOAD_C(IT) do { const int j_ = (IT) % 68, bh_ = (IT) / 68, h_ = bh_ & 3, b_ = bh_ >> 2; const bf16_t* rp_ = proj + (size_t)(gla_row0(b_, j_) + tk) * NINP; \
        qv = *(const u32x4*)(rp_ + C_GQ + h_ * 64 + k0); kv = *(const u32x4*)(rp_ + C_GK + h_ * 64 + k0); } while (0)
    if (first < 16 * 68) { GL1_LOAD_A(first); GL1_LOAD_B(first); GL1_LOAD_C(first); }
    for (int it = first; it < 16 * 68; it += stride) { const int j = it % 68, bh = it / 68, h = bh & 3, b = bh >> 2; const bool more = it + stride < 16 * 68;
        __syncthreads();
        { const int c0 = (t & 7) * 4; gz[tk * 32 + c0] = bflo(gzr.x); gz[tk * 32 + c0 + 1] = bfhi(gzr.x); gz[tk * 32 + c0 + 2] = bflo(gzr.y); gz[tk * 32 + c0 + 3] = bfhi(gzr.y); *(LAS f32x4*)(wg + t * 4) = wgr;
          *(LAS u32x4*)(F.lds + GL_VT + tk * GL_P128 + (t & 7) * 16) = vv0; *(LAS u32x4*)(F.lds + GL_VT + tk * GL_P128 + 128 + (t & 7) * 16) = vv1; }
        __syncthreads();
        if (more) GL1_LOAD_A(it + stride);
#pragma unroll
        for (int d = 0; d < 2; ++d) { float a[8] = {bg[d][0][0], bg[d][0][1], bg[d][0][2], bg[d][0][3], bg[d][1][0], bg[d][1][1], bg[d][1][2], bg[d][1][3]};
#pragma unroll
            for (int r = 0; r < 16; ++r) { const float zv = gz[tk * 32 + d * 16 + r]; const f32x4 w0 = *(const LAS f32x4*)(wg + (d * 16 + r) * 64 + k0), w1 = *(const LAS f32x4*)(wg + (d * 16 + r) * 64 + k0 + 4);
                a[0] += zv * w0[0]; a[1] += zv * w0[1]; a[2] += zv * w0[2]; a[3] += zv * w0[3]; a[4] += zv * w1[0]; a[5] += zv * w1[1]; a[6] += zv * w1[2]; a[7] += zv * w1[3]; }
#pragma unroll
            for (int q = 0; q < 8; ++q) gb[(d * 64 + tk) * 64 + k0 + q] = logsigmoidf_(a[q]) * (1.0f / 16.0f); }
        if (more) GL1_LOAD_B(it + stride);
        __syncthreads();
        { const int k = t & 63, seg = t >> 6; float vf[8], vb[8]; float rf = 0.f, rb = 0.f;
#pragma unroll
          for (int q = 0; q < 8; ++q) { rf += gb[(seg * 8 + q) * 64 + k]; vf[q] = rf; }
#pragma unroll
          for (int q = 7; q >= 0; --q) { rb += gb[(64 + seg * 8 + q) * 64 + k]; vb[q] = rb; }
          tot[seg * 64 + k] = rf; tot[512 + seg * 64 + k] = rb;
          __syncthreads();
          float pf = 0.f, pb = 0.f, af = 0.f, ab = 0.f;
#pragma unroll
          for (int s2 = 0; s2 < 8; ++s2) { const float x = tot[s2 * 64 + k], y = tot[512 + s2 * 64 + k]; af += x; ab += y; if (s2 < seg) pf += x; if (s2 > seg) pb += y; }
#pragma unroll
          for (int q = 0; q < 8; ++q) { gb[(seg * 8 + q) * 64 + k] = vf[q] + pf; gb[(64 + seg * 8 + q) * 64 + k] = vb[q] + pb; }
          if (seg == 0) { bl[k] = af; bl[64 + k] = ab; } }
        __syncthreads();
        { const float qq[8] = {bflo(qv.x), bfhi(qv.x), bflo(qv.y), bfhi(qv.y), bflo(qv.z), bfhi(qv.z), bflo(qv.w), bfhi(qv.w)}, kk[8] = {bflo(kv.x), bfhi(kv.x), bflo(kv.y), bfhi(kv.y), bflo(kv.z), bfhi(kv.z), bflo(kv.w), bfhi(kv.w)};
#pragma unroll
          for (int d = 0; d < 2; ++d) { float qo[8], ko[8], kd[8];
#pragma unroll
              for (int q = 0; q < 8; ++q) { const float bv = gb[(d * 64 + tk) * 64 + k0 + q]; qo[q] = qq[q] * 0.125f * __expf(bv); ko[q] = kk[q] * __expf(-bv); kd[q] = kk[q] * __expf(bl[d * 64 + k0 + q] - bv); }
              const size_t go = ((size_t)(((b * 4 + h) * 2 + d) * 68 + j) * 64 + tk) * 64 + k0; u32x4 w;
              w.x = cvt_pk_bf16(qo[0], qo[1]); w.y = cvt_pk_bf16(qo[2], qo[3]); w.z = cvt_pk_bf16(qo[4], qo[5]); w.w = cvt_pk_bf16(qo[6], qo[7]); *(u32x4*)(gqin + go) = w;
              w.x = cvt_pk_bf16(ko[0], ko[1]); w.y = cvt_pk_bf16(ko[2], ko[3]); w.z = cvt_pk_bf16(ko[4], ko[5]); w.w = cvt_pk_bf16(ko[6], ko[7]); *(u32x4*)(gkp + go) = w;
              w.x = cvt_pk_bf16(kd[0], kd[1]); w.y = cvt_pk_bf16(kd[2], kd[3]); w.z = cvt_pk_bf16(kd[4], kd[5]); w.w = cvt_pk_bf16(kd[6], kd[7]); *(LAS u32x4*)(F.lds + GL_KD + (d * 64 + tk) * GL_P64 + k0 * 2) = w; }
          if (t < 128) dec[(size_t)((((b * 4 + h) * 2 + (t >> 6)) * 68) + j) * 64 + (t & 63)] = __expf(bl[t]); }
        if (more) GL1_LOAD_C(it + stride);
        __syncthreads();
        const int i16 = F.lane & 15, g4 = F.lane >> 4, w = F.wave;
        const unsigned va = lds_addr_of(F.lds + GL_VT) + (unsigned)((8 * g4 + (i16 >> 2)) * GL_P128 + (w * 16 + 4 * (i16 & 3)) * 2);
        const unsigned ka = lds_addr_of(F.lds + GL_KD) + (unsigned)((8 * g4 + (i16 >> 2)) * GL_P64 + (4 * (i16 & 3)) * 2);
        const bf16x8 af0 = tr_read2(va, va + 4 * GL_P128), af1 = tr_read2(va + 32 * GL_P128, va + 32 * GL_P128 + 4 * GL_P128);
#pragma unroll
        for (int d = 0; d < 2; ++d) { bf16x8 kf[8]; if (d == 0) tr_read16_kdec<0>(ka, kf); else tr_read16_kdec<64 * GL_P64>(ka, kf);
            float* up = upd + (size_t)((((b * 4 + h) * 2 + d) * 68) + j) * 8192;
#pragma unroll
            for (int kt = 0; kt < 4; ++kt) { f32x4 acc = (f32x4){0.f, 0.f, 0.f, 0.f}; acc = MFMA16(af0, kf[kt], acc); acc = MFMA16(af1, kf[4 + kt], acc);
#pragma unroll
                for (int r = 0; r < 4; ++r) up[(w * 16 + 4 * g4 + r) * 64 + kt * 16 + i16] = acc[r]; } }
    }
#undef GL1_LOAD_A
#undef GL1_LOAD_B
#undef GL1_LOAD_C
}
__device__ __forceinline__ void gla3_items(const Frame& F, int l, int first, int stride) {
    const bf16_t* __restrict__ proj = WSP(bf16_t, WS_R1); const bf16_t* __restrict__ gst = WSP(bf16_t, WS_GST); bf16_t* __restrict__ mix = WSP(bf16_t, WS_R3);
    const bf16_t* __restrict__ gqin = WSP(bf16_t, WS_GQIN); const bf16_t* __restrict__ gkp = WSP(bf16_t, WS_GKP);
    const int jlo = (l == 0) ? 0 : 4;
    const int nj = 68 - jlo; const int t = F.tid, tk = t >> 3, sg8 = t & 7;
    const int i16 = F.lane & 15, g4 = F.lane >> 4, w = F.wave, tt = w & 3, vh = w >> 2;
    u32x4 rq[2], rk[2], rs[2][2], rv[2];
#define GL3_LOAD(IT) do { const int j_ = jlo + (IT) % nj, bh_ = (IT) / nj, h_ = bh_ & 3, b_ = bh_ >> 2; const int row0_ = gla_row0(b_, j_); \
        _Pragma("unroll") for (int d = 0; d < 2; ++d) { const size_t cj = (size_t)(((b_ * 4 + h_) * 2 + d) * 68 + j_); rq[d] = *(const u32x4*)(gqin + (cj * 64 + tk) * 64 + sg8 * 8); rk[d] = *(const u32x4*)(gkp + (cj * 64 + tk) * 64 + sg8 * 8); \
            _Pragma("unroll") for (int q = 0; q < 2; ++q) { const int e = t + q * NTHR; rs[d][q] = *(const u32x4*)(gst + cj * 8192 + (size_t)(e >> 3) * 64 + (e & 7) * 8); } } \
        _Pragma("unroll") for (int q = 0; q < 2; ++q) rv[q] = *(const u32x4*)(proj + (size_t)(row0_ + tk) * NINP + C_GV + h_ * 128 + (sg8 + 8 * q) * 8); } while (0)
    if (first < 16 * nj) GL3_LOAD(first);
    for (int it = first; it < 16 * nj; it += stride) { const int j = jlo + it % nj, bh = it / nj, h = bh & 3, b = bh >> 2; const int row0 = gla_row0(b, j);
        const size_t orow = (size_t)(row0 + tt * 16 + i16);
        u32x2 rr[4]; f32x4 ng[4];
#pragma unroll
        for (int v4 = 0; v4 < 4; ++v4) { const int v = (vh * 4 + v4) * 16 + 4 * g4; rr[v4] = *(const u32x2*)(proj + orow * NINP + C_GR + h * 128 + v); ng[v4] = *(const f32x4*)(F.in[20] + l * 128 + v); }
        __syncthreads();
#pragma unroll
        for (int d = 0; d < 2; ++d) { *(LAS u32x4*)(F.lds + G3_Q + (d * 64 + tk) * GL_P64 + sg8 * 16) = rq[d]; *(LAS u32x4*)(F.lds + G3_K + (d * 64 + tk) * GL_P64 + sg8 * 16) = rk[d];
#pragma unroll
            for (int q = 0; q < 2; ++q) { const int e = t + q * NTHR; *(LAS u32x4*)(F.lds + G3_S + (d * 128 + (e >> 3)) * GL_P64 + (e & 7) * 16) = rs[d][q]; } }
#pragma unroll
        for (int q = 0; q < 2; ++q) *(LAS u32x4*)(F.lds + G3_V + tk * GL_P128 + (sg8 + 8 * q) * 16) = rv[q];
        __syncthreads();
        if (it + stride < 16 * nj) GL3_LOAD(it + stride);
        f32x4 o[4];
#pragma unroll
        for (int v4 = 0; v4 < 4; ++v4) o[v4] = (f32x4){0.f, 0.f, 0.f, 0.f};
        bf16x8 vf[8];
        tr_read16_glav<0>(lds_addr_of(F.lds + G3_V) + (unsigned)((4 * g4 + (i16 >> 2)) * GL_P128 + (vh * 64 + 4 * (i16 & 3)) * 2), vf);
#pragma unroll
        for (int d = 0; d < 2; ++d) {
            const LAS unsigned char* qb_ = F.lds + G3_Q + d * 64 * GL_P64; const LAS unsigned char* kb_ = F.lds + G3_K + d * 64 * GL_P64; const LAS unsigned char* sb_ = F.lds + G3_S + d * 128 * GL_P64;
            bf16x8 qf[2];
#pragma unroll
            for (int ks = 0; ks < 2; ++ks) qf[ks] = *(const LAS bf16x8*)(qb_ + (tt * 16 + i16) * GL_P64 + (ks * 32 + 8 * g4) * 2);
            f32x4 st[4];
#pragma unroll
            for (int s4 = 0; s4 < 4; ++s4) { st[s4] = (f32x4){0.f, 0.f, 0.f, 0.f};
#pragma unroll
                for (int ks = 0; ks < 2; ++ks) { const bf16x8 kf = *(const LAS bf16x8*)(kb_ + (s4 * 16 + i16) * GL_P64 + (ks * 32 + 8 * g4) * 2); st[s4] = MFMA16(kf, qf[ks], st[s4]); }
#pragma unroll
                for (int r = 0; r < 4; ++r) { const int s = s4 * 16 + 4 * g4 + r, tq = tt * 16 + i16; if (d == 0 ? (s > tq) : (s < tq)) st[s4][r] = 0.f; } }
#pragma unroll
            for (int ks2 = 0; ks2 < 2; ++ks2) {
                bf16x8 pf; { u32x4 t4; t4.x = cvt_pk_bf16(st[2 * ks2][0], st[2 * ks2][1]); t4.y = cvt_pk_bf16(st[2 * ks2][2], st[2 * ks2][3]); t4.z = cvt_pk_bf16(st[2 * ks2 + 1][0], st[2 * ks2 + 1][1]); t4.w = cvt_pk_bf16(st[2 * ks2 + 1][2], st[2 * ks2 + 1][3]); pf = __builtin_bit_cast(bf16x8, t4); }
#pragma unroll
                for (int v4 = 0; v4 < 4; ++v4) o[v4] = MFMA16(vf[ks2 * 4 + v4], pf, o[v4]);
            }
#pragma unroll
            for (int v4 = 0; v4 < 4; ++v4)
#pragma unroll
                for (int ks = 0; ks < 2; ++ks) { const bf16x8 sf = *(const LAS bf16x8*)(sb_ + ((vh * 4 + v4) * 16 + i16) * GL_P64 + (ks * 32 + 8 * g4) * 2); o[v4] = MFMA16(sf, qf[ks], o[v4]); }
        }
        float ss = 0.f;
#pragma unroll
        for (int v4 = 0; v4 < 4; ++v4)
#pragma unroll
            for (int r = 0; r < 4; ++r) ss += o[v4][r] * o[v4][r];
        ss += shx<16>(ss); ss += shx<32>(ss);
        LAS float* ssq = (LAS float*)(F.lds + G3_SSQ);
        if (g4 == 0) ssq[vh * 64 + tt * 16 + i16] = ss;
        __syncthreads();
        const float rinv = rsqrtf((ssq[tt * 16 + i16] + ssq[64 + tt * 16 + i16]) * (1.0f / 128.0f) + LN_EPS);
#pragma unroll
        for (int v4 = 0; v4 < 4; ++v4) { const int v = (vh * 4 + v4) * 16 + 4 * g4; const float r0 = bflo(rr[v4].x), r1 = bfhi(rr[v4].x), r2 = bflo(rr[v4].y), r3 = bfhi(rr[v4].y);
            u32x2 wv; wv.x = cvt_pk_bf16(o[v4][0] * rinv * ng[v4][0] * siluf_(r0), o[v4][1] * rinv * ng[v4][1] * siluf_(r1)); wv.y = cvt_pk_bf16(o[v4][2] * rinv * ng[v4][2] * siluf_(r2), o[v4][3] * rinv * ng[v4][3] * siluf_(r3));
            *(u32x2*)(mix + orow * DM + 1536 + h * 128 + v) = wv; }
    }
#undef GL3_LOAD
}
__device__ __forceinline__ void row_stats1(const float (&v)[32], float& mu, float& rstd) {
    float s = 0.f, q = 0.f;
#pragma unroll
    for (int i = 0; i < 32; ++i) { s += v[i]; q += v[i] * v[i]; }
    s = wave_sum_dpp(s); q = wave_sum_dpp(q);
    mu = s * (1.0f / 2048.0f); const float var = fmaxf(q * (1.0f / 2048.0f) - mu * mu, 0.f); rstd = rsqrtf(var + LN_EPS);
}
__device__ __forceinline__ void phase_ln_mid(const Frame& F, int l) {
    float alpha_ = ALPHA; asm volatile("" : "+v"(alpha_));
    const int nrows = (l == 0) ? MT : NLAT;
    const float* __restrict__ mod = WSP(float, WS_MOD) + (size_t)l * 5 * 12288; const bf16_t* __restrict__ Y = WSP(bf16_t, WS_R2);
    LAS float* Rt = (LAS float*)F.lds;
    { const float* __restrict__ rp = F.in[26] + (size_t)l * 2048 * 16; f32x4 rv[16];
#pragma unroll
      for (int q = 0; q < 16; ++q) rv[q] = *(const f32x4*)(rp + (size_t)(F.tid + NTHR * q) * 4);
#pragma unroll
      for (int q = 0; q < 16; ++q) { const int e4 = F.tid + NTHR * q, c = e4 >> 2, x4 = (e4 & 3) * 4; Rt[(x4 + 0) * 2048 + c] = rv[q][0]; Rt[(x4 + 1) * 2048 + c] = rv[q][1]; Rt[(x4 + 2) * 2048 + c] = rv[q][2]; Rt[(x4 + 3) * 2048 + c] = rv[q][3]; } }
    __syncthreads();
    const float* __restrict__ g1 = F.in[22] + l * DM; const float* __restrict__ b1 = F.in[23] + l * DM;
    bf16_t* __restrict__ X1 = WSP(bf16_t, WS_X1); bf16_t* __restrict__ H = WSP(bf16_t, WS_H);
#define LNM_XIN(r) ((r) < NLAT ? F.in[0] + (size_t)(r) * DM : F.in[2] + (size_t)((r) - NLAT) * DM)
#define LNM_XLOAD(r) do { if (l == 0) { const float* __restrict__ xin = LNM_XIN(r); _Pragma("unroll") for (int i = 0; i < 8; ++i) xa[i] = *(const f32x4*)(xin + (i * 64 + F.lane) * 4); } \
        else { const bf16_t* __restrict__ xin = WSP(bf16_t, WS_X2B) + (size_t)(r) * DM; _Pragma("unroll") for (int i = 0; i < 8; ++i) { const u32x2 t_ = *(const u32x2*)(xin + (i * 64 + F.lane) * 4); xa[i][0] = __uint_as_float(t_.x); xa[i][1] = __uint_as_float(t_.y); } } \
        _Pragma("unroll") for (int i = 0; i < 8; ++i) ya[i] = *(const u32x2*)(Y + (size_t)(r) * DM + (i * 64 + F.lane) * 4); } while (0)
    f32x4 xa[8]; u32x2 ya[8];
#pragma unroll
    for (int i = 0; i < 8; ++i) xa[i] = (f32x4){0.f, 0.f, 0.f, 0.f};
    const int ntrip = ROWMAP_NTRIP(nrows);
    { const int row = ROWMAP_ROW(0, nrows); if (row >= 0) LNM_XLOAD(row); }
    LAS float* Vgt1 = (LAS float*)(F.lds + 131072); LAS float* Vsc2 = Vgt1 + 2048; LAS float* Vsh2 = Vsc2 + 2048;
    int bcur = -1;
    for (int k = 0; k < ntrip; ++k) {
        const int row = ROWMAP_ROW(k, nrows), b = ROWMAP_BATCH(k);
        if (b != bcur) { bcur = b; __syncthreads();
            { const float* mb = mod + (size_t)b * 12288; const int c0 = F.tid * 4; *(LAS f32x4*)(Vgt1 + c0) = *(const f32x4*)(mb + 4096 + c0); *(LAS f32x4*)(Vsc2 + c0) = *(const f32x4*)(mb + 8192 + c0); *(LAS f32x4*)(Vsh2 + c0) = *(const f32x4*)(mb + 6144 + c0); }
            __syncthreads(); }
        float v[32];
        { f32x4 ga[8];
#pragma unroll
          for (int i = 0; i < 8; ++i) ga[i] = *(const LAS f32x4*)(Vgt1 + (i * 64 + F.lane) * 4);
#pragma unroll
          for (int i = 0; i < 8; ++i) { float x0 = xa[i][0], x1 = xa[i][1], x2 = xa[i][2], x3 = xa[i][3];
              if (l != 0) { const unsigned p0 = __float_as_uint(xa[i][0]), p1 = __float_as_uint(xa[i][1]); x0 = bflo(p0); x1 = bfhi(p0); x2 = bflo(p1); x3 = bfhi(p1); }
              v[i * 4] = alpha_ * x0 + ga[i][0] * bflo(ya[i].x); v[i * 4 + 1] = alpha_ * x1 + ga[i][1] * bfhi(ya[i].x); v[i * 4 + 2] = alpha_ * x2 + ga[i][2] * bflo(ya[i].y); v[i * 4 + 3] = alpha_ * x3 + ga[i][3] * bfhi(ya[i].y); } }
        { const int nrow = (k + 1 < ntrip) ? ROWMAP_ROW(k + 1, nrows) : -1; if (nrow >= 0) LNM_XLOAD(nrow); }
        if (row < 0) continue;
        f32x4 gg[8], bb[8];
#pragma unroll
        for (int i = 0; i < 8; ++i) { const int c0 = (i * 64 + F.lane) * 4; gg[i] = *(const f32x4*)(g1 + c0); bb[i] = *(const f32x4*)(b1 + c0); }
        float mu, rstd; row_stats1(v, mu, rstd);
#pragma unroll
        for (int i = 0; i < 8; ++i) { const int c0 = (i * 64 + F.lane) * 4; f32x4 o;
#pragma unroll
            for (int c = 0; c < 4; ++c) { o[c] = (v[i * 4 + c] - mu) * rstd * gg[i][c] + bb[i][c]; v[i * 4 + c] = o[c]; }
            u32x2 w1; w1.x = cvt_pk_bf16(o[0], o[1]); w1.y = cvt_pk_bf16(o[2], o[3]); *(u32x2*)(X1 + (size_t)row * DM + c0) = w1; }
#pragma unroll
        for (int i = 0; i < 8; ++i) { const int c0 = (i * 64 + F.lane) * 4; gg[i] = *(const LAS f32x4*)(Vsc2 + c0); bb[i] = *(const LAS f32x4*)(Vsh2 + c0); }
        row_stats1(v, mu, rstd);
#pragma unroll
        for (int i = 0; i < 8; ++i) { const int c0 = (i * 64 + F.lane) * 4;
#pragma unroll
            for (int c = 0; c < 4; ++c) v[i * 4 + c] = (v[i * 4 + c] - mu) * rstd * (1.f + gg[i][c]) + bb[i][c];
            u32x2 w; w.x = cvt_pk_bf16(v[i * 4], v[i * 4 + 1]); w.y = cvt_pk_bf16(v[i * 4 + 2], v[i * 4 + 3]); *(u32x2*)(H + (size_t)row * DM + c0) = w; }
        float s16[16];
#pragma unroll
        for (int x = 0; x < 16; ++x) { float s = 0.f;
#pragma unroll
            for (int i = 0; i < 8; ++i) { const f32x4 r = *(const LAS f32x4*)(Rt + x * 2048 + (i * 64 + F.lane) * 4); s += v[i * 4] * r[0] + v[i * 4 + 1] * r[1] + v[i * 4 + 2] * r[2] + v[i * 4 + 3] * r[3]; }
            s16[x] = s; if ((x & 3) == 3) __builtin_amdgcn_sched_barrier(0); }
        float t8[8], t4[4], t2[2], t1;
        { const bool hi = (F.lane & 32) != 0;
#pragma unroll
          for (int j = 0; j < 8; ++j) { const float send = hi ? s16[j] : s16[8 + j], keep = hi ? s16[8 + j] : s16[j]; t8[j] = keep + shx<32>(send); } }
        { const bool hi = (F.lane & 16) != 0;
#pragma unroll
          for (int j = 0; j < 4; ++j) { const float send = hi ? t8[j] : t8[4 + j], keep = hi ? t8[4 + j] : t8[j]; t4[j] = keep + shx<16>(send); } }
        { const bool hi = (F.lane & 8) != 0;
#pragma unroll
          for (int j = 0; j < 2; ++j) { const float send = hi ? t4[j] : t4[2 + j], keep = hi ? t4[2 + j] : t4[j]; t2[j] = keep + shx<8>(send); } }
        { const bool hi = (F.lane & 4) != 0; const float send = hi ? t2[0] : t2[1], keep = hi ? t2[1] : t2[0]; t1 = keep + shx<4>(send); }
        t1 += shx<2>(t1); t1 += shx<1>(t1);
        const int xid = ((F.lane >> 5) & 1) * 8 + ((F.lane >> 4) & 1) * 4 + ((F.lane >> 3) & 1) * 2 + ((F.lane >> 2) & 1);
        float mx = t1; mx = fmaxf(mx, shx<4>(mx)); mx = fmaxf(mx, shx<8>(mx)); mx = fmaxf(mx, shx<16>(mx)); mx = fmaxf(mx, shx<32>(mx));
        const float ex = __expf(t1 - mx); float sm = ex; sm += shx<4>(sm); sm += shx<8>(sm); sm += shx<16>(sm); sm += shx<32>(sm);
        if ((F.lane & 3) == 0) WSP(float, WS_AFF)[(size_t)row * 16 + xid] = ex / sm;
    }
#undef LNM_XIN
#undef LNM_XLOAD
    __syncthreads();
}
__device__ __forceinline__ void phase_topk(const Frame& F, int l) {
    LAS unsigned* keys = (LAS unsigned*)F.lds;
    LAS unsigned* hist = keys + 4096;
    LAS unsigned* misc = hist + 256;
    const float* aff = WSP(float, WS_AFF); int* tokslot = WSP(int, WS_TOKSLOT); int* seltok = WSP(int, WS_SELTOK); unsigned short* vt16 = WSP(unsigned short, WS_VT);
    const int nitem = (l == 0) ? 128 : 64;
    if (l == 0 && F.bid >= F.G - NE) { const int e = F.bid - (F.G - NE), kr2 = F.tid >> 5, c42 = F.tid & 31; *(unsigned*)(vt16 + ((e * 9 + 8) * 4096 + kr2 * 256 + 8 * (c42 ^ pg8::g8swz_(kr2))) / 2 + 2) = 0u; }
    for (int it = F.bid; it < nitem; it += F.G) { const int set = it >> 6, b = (it >> 4) & 3, e = it & 15;
        const int n = set == 0 ? SEQ : CTXL, cap = set == 0 ? 512 : 32, base = set == 0 ? b * SEQ : NLAT + b * CTXL;
        __syncthreads();
        for (int i = F.tid; i < n; i += NTHR) keys[i] = __float_as_uint(aff[(size_t)(base + i) * 16 + e]);
        if (F.tid == 0) { misc[0] = 0u; misc[1] = (unsigned)cap; }
        __syncthreads();
        for (int pass = 0; pass < 4; ++pass) { const int shift = 24 - 8 * pass; const unsigned himask = pass == 0 ? 0u : (0xffffffffu << (shift + 8));
            if (F.tid < 256) hist[F.tid] = 0u;
            __syncthreads();
            const unsigned prefix = misc[0];
            for (int i = F.tid; i < n; i += NTHR) { const unsigned k = keys[i]; if ((k & himask) == prefix) __hip_atomic_fetch_add(&hist[(k >> shift) & 255u], 1u, __ATOMIC_RELAXED, __HIP_MEMORY_SCOPE_WORKGROUP); }
            __syncthreads();
            { const unsigned rem = misc[1];
              unsigned hc = (F.tid < 256) ? hist[255 - F.tid] : 0u, inc = hc;
              for (int o = 1; o < 64; o <<= 1) { const unsigned a = __shfl_up(inc, o); if (F.lane >= o) inc += a; }
              if (F.lane == 63) misc[40 + F.wave] = inc;
              __syncthreads();
              unsigned off = 0; for (int w2 = 0; w2 < F.wave; ++w2) off += misc[40 + w2];
              inc += off;
              if (F.tid < 256 && inc >= rem && inc - hc < rem) { misc[0] = prefix | ((unsigned)(255 - F.tid) << shift); misc[1] = rem - (inc - hc); } }
            __syncthreads();
        }
        const unsigned thr = misc[0], take_eq = misc[1];
        const int per = n / NTHR; unsigned cg = 0, ce = 0;
        const int i0 = per ? F.tid * per : F.tid, cnt = per ? per : (F.tid < n ? 1 : 0);
        for (int q = 0; q < cnt; ++q) { const unsigned k = keys[i0 + q]; cg += (k > thr); ce += (k == thr); }
        unsigned sg = cg, se = ce;
        for (int o = 1; o < 64; o <<= 1) { const unsigned a = __shfl_up(sg, o), c2 = __shfl_up(se, o); if (F.lane >= o) { sg += a; se += c2; } }
        if (F.lane == 63) { misc[8 + F.wave] = sg; misc[24 + F.wave] = se; }
        __syncthreads();
        unsigned og = 0, oe = 0; for (int w2 = 0; w2 < F.wave; ++w2) { og += misc[8 + w2]; oe += misc[24 + w2]; }
        unsigned pg = og + sg - cg, pe = oe + se - ce;
        for (int q = 0; q < cnt; ++q) { const int i = i0 + q; const unsigned k = keys[i]; const bool sel = (k > thr) || (k == thr && pe < take_eq);
            const unsigned slot = pg + (pe < take_eq ? pe : take_eq);
            const int erow = set == 0 ? b * 512 + (int)slot : 2048 + b * 32 + (int)slot;
            tokslot[(size_t)(base + i) * 16 + e] = sel ? erow : -1;
            if (sel) { seltok[e * ER + erow] = base + i;
                const int pm = e * 9 + (erow >> 8), rr = erow & 255, R = rr & 63, sl = (rr >> 7) * 2 + ((rr >> 6) & 1);
#pragma unroll
                for (int q8 = 0; q8 < 8; ++q8) { const int t2 = ((R >> 4) * 2 + (q8 >> 2)) * 64 + (R & 15) * 4 + (q8 & 3), kr2 = t2 >> 5, c42 = t2 & 31;
                    vt16[(pm * 4096 + kr2 * 256 + 8 * (c42 ^ pg8::g8swz_(kr2))) / 2 + sl] = (unsigned short)(base + i); } }
            pg += (k > thr); pe += (k == thr); }
    }
    __syncthreads();
}
__device__ __forceinline__ void phase_gather(const Frame& F, int l) {
    const int valid = (l == 0) ? 2176 : 2048, rows = (l == 0) ? ER : 2048;
    const int* __restrict__ seltok = WSP(int, WS_SELTOK); const bf16_t* __restrict__ H = WSP(bf16_t, WS_H); bf16_t* __restrict__ xe = WSP(bf16_t, WS_R2);
    const int n = NE * rows, step = F.G * 8;
    for (int it = F.bid * 8 + F.wave; it < n; it += 4 * step) {
        int tok[4]; bf16_t* dst[4];
#pragma unroll
        for (int u = 0; u < 4; ++u) { const int i = it + u * step; tok[u] = -1; dst[u] = xe;
            if (i < n) { const int e = i / rows, r = i % rows; dst[u] = xe + (size_t)(e * ER + r) * DM; tok[u] = (r < valid) ? seltok[e * ER + r] : -2; } }
        u32x4 v[4][4];
#pragma unroll
        for (int u = 0; u < 4; ++u) { const bf16_t* src = H + (size_t)(tok[u] >= 0 ? tok[u] : 0) * DM;
#pragma unroll
            for (int q = 0; q < 4; ++q) v[u][q] = *(const u32x4*)(src + (q * 64 + F.lane) * 8); }
#pragma unroll
        for (int u = 0; u < 4; ++u) if (tok[u] != -1) {
#pragma unroll
            for (int q = 0; q < 4; ++q) *(u32x4*)(dst[u] + (q * 64 + F.lane) * 8) = (tok[u] >= 0) ? v[u][q] : (u32x4){0u, 0u, 0u, 0u}; }
    }
}
__device__ __forceinline__ void phase_combine(const Frame& F, int l) {
    float alpha_ = ALPHA; asm volatile("" : "+v"(alpha_));
    const int nrows = (l == 0) ? MT : NLAT;
    const float* mod = WSP(float, WS_MOD) + (size_t)l * 5 * 12288; const float* modn = WSP(float, WS_MOD) + (size_t)5 * 12288;
    const float* aff = WSP(float, WS_AFF); const int* tokslot = WSP(int, WS_TOKSLOT); const bf16_t* ye = WSP(bf16_t, WS_R3);
    const float* g2 = F.in[24] + l * DM; const float* b2 = F.in[25] + l * DM;
    LAS float* Vg2 = (LAS float*)F.lds; LAS float* Vb2 = Vg2 + 2048; LAS float* Vgt2 = Vb2 + 2048; LAS float* Vsh = Vgt2 + 2048; LAS float* Vsc = Vsh + 2048;
    __syncthreads();
    { const int c0 = F.tid * 4; *(LAS f32x4*)(Vg2 + c0) = *(const f32x4*)(g2 + c0); *(LAS f32x4*)(Vb2 + c0) = *(const f32x4*)(b2 + c0); }
    int bcur = -1;
    int myslot = -1; float myg = 0.f; u32x4 xv[4];
    const int ntrip = ROWMAP_NTRIP(nrows);
    { const int row = ROWMAP_ROW(0, nrows); if (row >= 0) { if (F.lane < 16) { myslot = tokslot[(size_t)row * 16 + F.lane]; myg = aff[(size_t)row * 16 + F.lane]; }
        const bf16_t* xp = WSP(bf16_t, WS_X1) + (size_t)row * DM;
#pragma unroll
        for (int i = 0; i < 4; ++i) xv[i] = *(const u32x4*)(xp + (i * 64 + F.lane) * 8); } }
    for (int k = 0; k < ntrip; ++k) {
        const int row = ROWMAP_ROW(k, nrows), b = ROWMAP_BATCH(k);
        if (b != bcur) { bcur = b; __syncthreads();
            { const int c0 = F.tid * 4; *(LAS f32x4*)(Vgt2 + c0) = *(const f32x4*)(mod + (size_t)b * 12288 + 10240 + c0);
              if (l == 0) { *(LAS f32x4*)(Vsh + c0) = *(const f32x4*)(modn + (size_t)b * 12288 + c0); *(LAS f32x4*)(Vsc + c0) = *(const f32x4*)(modn + (size_t)b * 12288 + 2048 + c0); } }
            __syncthreads(); }
        float v[32];
#pragma unroll
        for (int i = 0; i < 4; ++i) { v[i * 8] = bflo(xv[i].x); v[i * 8 + 1] = bfhi(xv[i].x); v[i * 8 + 2] = bflo(xv[i].y); v[i * 8 + 3] = bfhi(xv[i].y); v[i * 8 + 4] = bflo(xv[i].z); v[i * 8 + 5] = bfhi(xv[i].z); v[i * 8 + 6] = bflo(xv[i].w); v[i * 8 + 7] = bfhi(xv[i].w); }
        const int cslot = myslot; const float cg = myg;
        { const int nrow = (k + 1 < ntrip) ? ROWMAP_ROW(k + 1, nrows) : -1; if (nrow >= 0) {
            if (F.lane < 16) { myslot = tokslot[(size_t)nrow * 16 + F.lane]; myg = aff[(size_t)nrow * 16 + F.lane]; }
            const bf16_t* xp = WSP(bf16_t, WS_X1) + (size_t)nrow * DM;
#pragma unroll
            for (int i = 0; i < 4; ++i) xv[i] = *(const u32x4*)(xp + (i * 64 + F.lane) * 8); } }
        if (row < 0) continue;
        float f[32];
#pragma unroll
        for (int i = 0; i < 32; ++i) f[i] = 0.f;
        unsigned long long msk = __ballot(cslot >= 0);
        while (msk) {
            const int e0 = __builtin_ctzll(msk); msk &= msk - 1; const int e1 = msk ? __builtin_ctzll(msk) : e0; const bool two = msk != 0; msk &= msk - 1;
            const int s0 = __builtin_amdgcn_readlane(cslot, e0), s1 = __builtin_amdgcn_readlane(cslot, e1);
            const float w0 = __int_as_float(__builtin_amdgcn_readlane(__float_as_int(cg), e0)), w1 = two ? __int_as_float(__builtin_amdgcn_readlane(__float_as_int(cg), e1)) : 0.f;
            const bf16_t* y0 = ye + (size_t)(e0 * ER + s0) * DM; const bf16_t* y1 = ye + (size_t)(e1 * ER + s1) * DM;
            u32x4 a[4], c[4];
#pragma unroll
            for (int i = 0; i < 4; ++i) { a[i] = *(const u32x4*)(y0 + (i * 64 + F.lane) * 8); c[i] = *(const u32x4*)(y1 + (i * 64 + F.lane) * 8); }
#pragma unroll
            for (int i = 0; i < 4; ++i) {
                f[i * 8 + 0] += w0 * bflo(a[i].x) + w1 * bflo(c[i].x); f[i * 8 + 1] += w0 * bfhi(a[i].x) + w1 * bfhi(c[i].x);
                f[i * 8 + 2] += w0 * bflo(a[i].y) + w1 * bflo(c[i].y); f[i * 8 + 3] += w0 * bfhi(a[i].y) + w1 * bfhi(c[i].y);
                f[i * 8 + 4] += w0 * bflo(a[i].z) + w1 * bflo(c[i].z); f[i * 8 + 5] += w0 * bfhi(a[i].z) + w1 * bfhi(c[i].z);
                f[i * 8 + 6] += w0 * bflo(a[i].w) + w1 * bflo(c[i].w); f[i * 8 + 7] += w0 * bfhi(a[i].w) + w1 * bfhi(c[i].w); }
        }
#pragma unroll
        for (int i = 0; i < 4; ++i) { const f32x4 ga = *(const LAS f32x4*)(Vgt2 + (i * 64 + F.lane) * 8), gc = *(const LAS f32x4*)(Vgt2 + (i * 64 + F.lane) * 8 + 4);
#pragma unroll
            for (int c = 0; c < 4; ++c) { v[i * 8 + c] = alpha_ * v[i * 8 + c] + ga[c] * f[i * 8 + c]; v[i * 8 + 4 + c] = alpha_ * v[i * 8 + 4 + c] + gc[c] * f[i * 8 + 4 + c]; } }
        float mu, rstd; row_stats1(v, mu, rstd);
        float* xo = F.out + (size_t)row * DM; bf16_t* xb = WSP(bf16_t, WS_X2B) + (size_t)row * DM;
#pragma unroll
        for (int i = 0; i < 4; ++i) { const int c0 = (i * 64 + F.lane) * 8;
#pragma unroll
            for (int hh = 0; hh < 2; ++hh) { const f32x4 gg = *(const LAS f32x4*)(Vg2 + c0 + hh * 4), bb = *(const LAS f32x4*)(Vb2 + c0 + hh * 4); f32x4 o;
#pragma unroll
                for (int c = 0; c < 4; ++c) { o[c] = (v[i * 8 + hh * 4 + c] - mu) * rstd * gg[c] + bb[c]; v[i * 8 + hh * 4 + c] = o[c]; }
                if (l != 0) *(f32x4*)(xo + c0 + hh * 4) = o; }
            if (l == 0 && row < NLAT) { u32x4 w; w.x = cvt_pk_bf16(v[i * 8], v[i * 8 + 1]); w.y = cvt_pk_bf16(v[i * 8 + 2], v[i * 8 + 3]); w.z = cvt_pk_bf16(v[i * 8 + 4], v[i * 8 + 5]); w.w = cvt_pk_bf16(v[i * 8 + 6], v[i * 8 + 7]); *(u32x4*)(xb + c0) = w; } }
        if (l == 0) { row_stats1(v, mu, rstd); bf16_t* hd = WSP(bf16_t, WS_H) + (size_t)row * DM;
#pragma unroll
            for (int i = 0; i < 4; ++i) { const int c0 = (i * 64 + F.lane) * 8; float o[8];
#pragma unroll
                for (int hh = 0; hh < 2; ++hh) { const f32x4 a = *(const LAS f32x4*)(Vsc + c0 + hh * 4), bq = *(const LAS f32x4*)(Vsh + c0 + hh * 4);
#pragma unroll
                    for (int c = 0; c < 4; ++c) o[hh * 4 + c] = (v[i * 8 + hh * 4 + c] - mu) * rstd * (1.f + a[c]) + bq[c]; }
                u32x4 w; w.x = cvt_pk_bf16(o[0], o[1]); w.y = cvt_pk_bf16(o[2], o[3]); w.z = cvt_pk_bf16(o[4], o[5]); w.w = cvt_pk_bf16(o[6], o[7]); *(u32x4*)(hd + c0) = w; } }
    }
    __syncthreads();
}
#ifndef PROBE_SUB
#define PROBE_SUB 0
#endif
__device__ __forceinline__ void s5_scan2(const Frame& F, int l, int first_thread, int nthreads) {
    const float* __restrict__ S = WSP(float, WS_S5S); bf16_t* __restrict__ SI = WSP(bf16_t, WS_S5IN);
    for (int e = first_thread; e < 4 * 32 * 128; e += nthreads) { const int p = e & 63, d = (e >> 6) & 1, g = (e >> 7) & 31, b = e >> 12;
        const f32x2 lt = WSP(f32x2, WS_LAMT)[((size_t)(l * 32 + g) * 2 + d) * 64 + p];
        float sx = 0.f, sy = 0.f; const size_t co = (size_t)g * 256 + d * 128 + p * 2;
#define S5S_ROW(i) (((i) < 8) ? (512 + b * 8 + (d == 0 ? (i) : 7 - (i))) : (b * 128 + (d == 0 ? ((i) - 8) : 127 - ((i) - 8))))
        for (int i0 = 0; i0 < 136; i0 += 34) { f32x2 sv[34];
#pragma unroll
            for (int q = 0; q < 34; ++q) { const int r = S5S_ROW(i0 + q); sv[q] = *(const f32x2*)(S + ((unsigned)r * 8192u + (unsigned)co)); }
#pragma unroll
            for (int q = 0; q < 34; ++q) { const int r = S5S_ROW(i0 + q); *(unsigned*)(SI + ((unsigned)r * 8192u + (unsigned)co)) = cvt_pk_bf16(sx, sy);
                const float nx = lt.x * sx - lt.y * sy + sv[q].x, ny = lt.x * sy + lt.y * sx + sv[q].y; sx = nx; sy = ny; } }
#undef S5S_ROW
    }
}
template <int NEL>
__device__ __forceinline__ void gla_scan_n(const float* __restrict__ upd, const float* __restrict__ dec, bf16_t* __restrict__ st, int e0, int es) {
    int el[NEL], bhd[NEL], d[NEL], k[NEL]; float s[NEL];
#pragma unroll
    for (int a = 0; a < NEL; ++a) { const int e = e0 + a * es; el[a] = e & 8191; bhd[a] = e >> 13; d[a] = bhd[a] & 1; k[a] = el[a] & 63; s[a] = 0.f; }
    for (int p0 = 0; p0 < 68; p0 += 17) { float u[NEL][17], dc[NEL][17];
#pragma unroll
        for (int q = 0; q < 17; ++q)
#pragma unroll
            for (int a = 0; a < NEL; ++a) { const int pos = p0 + q; const int j = d[a] == 0 ? pos : (pos < 4 ? 3 - pos : 71 - pos); const unsigned base = (unsigned)(bhd[a] * 68 + j); u[a][q] = upd[base * 8192u + (unsigned)el[a]]; dc[a][q] = dec[base * 64u + (unsigned)k[a]]; }
#pragma unroll
        for (int q = 0; q < 17; ++q)
#pragma unroll
            for (int a = 0; a < NEL; ++a) { const int pos = p0 + q; const int j = d[a] == 0 ? pos : (pos < 4 ? 3 - pos : 71 - pos); const unsigned base = (unsigned)(bhd[a] * 68 + j); st[base * 8192u + (unsigned)el[a]] = f2bf(s[a]); s[a] = dc[a][q] * s[a] + u[a][q]; } }
}
__device__ __forceinline__ void gla_scan2(const Frame& F, int first_thread, int nthreads) {
    const float* __restrict__ upd = WSP(float, WS_R3 + (size_t)MT * DM * 2 + (size_t)MT * 512 * 2); const float* __restrict__ dec = WSP(float, WS_GDEC); bf16_t* __restrict__ st = WSP(bf16_t, WS_GST);
    const int N = 32 * 8192;
    for (int e = first_thread; e < N; e += 3 * nthreads) {
        if (e + 2 * nthreads < N) gla_scan_n<3>(upd, dec, st, e, nthreads);
        else if (e + nthreads < N) gla_scan_n<2>(upd, dec, st, e, nthreads);
        else gla_scan_n<1>(upd, dec, st, e, nthreads); }
}

#define XB_TMO      128
#define XB_XCNT(j)  (256  + 64 * (j))
#define XB_XSUB(j)  (1280 + 64 * (j))
#define XB_XGEN(j)  (2304 + 64 * (j))
#define XB_TOP      3328
#define XB_TOPGEN   3392
#define XCD_BAR_WORDS 3456
#define XB_SPIN_CAP (1u << 18)

__device__ __forceinline__ unsigned xb_ld(unsigned* p)              { return __hip_atomic_load(p, __ATOMIC_RELAXED, __HIP_MEMORY_SCOPE_AGENT); }
__device__ __forceinline__ unsigned xb_add(unsigned* p, unsigned v) { return __hip_atomic_fetch_add(p, v, __ATOMIC_RELAXED, __HIP_MEMORY_SCOPE_AGENT); }
__device__ __forceinline__ unsigned xb_xcc_id() { return (unsigned)__builtin_amdgcn_s_getreg((3 << 11) | 20) & 0xFu; }
#define XB_SPIN(cond, bar) do { unsigned _sp = 0; while (cond) { __builtin_amdgcn_s_sleep(1); \
    if ((++_sp & 255u) == 0u) { if (xb_ld(&(bar)[XB_TMO])) break; if (_sp > XB_SPIN_CAP) { atomicAdd(&(bar)[XB_TMO], 1u); break; } } } } while (0)

struct XcdBarrier {
    unsigned* bar; unsigned x;
    volatile LAS unsigned* st;
};

__device__ __forceinline__ XcdBarrier xcd_barrier_post(unsigned* bar, volatile LAS unsigned* st) {
    XcdBarrier b; b.bar = bar; b.x = xb_xcc_id(); b.st = st;
    if (threadIdx.x == 0) (void)xb_add(&bar[XB_XCNT(b.x)], 1u);
    return b;
}
__device__ __forceinline__ void xcd_barrier_complete(unsigned* bar, unsigned x, unsigned& nloc, unsigned& nx) {
    const unsigned G = gridDim.x * gridDim.y * gridDim.z;
    unsigned sum, cnt, mine, sp = 0u;
    for (;;) {
        sum = 0u; cnt = 0u; mine = 0u;
#pragma unroll
        for (unsigned j = 0; j < 16; ++j) { const unsigned c = xb_ld(&bar[XB_XCNT(j)]); sum += c; cnt += (c > 0u) ? 1u : 0u; mine = (j == x) ? c : mine; }
        if (sum == G) break;
        __builtin_amdgcn_s_sleep(1);
        if ((++sp & 255u) == 0u) { if (xb_ld(&bar[XB_TMO])) break; if (sp > XB_SPIN_CAP) { atomicAdd(&bar[XB_TMO], 1u); break; } }
    }
    nloc = mine > 0u ? mine : 1u; nx = cnt > 0u ? cnt : 1u;
}

__device__ __forceinline__ void xcd_barrier(const XcdBarrier& b) {
    asm volatile("s_waitcnt vmcnt(0)" ::: "memory");
    __syncthreads();
    if (threadIdx.x == 0) {
        unsigned* bar = b.bar;
        __builtin_amdgcn_s_waitcnt(0);
        unsigned nloc = b.st[0], nx = b.st[1];
        if (nloc == 0u) { xcd_barrier_complete(bar, b.x, nloc, nx); b.st[0] = nloc; b.st[1] = nx; }
        const unsigned old = xb_add(&bar[XB_XSUB(b.x)], 1u);
        const unsigned gen = old / nloc;
        if (old + 1u == (gen + 1u) * nloc) {
            __builtin_amdgcn_fence(__ATOMIC_RELEASE, "agent");
            asm volatile("s_waitcnt vmcnt(0)" ::: "memory");
            const unsigned og = xb_add(&bar[XB_TOP], 1u);
            const unsigned tg = og / nx;
            if (og + 1u == (tg + 1u) * nx) xb_add(&bar[XB_TOPGEN], 1u);
            else XB_SPIN(xb_ld(&bar[XB_TOPGEN]) == tg, bar);
            __builtin_amdgcn_fence(__ATOMIC_ACQUIRE, "agent");
            xb_add(&bar[XB_XGEN(b.x)], 1u);
            asm volatile("s_waitcnt vmcnt(0)" ::: "memory");
        } else {
            XB_SPIN(xb_ld(&bar[XB_XGEN(b.x)]) == gen, bar);
            __builtin_amdgcn_fence(__ATOMIC_ACQUIRE, "agent");
            asm volatile("s_waitcnt vmcnt(0)" ::: "memory");
        }
    }
    __syncthreads();
}


__device__ __forceinline__ int wrapadd(int a, int b, int n) { int x = a + (b < n ? b : 0); return x >= n ? x - n : x; }
__device__ __forceinline__ void conv_share(int c, int G, int NU, int& q0, int& q1) { int g_; asm volatile("v_mov_b32 %0, %1" : "=v"(g_) : "s"(G)); q0 = __builtin_amdgcn_readfirstlane((int)((long)c * NU / g_)); q1 = __builtin_amdgcn_readfirstlane((int)((long)(c + 1) * NU / g_)); }
constexpr int N_PHASES = 27;
__global__ void __launch_bounds__(NTHR, 2) mega_fwd(Args args) {
    extern __shared__ __attribute__((aligned(16))) unsigned char lds_raw[];
    Frame F; F.in = args.in; F.out = args.out; F.ws = args.ws; F.lds = (LAS unsigned char*)lds_raw;
    F.tid = threadIdx.x; F.lane = F.tid & 63; F.wave = __builtin_amdgcn_readfirstlane(F.tid >> 6); F.G = gridDim.x; F.bid = blockIdx.x;
    const int wave0_ = __builtin_amdgcn_readfirstlane((int)threadIdx.x >> 6);
#define FRESH() do { int t_; asm volatile("v_mbcnt_lo_u32_b32 %0, -1, 0\n\tv_mbcnt_hi_u32_b32 %0, -1, %0" : "=v"(t_)); t_ |= (wave0_ << 6); F.tid = t_; F.lane = t_ & 63; F.wave = __builtin_amdgcn_readfirstlane(t_ >> 6); { const void* ka_ = (const void*)__builtin_amdgcn_kernarg_segment_ptr(); unsigned char* w_; float* o_; asm volatile("s_load_dwordx2 %0, %2, 0xf8\n\ts_load_dwordx2 %1, %2, 0xf0\n\ts_waitcnt lgkmcnt(0)" : "=&s"(w_), "=&s"(o_) : "s"(ka_) : "memory"); F.ws = w_; F.out = o_; F.bid = blockIdx.x; } } while (0)
    const int lo = args.ph_lo, hi = args.ph_hi;
    const bool fused = (hi - lo) > 1;
    if (F.tid == 0) *(LAS u32x4*)(F.lds + LDS_BAR_OFF) = (u32x4){0u, 0u, 0u, 0u};
    __syncthreads();
    XcdBarrier bar; bar.bar = (unsigned*)(F.ws + WS_CTL); bar.x = 0; bar.st = nullptr;
    if (fused) bar = xcd_barrier_post((unsigned*)(F.ws + WS_CTL), (volatile LAS unsigned*)(F.lds + LDS_BAR_OFF));
#ifdef ONLY_PHASE
#define IN(k) (((k) == ONLY_PHASE || (k) == ONLY_PHASE + 12) && lo <= (k) && (k) < hi)
#else
#define IN(k) (lo <= (k) && (k) < hi)
#endif
#define SEAM(k) do { if (IN((k) + 1)) xcd_barrier(bar); } while (0)
#ifndef PROBE_REP
#define PROBE_REP 0
#endif
#define NREP(bit) (((PROBE_REP >> (bit)) & 1) ? 2 : 1)
    if (IN(0)) { FRESH(); phase_prologue(F); SEAM(0); }
    if (IN(1)) { FRESH(); phase_mod_reduce(F); SEAM(1); }
    if (IN(2)) { FRESH(); phase_ln1_first(F); SEAM(2); }
    for (int l = 0; l < 2; ++l) {
        const int pb = 3 + l * 12;
        if (IN(pb + 0)) { FRESH();
            pg8::Gemm g{WSP(bf16_t, WS_H), WSP(bf16_t, WS_WIN) + (size_t)l * NINP * DM, MT, NINP, DM}; pg8::StaticOrder S; S.init(MT, NINP, F.G, F.bid);
            pg8::EpiProj E{WSP(bf16_t, WS_R1), WSP(bf16_t, WS_SU), WSP(float, WS_ROPE)};
            pg8::gemm_phase<pg8::EpiProj, pg8::StaticOrder>(F.lds, g, S, E, F.tid); SEAM(pb + 0); }
        if (IN(pb + 1)) { FRESH(); for (int r_ = 0; r_ < (PROBE_SUB == 1 ? 2 : 1); ++r_) attn_items(F, l, F.bid, F.G); for (int r_ = 0; r_ < (PROBE_SUB == 2 ? 2 : 1); ++r_) if ((F.G & 7) == 0) s5a_items(F, l, F.bid & 7, wrapadd(F.bid >> 3, F.G >> 4, F.G >> 3), F.G >> 3); else s5a_items(F, l, -1, F.bid, F.G); for (int r_ = 0; r_ < (PROBE_SUB == 3 ? 2 : 1); ++r_) gla1_items(F, l, wrapadd(F.bid, 96, F.G), F.G); SEAM(pb + 1); }
        if (IN(pb + 2)) { FRESH(); if (F.bid < 32) s5_scan2(F, l, F.bid * NTHR + F.tid, 32 * NTHR); else gla_scan2(F, (F.bid - 32) * NTHR + F.tid, (F.G - 32) * NTHR); SEAM(pb + 2); }
        if (IN(pb + 3)) { FRESH(); for (int r_ = 0; r_ < (PROBE_SUB == 4 ? 2 : 1); ++r_) if ((F.G & 7) == 0) s5c_items(F, l, F.bid & 7, F.bid >> 3, F.G >> 3); else s5c_items(F, l, -1, F.bid, F.G); for (int r_ = 0; r_ < (PROBE_SUB == 5 ? 2 : 1); ++r_) gla3_items(F, l, wrapadd(F.bid, 32, F.G), F.G); SEAM(pb + 3); }
        if (IN(pb + 4)) { FRESH();
            pg8::Gemm g{WSP(bf16_t, WS_R3 + (size_t)MT * DM * 2), WSP(bf16_t, WS_WGLU) + (size_t)l * 512 * 512, MT, 512, 512}; pg8::StaticOrder S; S.init(MT, 512, F.G, F.bid);
            pg8::EpiGlu E{WSP(bf16_t, WS_R3 + (size_t)MT * DM * 2), F.in[17] + l * 512, WSP(bf16_t, WS_R3)};
            pg8::gemm_phase<pg8::EpiGlu, pg8::StaticOrder, MT>(F.lds, g, S, E, F.tid); SEAM(pb + 4); }
        if (IN(pb + 5)) { FRESH();
            pg8::Gemm g{WSP(bf16_t, WS_R3), WSP(bf16_t, WS_WOUT) + (size_t)l * DM * DM, NLAT, DM, DM};
            pg8::EpiBf16 E{WSP(bf16_t, WS_R2), DM};
            const bool qtail = (F.G >= 128);
            { const int split = 0;     pg8::OutOrder0 S; S.S0.init((l == 0 && !split && !qtail) ? MT : NLAT, DM, F.G, F.bid); S.G = F.G; S.c = F.bid; S.split = split; pg8::gemm_phase<pg8::EpiBf16, pg8::OutOrder0>(F.lds, g, S, E, F.tid); }
            if (l == 0 && qtail) { FRESH(); if (F.bid < 128) pg8::gemm_quarter<pg8::EpiBf16>(F.lds, g, 64 + (F.bid >> 5), (F.bid >> 2) & 7, (F.bid >> 1) & 1, F.bid & 1, E, F.tid); }
            SEAM(pb + 5); }
        if (IN(pb + 6)) { FRESH(); phase_ln_mid(F, l); SEAM(pb + 6); }
        if (IN(pb + 7)) { FRESH(); phase_topk(F, l); SEAM(pb + 7); }
        if (IN(pb + 9)) { FRESH();
            pg8::GemmF g{WSP(bf16_t, WS_H), F.in[27] + (size_t)l * NE * DM * DM, F.in[28] + (size_t)l * NE * DM * DM, (size_t)DM * DM, 128, DM, DM, nullptr, WSP(unsigned, WS_VT)};
            pg8::GroupedOrder S{NE, (l == 0) ? 9 : 8, 16, 9, F.G, F.bid, 0};
            pg8::EpiGateUp E{WSP(bf16_t, WS_R1)};
            pg8::gemm_phase_fb<pg8::EpiGateUp, pg8::GroupedOrder, 0, false, true>(F.lds, g, S, E, F.tid); SEAM(pb + 9); }
        if (IN(pb + 10)) { FRESH();
            pg8::GemmF g{WSP(bf16_t, WS_R1), F.in[29] + (size_t)l * NE * DM * DM, F.in[29] + (size_t)l * NE * DM * DM + 128, (size_t)DM * DM, 256, DM, DM, nullptr};
            pg8::GroupedOrder S{NE, (l == 0) ? 9 : 8, 8, 9, F.G, F.bid, 0};
            pg8::EpiBf16 E{WSP(bf16_t, WS_R3), DM};
            pg8::gemm_phase_fb<pg8::EpiBf16, pg8::GroupedOrder>(F.lds, g, S, E, F.tid); SEAM(pb + 10); }
        if (IN(pb + 11)) { FRESH(); phase_combine(F, l); SEAM(pb + 11); }
    }
#undef IN
#undef SEAM
}

#ifndef PROBE_NREP
#define PROBE_NREP 2
#endif
#ifndef PROBE_REP_MASK
#define PROBE_REP_MASK 0ull
#endif
#ifndef MK_MULTI
#define MK_MULTI 0
#endif
extern "C" void kernel_launch(void* const* d_in, const int* in_sizes, int n_in, void* d_out, int out_size, void* d_ws, size_t ws_size, hipStream_t stream) {
    static int grid = 0;
    if (grid == 0) {
        if (n_in != 30 || out_size != NLAT * DM || ws_size < WS_END) { fprintf(stderr, "kernel_launch: unexpected shapes (n_in %d, out %d, ws %zu, need %zu)\n", n_in, out_size, ws_size, (size_t)WS_END); grid = -1; return; }
        int dev = 0, cus = 0, per_cu = 0;
        if (hipGetDevice(&dev) != hipSuccess || hipDeviceGetAttribute(&cus, hipDeviceAttributeMultiprocessorCount, dev) != hipSuccess) { grid = -1; return; }
        if (hipFuncSetAttribute((const void*)mega_fwd, hipFuncAttributeMaxDynamicSharedMemorySize, LDS_BYTES) != hipSuccess) { fprintf(stderr, "kernel_launch: hipFuncSetAttribute failed\n"); grid = -1; return; }
        if (hipOccupancyMaxActiveBlocksPerMultiprocessor(&per_cu, (const void*)mega_fwd, NTHR, LDS_BYTES) != hipSuccess || per_cu < 1) fprintf(stderr, "kernel_launch: occupancy query says %d\n", per_cu);
        (void)hipGetLastError();
        grid = cus;
    }
    if (grid < 0) return;
    (void)hipMemsetAsync((char*)d_ws + WS_CTL, 0, CTL_BYTES, stream);
    Args a{};
    for (int i = 0; i < 30; ++i) a.in[i] = (const float*)d_in[i];
    a.out = (float*)d_out; a.ws = (unsigned char*)d_ws;
#if MK_MULTI
    for (int p = 0; p < N_PHASES; ++p) { const int nrep = ((PROBE_REP_MASK >> p) & 1ull) ? PROBE_NREP : 1; for (int r = 0; r < nrep; ++r) { a.ph_lo = p; a.ph_hi = p + 1; hipLaunchKernelGGL(mega_fwd, dim3(grid), dim3(NTHR), LDS_BYTES, stream, a); } }
#else
    a.ph_lo = 0; a.ph_hi = N_PHASES; hipLaunchKernelGGL(mega_fwd, dim3(grid), dim3(NTHR), LDS_BYTES, stream, a);
#endif
}
```

```cpp
#include <hip/hip_runtime.h>
#ifndef PROBE_SUB
#define PROBE_SUB 0
#endif
#include <cstdio>
#include <cstdint>

#define LAS __attribute__((address_space(3)))
typedef unsigned short bf16_t;
typedef short bf16x8 __attribute__((ext_vector_type(8)));
typedef short s16x4 __attribute__((ext_vector_type(4)));
typedef float f32x4 __attribute__((ext_vector_type(4)));
typedef float f32x2 __attribute__((ext_vector_type(2)));
typedef unsigned u32x4 __attribute__((ext_vector_type(4)));
typedef unsigned u32x2 __attribute__((ext_vector_type(2)));

constexpr int NB = 4, SEQ = 4096, CTXL = 256, DM = 2048;
constexpr int NLAT = NB * SEQ, NCTX = NB * CTXL, MT = NLAT + NCTX;
constexpr int NIN = 3616, NINP = 3840;
constexpr int C_Q = 0, C_K = 1024, C_V = 1280, C_SU = 1536, C_GQ = 2048, C_GK = 2304, C_GV = 2560, C_GR = 3072, C_GZ = 3584;
constexpr int NE = 16, ER = 2304;
constexpr float ALPHA = 1.41421356237309515f;
constexpr float LN_EPS = 1e-6f;
constexpr int NTHR = 512;
constexpr int LDS_BYTES = 163840;
constexpr int LDS_BAR_OFF = 163840 - 64;

constexpr size_t al256(size_t x) { return (x + 255) & ~(size_t)255; }
constexpr size_t WS_CTL = 0, CTL_BYTES = 1u << 20;
constexpr size_t WS_MODP = WS_CTL + CTL_BYTES;
constexpr size_t WS_MOD = WS_MODP + (size_t)2 * 32 * 5 * 12288 * 4;
constexpr size_t WS_ROPE = WS_MOD + (size_t)2 * 5 * 12288 * 4;
constexpr size_t WS_LAMT = WS_ROPE + 64 * 32 * 8;
constexpr size_t WS_WIN = al256(WS_LAMT + 2 * 32 * 2 * 64 * 8);
constexpr size_t WS_WOUT = WS_WIN + (size_t)2 * NINP * DM * 2;
constexpr size_t WS_WGLU = WS_WOUT + (size_t)2 * DM * DM * 2;
constexpr size_t WS_WGU = WS_WGLU + (size_t)2 * 512 * 512 * 2;
constexpr size_t WS_X2B = WS_WGU;
constexpr size_t WS_WDN = WS_WGU + (size_t)2 * NE * 4096 * DM * 2;
constexpr size_t WS_S5A = WS_WDN + (size_t)2 * NE * 2048 * DM * 2;
constexpr size_t WS_S5C = WS_S5A + (size_t)2 * 32 * 256 * 512 * 2;
constexpr size_t WS_X1 = WS_S5C + (size_t)2 * 32 * 512 * 768 * 2;
constexpr size_t WS_X2C = WS_X1 + (size_t)MT * DM * 4;
constexpr size_t WS_H = WS_X2C + (size_t)NCTX * DM * 4;
constexpr size_t WS_R1 = WS_H + (size_t)MT * DM * 2;
constexpr size_t R_BYTES = (size_t)NE * ER * DM * 2;
constexpr size_t WS_R2 = WS_R1 + R_BYTES;
constexpr size_t WS_R3 = WS_R2 + R_BYTES;
constexpr size_t R3_BYTES = (size_t)MT * DM * 2 + (size_t)MT * 512 * 2 + (size_t)32 * 68 * 8192 * 4;
constexpr size_t WS_SU = WS_R3 + R3_BYTES;
constexpr size_t WS_AFF = WS_SU + (size_t)32 * MT * 16 * 2;
constexpr size_t WS_TOKSLOT = WS_AFF + (size_t)MT * 16 * 4;
constexpr size_t WS_SELTOK = WS_TOKSLOT + (size_t)MT * 16 * 4;
constexpr size_t WS_S5S = WS_SELTOK + (size_t)NE * ER * 4;
constexpr size_t WS_S5IN = WS_S5S + (size_t)544 * 32 * 256 * 4;
constexpr size_t WS_GDEC = WS_S5IN + (size_t)544 * 32 * 256 * 2;
constexpr size_t WS_GST = WS_GDEC + (size_t)32 * 68 * 64 * 4;
constexpr size_t WS_GQIN = WS_GST + (size_t)32 * 68 * 8192 * 2;
constexpr size_t WS_GKP = WS_GQIN + (size_t)32 * 68 * 4096 * 2;
constexpr size_t WS_VT = WS_GKP + (size_t)32 * 68 * 4096 * 2;
constexpr size_t WS_END = WS_VT + (size_t)NE * 9 * 4096;
static_assert(R3_BYTES >= R_BYTES, "YE must fit in R3");
static_assert((size_t)MT * NINP * 2 <= R_BYTES && (size_t)MT * DM * 4 <= R_BYTES, "PROJ / Y fit");
static_assert(WS_END < (size_t)2000 * 1000 * 1000, "workspace budget");

__device__ __forceinline__ unsigned cvt_pk_bf16(float lo, float hi) { unsigned r; asm volatile("v_cvt_pk_bf16_f32 %0, %1, %2" : "=v"(r) : "v"(lo), "v"(hi)); return r; }
typedef _Float16 h2_t __attribute__((ext_vector_type(2)));
__device__ __forceinline__ unsigned cvt_pk_f16(float lo, float hi) { h2_t h; h.x = (_Float16)lo; h.y = (_Float16)hi; return __builtin_bit_cast(unsigned, h); }
__device__ __forceinline__ bf16_t f2bf(float x) { return (bf16_t)(cvt_pk_bf16(x, 0.f) & 0xffffu); }
__device__ __forceinline__ float bf2f(bf16_t b) { return __uint_as_float(((unsigned)b) << 16); }
__device__ __forceinline__ float bflo(unsigned w) { return __uint_as_float(w << 16); }
__device__ __forceinline__ float bfhi(unsigned w) { return __uint_as_float(w & 0xffff0000u); }
template <int O>
__device__ __forceinline__ float shx(float v) {
    const int x = __float_as_int(v);
    if constexpr (O == 1) return __int_as_float(__builtin_amdgcn_update_dpp(0, x, 0xB1, 0xF, 0xF, true));
    else if constexpr (O == 2) return __int_as_float(__builtin_amdgcn_update_dpp(0, x, 0x4E, 0xF, 0xF, true));
    else if constexpr (O == 4) { const int t = __builtin_amdgcn_update_dpp(0, x, 0x1B, 0xF, 0xF, true); return __int_as_float(__builtin_amdgcn_update_dpp(0, t, 0x141, 0xF, 0xF, true)); }
    else if constexpr (O == 8) return __int_as_float(__builtin_amdgcn_update_dpp(0, x, 0x128, 0xF, 0xF, true));
    else { const unsigned lane_ = __builtin_amdgcn_mbcnt_hi(~0u, __builtin_amdgcn_mbcnt_lo(~0u, 0u));
        if constexpr (O == 16) { const auto r = __builtin_amdgcn_permlane16_swap((unsigned)x, (unsigned)x, false, false); return __int_as_float((int)((lane_ & 16u) ? r[0] : r[1])); }
        else { static_assert(O == 32, "shx: power-of-two offsets below 64"); const auto r = __builtin_amdgcn_permlane32_swap((unsigned)x, (unsigned)x, false, false); return __int_as_float((int)((lane_ & 32u) ? r[0] : r[1])); } }
}
__device__ __forceinline__ float wave_sum_dpp(float x) {
    x += __int_as_float(__builtin_amdgcn_update_dpp(0, __float_as_int(x), 0xB1, 0xF, 0xF, true));
    x += __int_as_float(__builtin_amdgcn_update_dpp(0, __float_as_int(x), 0x4E, 0xF, 0xF, true));
    x += __int_as_float(__builtin_amdgcn_update_dpp(0, __float_as_int(x), 0x141, 0xF, 0xF, true));
    x += __int_as_float(__builtin_amdgcn_update_dpp(0, __float_as_int(x), 0x140, 0xF, 0xF, true));
    const int xi = __float_as_int(x);
    return __int_as_float(__builtin_amdgcn_readlane(xi, 0)) + __int_as_float(__builtin_amdgcn_readlane(xi, 16)) + __int_as_float(__builtin_amdgcn_readlane(xi, 32)) + __int_as_float(__builtin_amdgcn_readlane(xi, 48));
}
__device__ __forceinline__ float wave_sum(float v) { return wave_sum_dpp(v); }
__device__ __forceinline__ float wave_max(float v) { v = fmaxf(v, shx<1>(v)); v = fmaxf(v, shx<2>(v)); v = fmaxf(v, shx<4>(v)); v = fmaxf(v, shx<8>(v)); v = fmaxf(v, shx<16>(v)); return fmaxf(v, shx<32>(v)); }
__device__ __forceinline__ float sigmoidf_(float x) { return __builtin_amdgcn_rcpf(1.0f + __expf(-x)); }
__device__ __forceinline__ float siluf_(float x) { return x * __builtin_amdgcn_rcpf(1.0f + __expf(-x)); }
__device__ __forceinline__ float gelu_tanh(float x) { const float u = 0.7978845608028654f * (x + 0.044715f * x * x * x); const float e = __expf(-2.0f * fabsf(u)); const float t = (1.0f - e) * __builtin_amdgcn_rcpf(1.0f + e); return 0.5f * x * (1.0f + (u < 0.f ? -t : t)); }
__device__ __forceinline__ float logsigmoidf_(float x) { return fminf(x, 0.f) - __logf(1.0f + __expf(-fabsf(x))); }
__device__ __forceinline__ s16x4 tr_read(unsigned lds_addr) { s16x4 r; asm volatile("ds_read_b64_tr_b16 %0, %1\n\ts_waitcnt lgkmcnt(0)" : "=&v"(r) : "v"(lds_addr) : "memory"); return r; }
__device__ __forceinline__ bf16x8 tr_read2(unsigned a0, unsigned a1) { s16x4 r0, r1; asm volatile("ds_read_b64_tr_b16 %0, %2\n\tds_read_b64_tr_b16 %1, %3\n\ts_waitcnt lgkmcnt(0)" : "=&v"(r0), "=&v"(r1) : "v"(a0), "v"(a1) : "memory");
    bf16x8 o; o[0] = r0[0]; o[1] = r0[1]; o[2] = r0[2]; o[3] = r0[3]; o[4] = r1[0]; o[5] = r1[1]; o[6] = r1[2]; o[7] = r1[3]; return o; }
__device__ __forceinline__ unsigned lds_addr_of(const LAS void* p) { return (unsigned)(uintptr_t)p; }
#define MFMA16(a, b, c) __builtin_amdgcn_mfma_f32_16x16x32_bf16((a), (b), (c), 0, 0, 0)
namespace pg8 {
#define PG8_LAS __attribute__((address_space(3)))
constexpr int BM = 256, BK = 64, HALF = 128, HTB = HALF * BK * 2  , STAGE_BYTES = 8 * HTB, NXCD = 8, WGM = 8;

__host__ __device__ __forceinline__ int lds_byte(int r, int c) { const int st = (r >> 4) * 2 + (c >> 5), rr = r & 15, cc = c & 31, ob = rr * 64 + cc * 2; return st * 1024 + (ob ^ (((ob >> 9) & 1) << 5)); }
__host__ __device__ __forceinline__ void stage_rc(int b, int& R, int& C) { const int st = b / 1024, sb = b % 1024, swz = sb ^ (((sb >> 9) & 1) << 5); R = (st >> 1) * 16 + swz / 64; C = (st & 1) * 32 + (swz % 64) / 2; }
__host__ __device__ __forceinline__ int perm32(int rho) { const int n = rho >> 4, i = rho & 15; return 8 * (i >> 2) + 4 * n + (i & 3); }

struct Unit { int pm, pn, pb, e, fl; };
struct Gemm { const bf16_t* A; const bf16_t* Bt; int M, N, K; };

struct StaticOrder {
    int nM, nN, nwg, G, c;
    __host__ __device__ void init(int M, int N, int G_, int c_) { nM = M / BM; nN = N / BM; nwg = nM * nN; G = G_; c = c_; }
    __host__ __device__ bool next(int i, Unit& u) const {
        const long L = (long)i * G + c; if (L >= nwg) return false;
        int wgid = (int)L; { const int q = nwg / NXCD, r = nwg % NXCD, xcd = wgid % NXCD, off = wgid / NXCD; wgid = (xcd < r ? xcd * (q + 1) : r * (q + 1) + (xcd - r) * q) + off; }
        const int nig = WGM * nN, gid = wgid / nig, fm = gid * WGM, gsz = (nM - fm) < WGM ? (nM - fm) : WGM;
        u.pm = fm + ((wgid % nig) % gsz); u.pn = (wgid % nig) / gsz; u.pb = u.pn; u.e = 0; u.fl = 0; return true;
    }
    __device__ __forceinline__ void a_ready(const Unit&) const {}
    __device__ __forceinline__ void done(const Unit&) const {}
    __device__ __forceinline__ void after_unit(int, int) const {}
    __device__ __forceinline__ void finish(int, int) const {}
};
template <class Epi, class Sched, int AGRP = 0  >
__device__ __forceinline__ void gemm_phase(PG8_LAS unsigned char* lds, const Gemm g, const Sched& S, const Epi& E, const int tid) {
    const int wid = __builtin_amdgcn_readfirstlane(tid >> 6), lane = tid & 63, wr = wid >> 2, wc = wid & 3, fr = lane & 15, fq = lane >> 4;
    const int K = g.K, nt = K / BK;
    unsigned voffA[2], voffB[2];
#pragma unroll
    for (int i = 0; i < 2; ++i) { int R, C; stage_rc(tid * 16 + i * 8192, R, C); const int Rb = Epi::PERM ? ((R & ~31) + perm32(R & 31)) : R;
        voffA[i] = AGRP ? (unsigned)((C >> 4) * AGRP * 16 + R * 16 + (C & 15)) * 2u : (unsigned)(R * K + C) * 2u; voffB[i] = (unsigned)(Rb * K + C) * 2u; }
    const size_t kstepB = (size_t)(BK * 2), hstepB = (size_t)HALF * K * 2, tstepB = 2 * hstepB;
    const size_t kstepA = AGRP ? (size_t)4 * AGRP * 32 : kstepB, hstepA = AGRP ? (size_t)HALF * 32 : hstepB, tstepA = 2 * hstepA;
    const unsigned ldsw = (unsigned)wid * 1024u;
    const int aoff = lds_byte(wr * 64 + fr, fq * 8), boff = lds_byte(wc * 32 + fr, fq * 8);
#define PG8_SA(b, h) (((b) * 2 + (h)) * HTB)
#define PG8_SB(b, h) ((4 + (b) * 2 + (h)) * HTB)
#define PG8_STAGE(bufoff, gbase, voff) do { _Pragma("unroll") for (int _i = 0; _i < 2; ++_i) \
        __builtin_amdgcn_global_load_lds((const unsigned*)((const char*)(gbase) + (voff)[_i]), (PG8_LAS unsigned*)(lds + (bufoff) + ldsw + _i * 8192), 16, 0, 0); } while (0)
#define PG8_LDA(dst, b, h) do { _Pragma("unroll") for (int m = 0; m < 4; ++m) _Pragma("unroll") for (int k = 0; k < 2; ++k) dst[m][k] = *(const PG8_LAS bf16x8*)(lds + PG8_SA(b, h) + aoff + m * 2048 + k * 1024); } while (0)
#define PG8_LDB(dst, b, h) do { _Pragma("unroll") for (int n = 0; n < 2; ++n) _Pragma("unroll") for (int k = 0; k < 2; ++k) dst[n][k] = *(const PG8_LAS bf16x8*)(lds + PG8_SB(b, h) + boff + n * 2048 + k * 1024); } while (0)
#define PG8_MMA(ai, bj, At, Bt) do { __builtin_amdgcn_s_setprio(1); _Pragma("unroll") for (int m = 0; m < 4; ++m) _Pragma("unroll") for (int n = 0; n < 2; ++n) _Pragma("unroll") for (int k = 0; k < 2; ++k) \
        acc[ai][bj][m][n] = __builtin_amdgcn_mfma_f32_16x16x32_bf16(Bt[n][k], At[m][k], acc[ai][bj][m][n], 0, 0, 0); __builtin_amdgcn_s_setprio(0); } while (0)
#define PG8_WAIT_V(n) asm volatile("s_waitcnt vmcnt(" #n ")" ::: "memory")
#define PG8_WAIT_L(n) asm volatile("s_waitcnt lgkmcnt(" #n ")" ::: "memory")
#define PG8_BAR __builtin_amdgcn_s_barrier()
#define PG8_SCHED __builtin_amdgcn_sched_barrier(0)
    Unit cur, nxt; int ui = 0;
#define PG8_UNI(u) do { (u).pm = __builtin_amdgcn_readfirstlane((u).pm); (u).pn = __builtin_amdgcn_readfirstlane((u).pn); (u).pb = __builtin_amdgcn_readfirstlane((u).pb); (u).e = __builtin_amdgcn_readfirstlane((u).e); (u).fl = __builtin_amdgcn_readfirstlane((u).fl); } while (0)
    if (!S.next(0, cur)) { S.finish(-1, tid); return; } PG8_UNI(cur);
    f32x4 acc[2][2][4][2];
#pragma unroll
    for (int a = 0; a < 2; ++a)
#pragma unroll
        for (int b = 0; b < 2; ++b)
#pragma unroll
            for (int m = 0; m < 4; ++m)
#pragma unroll
                for (int n = 0; n < 2; ++n) acc[a][b][m][n] = (f32x4){0.f, 0.f, 0.f, 0.f};
    bf16x8 At[4][2], B0[2][2], B1[2][2];
    const char* cA = (const char*)g.A + (size_t)cur.pm * tstepA; const char* cB = (const char*)g.Bt + (size_t)cur.pb * tstepB;
    S.a_ready(cur);
    PG8_STAGE(PG8_SB(0, 0), cB, voffB); PG8_STAGE(PG8_SA(0, 0), cA, voffA); PG8_STAGE(PG8_SB(0, 1), cB + hstepB, voffB); PG8_STAGE(PG8_SA(0, 1), cA + hstepA, voffA);
    if (wr == 1) PG8_BAR;
    PG8_WAIT_V(4); PG8_BAR;
    PG8_STAGE(PG8_SB(1, 0), cB + kstepB, voffB); PG8_STAGE(PG8_SA(1, 0), cA + kstepA, voffA); PG8_STAGE(PG8_SB(1, 1), cB + hstepB + kstepB, voffB);
    PG8_WAIT_V(6); PG8_BAR;
    for (;;) {
        const bool has_next = S.next(ui + 1, nxt); PG8_UNI(nxt);
        const char* nA = has_next ? (const char*)g.A + (size_t)nxt.pm * tstepA : cA; const char* nB = has_next ? (const char*)g.Bt + (size_t)nxt.pb * tstepB : cB;
        for (int t = 0; t < nt; t += 2) {
            const bool last = (t == nt - 2);
            const char* a1 = cA + (size_t)(t + 1) * kstepA;
            const char* a2 = last ? nA : cA + (size_t)(t + 2) * kstepA; const char* b2 = last ? nB : cB + (size_t)(t + 2) * kstepB;
            const char* a3 = a2 + kstepA; const char* b3 = b2 + kstepB;
            if (last && has_next) S.a_ready(nxt);
            PG8_LDB(B0, 0, 0); PG8_SCHED; PG8_LDA(At, 0, 0); PG8_STAGE(PG8_SA(1, 1), a1 + hstepA, voffA);
            PG8_WAIT_L(8); PG8_BAR; PG8_WAIT_L(0); PG8_MMA(0, 0, At, B0); PG8_BAR; PG8_SCHED;
            PG8_LDB(B1, 0, 1); PG8_STAGE(PG8_SB(0, 0), b2, voffB);
            PG8_BAR; PG8_WAIT_L(0); PG8_MMA(0, 1, At, B1); PG8_BAR;
            PG8_LDA(At, 0, 1); PG8_STAGE(PG8_SA(0, 0), a2, voffA);
            PG8_BAR; PG8_WAIT_L(0); PG8_MMA(1, 0, At, B0); PG8_BAR; PG8_SCHED;
            PG8_STAGE(PG8_SB(0, 1), b2 + hstepB, voffB);
            PG8_WAIT_V(6); PG8_BAR; PG8_MMA(1, 1, At, B1); PG8_BAR;
            PG8_LDB(B0, 1, 0); PG8_SCHED; PG8_LDA(At, 1, 0); PG8_STAGE(PG8_SA(0, 1), a2 + hstepA, voffA);
            PG8_WAIT_L(8); PG8_BAR; PG8_WAIT_L(0); PG8_MMA(0, 0, At, B0); PG8_BAR; PG8_SCHED;
            PG8_LDB(B1, 1, 1); PG8_STAGE(PG8_SB(1, 0), b3, voffB);
            PG8_BAR; PG8_WAIT_L(0); PG8_MMA(0, 1, At, B1); PG8_BAR;
            PG8_LDA(At, 1, 1); PG8_STAGE(PG8_SA(1, 0), a3, voffA);
            PG8_BAR; PG8_WAIT_L(0); PG8_MMA(1, 0, At, B0); PG8_BAR; PG8_SCHED;
            PG8_STAGE(PG8_SB(1, 1), b3 + hstepB, voffB);
            PG8_WAIT_V(6); PG8_BAR; PG8_MMA(1, 1, At, B1); PG8_BAR;
        }
        if constexpr (!Epi::AFTER_DRAIN) { for (int r_ = 0; r_ < (PROBE_SUB == 9 ? 2 : 1); ++r_) E(acc, cur, wr, wc, fr, fq); S.done(cur); S.after_unit(ui, tid); }
        if (!has_next) break;
#pragma unroll
        for (int a = 0; a < 2; ++a)
#pragma unroll
            for (int b = 0; b < 2; ++b)
#pragma unroll
                for (int m = 0; m < 4; ++m)
#pragma unroll
                    for (int n = 0; n < 2; ++n) acc[a][b][m][n] = (f32x4){0.f, 0.f, 0.f, 0.f};
        cur = nxt; cA = nA; cB = nB; ++ui;
    }
    S.finish(ui, tid);
    PG8_WAIT_V(0);
    if (wr == 0) PG8_BAR;
    PG8_BAR;
    if constexpr (Epi::AFTER_DRAIN) { E.fused(acc, cur, wr, wc, fr, fq, lds, wid, lane); S.done(cur); }
#undef PG8_SA
#undef PG8_SB
#undef PG8_STAGE
#undef PG8_LDA
#undef PG8_LDB
#undef PG8_MMA
#undef PG8_WAIT_V
#undef PG8_WAIT_L
#undef PG8_BAR
#undef PG8_SCHED
#undef PG8_UNI
}
template <class Epi>
__device__ __forceinline__ void gemm_quarter(PG8_LAS unsigned char* lds, const Gemm g, const int pm, const int pn, const int mh, const int nh, const Epi& E, const int tid) {
    const int wid = __builtin_amdgcn_readfirstlane(tid >> 6), lane = tid & 63, wr = wid >> 2, wc = wid & 3, fr = lane & 15, fq = lane >> 4;
    const int K = g.K, nt = K / BK;
    unsigned voffA[2], voffB[2];
#pragma unroll
    for (int i = 0; i < 2; ++i) { int R, C; stage_rc(tid * 16 + i * 8192, R, C); const int Rb = Epi::PERM ? ((R & ~31) + perm32(R & 31)) : R; voffA[i] = (unsigned)(R * K + C) * 2u; voffB[i] = (unsigned)(Rb * K + C) * 2u; }
    const char* cA = (const char*)g.A + ((size_t)pm * BM + (size_t)mh * HALF) * K * 2; const char* cB = (const char*)g.Bt + ((size_t)pn * BM + (size_t)nh * HALF) * K * 2;
    const unsigned ldsw = (unsigned)wid * 1024u;
    const int aoff = lds_byte(wr * 64 + fr, fq * 8), boff = lds_byte(wc * 32 + fr, fq * 8);
#define PQ_SA(b) (((b) * 2) * HTB)
#define PQ_SB(b) ((4 + (b) * 2) * HTB)
#define PQ_STAGE(bufoff, gbase, voff) do { _Pragma("unroll") for (int _i = 0; _i < 2; ++_i) \
        __builtin_amdgcn_global_load_lds((const unsigned*)((const char*)(gbase) + (voff)[_i]), (PG8_LAS unsigned*)(lds + (bufoff) + ldsw + _i * 8192), 16, 0, 0); } while (0)
    f32x4 acc[2][2][4][2];
#pragma unroll
    for (int a = 0; a < 2; ++a)
#pragma unroll
        for (int b = 0; b < 2; ++b)
#pragma unroll
            for (int m = 0; m < 4; ++m)
#pragma unroll
                for (int n = 0; n < 2; ++n) acc[a][b][m][n] = (f32x4){0.f, 0.f, 0.f, 0.f};
    PQ_STAGE(PQ_SA(0), cA, voffA); PQ_STAGE(PQ_SB(0), cB, voffB);
    for (int t = 0; t < nt; ++t) { const int b = t & 1;
        if (t + 1 < nt) { PQ_STAGE(PQ_SA(b ^ 1), cA + (size_t)(t + 1) * (BK * 2), voffA); PQ_STAGE(PQ_SB(b ^ 1), cB + (size_t)(t + 1) * (BK * 2), voffB); asm volatile("s_waitcnt vmcnt(4)" ::: "memory"); }
        else asm volatile("s_waitcnt vmcnt(0)" ::: "memory");
        __builtin_amdgcn_s_barrier();
        bf16x8 At[4][2], B0[2][2];
#pragma unroll
        for (int m = 0; m < 4; ++m)
#pragma unroll
            for (int k = 0; k < 2; ++k) At[m][k] = *(const PG8_LAS bf16x8*)(lds + (b ? PQ_SA(1) : PQ_SA(0)) + aoff + m * 2048 + k * 1024);
#pragma unroll
        for (int n = 0; n < 2; ++n)
#pragma unroll
            for (int k = 0; k < 2; ++k) B0[n][k] = *(const PG8_LAS bf16x8*)(lds + (b ? PQ_SB(1) : PQ_SB(0)) + boff + n * 2048 + k * 1024);
        asm volatile("s_waitcnt lgkmcnt(0)" ::: "memory");
#pragma unroll
        for (int m = 0; m < 4; ++m)
#pragma unroll
            for (int n = 0; n < 2; ++n)
#pragma unroll
                for (int k = 0; k < 2; ++k) acc[0][0][m][n] = __builtin_amdgcn_mfma_f32_16x16x32_bf16(B0[n][k], At[m][k], acc[0][0][m][n], 0, 0, 0);
        __builtin_amdgcn_s_barrier();
    }
    Unit u; u.pm = pm; u.pn = pn; u.pb = pn; u.e = 0; u.fl = 1 | 2 | (mh ? 8 : 0) | (nh ? 16 : 0);
    E(acc, u, wr, wc, fr, fq);
#undef PQ_SA
#undef PQ_SB
#undef PQ_STAGE
}
}
namespace pg8 {
struct GemmF { const bf16_t* A; const float* Bf0; const float* Bf1; size_t estride; int ncstep; int ldb; int K; bf16_t* img; const unsigned* vt = nullptr; };
__device__ __forceinline__ int g8swz(int k) { return (k & 1) | (((k >> 1) & 1) << 3) | (((k >> 3) & 1) << 4); }
template <class Epi, class Sched, int VAR = 0, bool IMG = false, bool GATH = false, bool HALFN = false  >
__device__ __forceinline__ void gemm_phase_fb(PG8_LAS unsigned char* lds, const GemmF g, const Sched& S, const Epi& E, const int tid) {
    static_assert(Epi::PERM && !Epi::AFTER_DRAIN, "f32-B body: 2-byte-output epilogues only");
    const int wid = __builtin_amdgcn_readfirstlane(tid >> 6), lane = tid & 63, wr = wid >> 2, wc = wid & 3, fr = lane & 15, fq = lane >> 4;
    const int K = g.K, nt = K / BK;
    unsigned voffA0; { int R, C; stage_rc(tid * 16, R, C); voffA0 = (unsigned)(R * K + C) * 2u; }
    const unsigned kstepA = (unsigned)(BK * 2), hstepA = (unsigned)HALF * K * 2, tstepA = 2 * hstepA;
    const unsigned kstepB = (unsigned)BK * (unsigned)g.ldb * 4u;
    const unsigned ldsw = (unsigned)wid * 1024u;
    const int aoff = lds_byte(wr * 64 + fr, fq * 8);
    const int kr = tid >> 5, c4 = tid & 31;
    const unsigned voffBf = (unsigned)(kr * g.ldb + c4 * 4) * 4u; const unsigned jstepB = 16u * (unsigned)g.ldb * 4u;
    u32x4 rs0, rs1;
    { const unsigned long long p0 = (unsigned long long)(uintptr_t)g.Bf0, p1 = (unsigned long long)(uintptr_t)g.Bf1;
      rs0.x = __builtin_amdgcn_readfirstlane((unsigned)p0); rs0.y = __builtin_amdgcn_readfirstlane((unsigned)(p0 >> 32) & 0xffffu); rs0.z = 0x7fffffffu; rs0.w = 0x00020000u;
      rs1.x = __builtin_amdgcn_readfirstlane((unsigned)p1); rs1.y = __builtin_amdgcn_readfirstlane((unsigned)(p1 >> 32) & 0xffffu); rs1.z = 0x7fffffffu; rs1.w = 0x00020000u; }
    const __amdgpu_buffer_rsrc_t rsA = __builtin_amdgcn_make_buffer_rsrc((void*)g.A, 0, 0x7fffffff, 0x00020000);
    const __amdgpu_buffer_rsrc_t rsI = __builtin_amdgcn_make_buffer_rsrc((void*)g.img, 0, 0x7fffffff, 0x00020000);
    const unsigned istepI = (unsigned)(K / BK) * 32768u;
    const unsigned woffB = (unsigned)(kr * 256 + 8 * (c4 ^ g8swz(kr)));
    u32x2 vt = {0u, 0u}, vn = {0u, 0u}; unsigned c2 = 0; u32x4 rsV = {0u, 0u, 0u, 0u};
    if constexpr (GATH) { int R, C; stage_rc(tid * 16, R, C); c2 = (unsigned)C * 2u; const unsigned long long pv = (unsigned long long)(uintptr_t)g.vt;
        rsV.x = __builtin_amdgcn_readfirstlane((unsigned)pv); rsV.y = __builtin_amdgcn_readfirstlane((unsigned)(pv >> 32) & 0xffffu); rsV.z = 0x7fffffffu; rsV.w = 0x00020000u; }
    const unsigned lds0 = (unsigned)(uintptr_t)lds;
    unsigned btb0; { const int q = fr >> 2, p = fr & 3, krow = 8 * fq + q; btb0 = lds0 + (unsigned)(krow * 256 + 8 * ((8 * wc + 2 * p) ^ g8swz(krow))); }
#define PG8_SA(b, h) (((b) * 2 + (h)) * HTB)
#define PG8_SB(b, h) ((4 + (b) * 2 + (h)) * HTB)
#define PG8_STAGEA(b, h, base) do { if constexpr (GATH) { const unsigned _p = (h) ? vt.y : vt.x; \
        __builtin_amdgcn_raw_ptr_buffer_load_lds(rsA, (PG8_LAS void*)(lds + PG8_SA(b, h) + ldsw), 16, ((_p & 0xffffu) << 12) + c2, (base), 0, 0); \
        __builtin_amdgcn_raw_ptr_buffer_load_lds(rsA, (PG8_LAS void*)(lds + PG8_SA(b, h) + ldsw + 8192), 16, ((_p >> 16) << 12) + c2, (base), 0, 0); } else { _Pragma("unroll") for (int _i = 0; _i < 2; ++_i) \
        __builtin_amdgcn_raw_ptr_buffer_load_lds(rsA, (PG8_LAS void*)(lds + PG8_SA(b, h) + ldsw + _i * 8192), 16, voffA0, (base) + (unsigned)(h) * hstepA + (unsigned)_i * 128u * (unsigned)K, 0, 0); } } while (0)
#define PG8_BISSUE(R, rs, soff) do { if constexpr (VAR == 2 || VAR == 3 || VAR == 4) break; _Pragma("unroll") for (int _j = 0; _j < 4; ++_j) { const unsigned _so = (VAR == 5) ? (unsigned)__builtin_amdgcn_readfirstlane(_j * jstepB) : (unsigned)__builtin_amdgcn_readfirstlane((soff) + _j * jstepB); \
        asm volatile("buffer_load_dwordx4 %0, %1, %2, %3 offen" : "=v"(R[_j]) : "v"(voffBf), "s"(rs), "s"(_so) : "memory"); } } while (0)
#define PG8_RPIN(R) asm volatile("" : "+v"(R[0]), "+v"(R[1]), "+v"(R[2]), "+v"(R[3]))
#define PG8_BCOMMIT(R, bufoff, imgoff) do { if constexpr (VAR == 1 || VAR == 3 || VAR == 4) break; _Pragma("unroll") for (int _j = 0; _j < 4; ++_j) { u32x2 _w; _w.x = cvt_pk_bf16(R[_j][0], R[_j][1]); _w.y = cvt_pk_bf16(R[_j][2], R[_j][3]); \
        *(PG8_LAS u32x2*)(lds + (bufoff) + woffB + _j * 4096) = _w; \
        if constexpr (IMG) __builtin_amdgcn_raw_buffer_store_b64(_w, rsI, woffB, (unsigned)__builtin_amdgcn_readfirstlane((int)((imgoff) + _j * 4096)), 0); } } while (0)
#define PG8_WAIT_VC() do { if constexpr (IMG) asm volatile("s_waitcnt vmcnt(10)" ::: "memory"); else asm volatile("s_waitcnt vmcnt(6)" ::: "memory"); } while (0)
#define PG8_WAIT_VC26() do { if constexpr (!HALFN) PG8_WAIT_VC(); } while (0)
#define PG8_WAIT_VC48() do { if constexpr (HALFN) asm volatile("s_waitcnt vmcnt(2)" ::: "memory"); else PG8_WAIT_VC(); } while (0)
#define PG8_LDA(dst, b, h) do { _Pragma("unroll") for (int m = 0; m < 4; ++m) _Pragma("unroll") for (int k = 0; k < 2; ++k) dst[m][k] = *(const PG8_LAS bf16x8*)(lds + PG8_SA(b, h) + aoff + m * 2048 + k * 1024); } while (0)
#define PG8_LDBT(dst, b, h) do { if constexpr (VAR == 4) break; const unsigned _a0 = btb0 + PG8_SB(b, h), _a1 = (btb0 ^ 8u) + PG8_SB(b, h); s16x4 _r0, _r1, _r2, _r3, _r4, _r5, _r6, _r7; \
        asm volatile("ds_read_b64_tr_b16 %0, %8\n\tds_read_b64_tr_b16 %1, %8 offset:1024\n\tds_read_b64_tr_b16 %2, %8 offset:8192\n\tds_read_b64_tr_b16 %3, %8 offset:9216\n\t" \
                     "ds_read_b64_tr_b16 %4, %9\n\tds_read_b64_tr_b16 %5, %9 offset:1024\n\tds_read_b64_tr_b16 %6, %9 offset:8192\n\tds_read_b64_tr_b16 %7, %9 offset:9216" \
                     : "=&v"(_r0), "=&v"(_r1), "=&v"(_r2), "=&v"(_r3), "=&v"(_r4), "=&v"(_r5), "=&v"(_r6), "=&v"(_r7) : "v"(_a0), "v"(_a1) : "memory"); \
        dst[0][0] = (bf16x8){_r0[0], _r0[1], _r0[2], _r0[3], _r1[0], _r1[1], _r1[2], _r1[3]}; dst[0][1] = (bf16x8){_r2[0], _r2[1], _r2[2], _r2[3], _r3[0], _r3[1], _r3[2], _r3[3]}; \
        dst[1][0] = (bf16x8){_r4[0], _r4[1], _r4[2], _r4[3], _r5[0], _r5[1], _r5[2], _r5[3]}; dst[1][1] = (bf16x8){_r6[0], _r6[1], _r6[2], _r6[3], _r7[0], _r7[1], _r7[2], _r7[3]}; } while (0)
#define PG8_BPIN(Bt) asm volatile("" : "+v"(Bt[0][0]), "+v"(Bt[0][1]), "+v"(Bt[1][0]), "+v"(Bt[1][1]))
#define PG8_MMA(ai, bj, At, Bt) do { __builtin_amdgcn_s_setprio(1); _Pragma("unroll") for (int m = 0; m < 4; ++m) _Pragma("unroll") for (int n = 0; n < 2; ++n) _Pragma("unroll") for (int k = 0; k < 2; ++k) \
        acc[ai][bj][m][n] = __builtin_amdgcn_mfma_f32_16x16x32_bf16(Bt[n][k], At[m][k], acc[ai][bj][m][n], 0, 0, 0); __builtin_amdgcn_s_setprio(0); } while (0)
#define PG8_WAIT_V(n) asm volatile("s_waitcnt vmcnt(" #n ")" ::: "memory")
#define PG8_WAIT_L(n) asm volatile("s_waitcnt lgkmcnt(" #n ")" ::: "memory")
#define PG8_BAR __builtin_amdgcn_s_barrier()
#define PG8_SCHED __builtin_amdgcn_sched_barrier(0)
#define PG8_BOFF(u) ((unsigned)__builtin_amdgcn_readfirstlane((int)(((size_t)(u).e * g.estride + (size_t)(u).pn * g.ncstep) * 4 + ((HALFN && ((u).fl & 16)) ? 512 : 0))))
    Unit cur, nxt; int ui = 0;
#define PG8_UNI(u) do { (u).pm = __builtin_amdgcn_readfirstlane((u).pm); (u).pn = __builtin_amdgcn_readfirstlane((u).pn); (u).pb = __builtin_amdgcn_readfirstlane((u).pb); (u).e = __builtin_amdgcn_readfirstlane((u).e); (u).fl = __builtin_amdgcn_readfirstlane((u).fl); } while (0)
    if (!S.next(0, cur)) { S.finish(-1, tid); return; } PG8_UNI(cur);
    f32x4 acc[2][2][4][2];
#pragma unroll
    for (int a = 0; a < 2; ++a)
#pragma unroll
        for (int b = 0; b < 2; ++b)
#pragma unroll
            for (int m = 0; m < 4; ++m)
#pragma unroll
                for (int n = 0; n < 2; ++n) acc[a][b][m][n] = (f32x4){0.f, 0.f, 0.f, 0.f};
    bf16x8 At[4][2], B0[2][2], B1[2][2];
    f32x4 bp[4], bq[4];
    unsigned cA = GATH ? 0u : (unsigned)cur.pm * tstepA, cB = PG8_BOFF(cur), cI = (unsigned)cur.pb * istepI;
    if constexpr (GATH) { vt = *(const u32x2*)((const char*)g.vt + (size_t)cur.pm * 4096 + woffB); vn = vt; }
    S.a_ready(cur);
    if constexpr (HALFN) {
        PG8_BISSUE(bq, rs0, cB); PG8_STAGEA(0, 0, cA); PG8_STAGEA(0, 1, cA);
        if (wr == 1) PG8_BAR;
        PG8_WAIT_V(4); PG8_RPIN(bq); PG8_BCOMMIT(bq, PG8_SB(0, 0), cI); PG8_WAIT_L(0); PG8_BAR;
        PG8_BISSUE(bq, rs0, cB + kstepB); PG8_STAGEA(1, 0, cA + kstepA);
        PG8_WAIT_V(2); PG8_RPIN(bq); PG8_BCOMMIT(bq, PG8_SB(1, 0), cI + 32768u);
        PG8_BISSUE(bq, rs0, cB + 2 * kstepB);
        PG8_WAIT_L(0); PG8_BAR;
    } else {
    PG8_BISSUE(bq, rs0, cB); PG8_STAGEA(0, 0, cA); PG8_BISSUE(bp, rs1, cB); PG8_STAGEA(0, 1, cA);
    if (wr == 1) PG8_BAR;
    PG8_WAIT_V(6); PG8_RPIN(bq); PG8_BCOMMIT(bq, PG8_SB(0, 0), cI); PG8_WAIT_L(0); PG8_BAR;
    PG8_BISSUE(bq, rs0, cB + kstepB); PG8_STAGEA(1, 0, cA + kstepA);
    PG8_WAIT_VC(); PG8_RPIN(bp); PG8_BCOMMIT(bp, PG8_SB(0, 1), cI + 16384u);
    PG8_BISSUE(bp, rs1, cB + kstepB);
    PG8_WAIT_VC(); PG8_RPIN(bq); PG8_BCOMMIT(bq, PG8_SB(1, 0), cI + 32768u);
    PG8_BISSUE(bq, rs0, cB + 2 * kstepB);
    PG8_WAIT_L(0); PG8_BAR;
    }
    for (;;) {
        const bool has_next = S.next(ui + 1, nxt); PG8_UNI(nxt);
        const unsigned nA = GATH ? 0u : (has_next ? (unsigned)nxt.pm * tstepA : cA);
        const unsigned nV = (unsigned)__builtin_amdgcn_readfirstlane((has_next ? nxt.pm : cur.pm) * 4096);
        const unsigned nB = has_next ? PG8_BOFF(nxt) : cB; const unsigned nI = has_next ? (unsigned)nxt.pb * istepI : cI;
        for (int t = 0; t < nt; t += 2) {
            const bool last = (t == nt - 2);
            const unsigned a1 = cA + (unsigned)(t + 1) * kstepA, a2 = last ? nA : cA + (unsigned)(t + 2) * kstepA, a3 = a2 + kstepA;
            const unsigned b2 = last ? nB : cB + (unsigned)(t + 2) * kstepB, b3 = b2 + kstepB;
            const unsigned i2 = last ? nI : cI + (unsigned)(t + 2) * 32768u, i3 = i2 + 32768u;
            const unsigned b4 = (t + 4 < nt) ? cB + (unsigned)(t + 4) * kstepB : nB + (unsigned)(t + 4 - nt) * kstepB;
            if (last && has_next) S.a_ready(nxt);
            PG8_LDBT(B0, 0, 0); PG8_SCHED; PG8_LDA(At, 0, 0); PG8_STAGEA(1, 1, a1); if constexpr (GATH) { vt.x = last ? vn.x : vt.x; vt.y = last ? vn.y : vt.y; }
            PG8_WAIT_L(8); PG8_BAR; PG8_WAIT_L(0); PG8_BPIN(B0); PG8_MMA(0, 0, At, B0); PG8_BAR; PG8_SCHED;
            if constexpr (!HALFN) { PG8_LDBT(B1, 0, 1); PG8_WAIT_VC(); PG8_RPIN(bp); } if constexpr (GATH) asm volatile("buffer_load_dwordx2 %0, %1, %2, %3 offen" : "=v"(vn) : "v"(woffB), "s"(rsV), "s"(nV) : "memory");
            if constexpr (!HALFN) { PG8_BCOMMIT(bp, PG8_SB(1, 1), cI + (unsigned)(t + 1) * 32768u + 16384u); PG8_BISSUE(bp, rs1, b2); }
            PG8_BAR; PG8_WAIT_L(0); if constexpr (!HALFN) { PG8_BPIN(B1); PG8_MMA(0, 1, At, B1); } PG8_BAR;
            PG8_LDA(At, 0, 1); PG8_STAGEA(0, 0, a2);
            PG8_BAR; PG8_WAIT_L(0); PG8_MMA(1, 0, At, B0); PG8_BAR; PG8_SCHED;
            PG8_WAIT_VC48(); PG8_RPIN(bq); PG8_BCOMMIT(bq, PG8_SB(0, 0), i2); PG8_BISSUE(bq, rs0, b3);
            PG8_BAR; if constexpr (!HALFN) PG8_MMA(1, 1, At, B1); PG8_BAR;
            PG8_LDBT(B0, 1, 0); PG8_SCHED; PG8_LDA(At, 1, 0); PG8_STAGEA(0, 1, a2);
            PG8_WAIT_L(8); PG8_BAR; PG8_WAIT_L(0); PG8_BPIN(B0); PG8_MMA(0, 0, At, B0); PG8_BAR; PG8_SCHED;
            if constexpr (!HALFN) { PG8_LDBT(B1, 1, 1); PG8_WAIT_VC(); PG8_RPIN(bp); PG8_BCOMMIT(bp, PG8_SB(0, 1), i2 + 16384u); PG8_BISSUE(bp, rs1, b3); }
            PG8_BAR; PG8_WAIT_L(0); if constexpr (!HALFN) { PG8_BPIN(B1); PG8_MMA(0, 1, At, B1); } PG8_BAR;
            PG8_LDA(At, 1, 1); PG8_STAGEA(1, 0, a3);
            PG8_BAR; PG8_WAIT_L(0); PG8_MMA(1, 0, At, B0); PG8_BAR; PG8_SCHED;
            PG8_WAIT_VC48(); PG8_RPIN(bq); PG8_BCOMMIT(bq, PG8_SB(1, 0), i3); PG8_BISSUE(bq, rs0, b4);
            PG8_BAR; if constexpr (!HALFN) PG8_MMA(1, 1, At, B1); PG8_BAR;
        }
        int ln_; asm volatile("v_mbcnt_lo_u32_b32 %0, -1, 0\n\tv_mbcnt_hi_u32_b32 %0, -1, %0" : "=v"(ln_));
        { int fr_ = ln_ & 15, fq_ = ln_ >> 4;
          for (int r_ = 0; r_ < (PROBE_SUB == 8 ? 2 : 1); ++r_) E(acc, cur, wr, wc, fr_, fq_); }
        S.done(cur);
        if (!has_next) break;
#pragma unroll
        for (int a = 0; a < 2; ++a)
#pragma unroll
            for (int b = 0; b < 2; ++b)
#pragma unroll
                for (int m = 0; m < 4; ++m)
#pragma unroll
                    for (int n = 0; n < 2; ++n) acc[a][b][m][n] = (f32x4){0.f, 0.f, 0.f, 0.f};
        cur = nxt; cA = nA; cB = nB; cI = nI; ++ui;
    }
    PG8_WAIT_V(0); PG8_WAIT_L(0);
    if constexpr (!HALFN) asm volatile("" :: "v"(bp[0]), "v"(bp[1]), "v"(bp[2]), "v"(bp[3])); asm volatile("" :: "v"(bq[0]), "v"(bq[1]), "v"(bq[2]), "v"(bq[3]));
    if (wr == 0) PG8_BAR;
    PG8_BAR;
#undef PG8_SA
#undef PG8_SB
#undef PG8_STAGEA
#undef PG8_BISSUE
#undef PG8_BCOMMIT
#undef PG8_RPIN
#undef PG8_WAIT_VC
#undef PG8_WAIT_VC26
#undef PG8_WAIT_VC48
#undef PG8_LDA
#undef PG8_LDBT
#undef PG8_BPIN
#undef PG8_MMA
#undef PG8_WAIT_V
#undef PG8_WAIT_L
#undef PG8_BAR
#undef PG8_SCHED
#undef PG8_UNI
#undef PG8_BOFF
}
}
namespace pg8 {
struct GroupedOrder {
    int nE, nMt, nNt, ERT, G, c, mt0;
    __device__ __forceinline__ bool next(int i, Unit& u) const {
        const int nwg = nE * nMt * nNt; const long L = (long)i * G + c; if (L >= nwg) return false;
        int wgid = (int)L; { const int q = nwg / NXCD, r = nwg % NXCD, xcd = wgid % NXCD, off = wgid / NXCD; wgid = (xcd < r ? xcd * (q + 1) : r * (q + 1) + (xcd - r) * q) + off; }
        const int per = nMt * nNt, e = wgid / per, rem = wgid % per, mt = rem % nMt, nt = rem / nMt;
        u.e = e; u.pm = e * ERT + mt0 + mt; u.pn = nt; u.pb = e * nNt + nt; u.fl = 0; return true;
    }
    __device__ __forceinline__ void a_ready(const Unit&) const {}
    __device__ __forceinline__ void done(const Unit&) const {}
    __device__ __forceinline__ void after_unit(int, int) const {}
    __device__ __forceinline__ void finish(int, int) const {}
};
struct GroupedOrderHead : GroupedOrder { int lim;
    __device__ __forceinline__ bool next(int i, Unit& u) const { if ((long)i * G + c >= lim) return false; return GroupedOrder::next(i, u); } };
struct GroupedOrderTailHN : GroupedOrder { int L0;
    __device__ __forceinline__ bool next(int i, Unit& u) const { if (i > 0) return false; GroupedOrder b = *this; b.c = (c & 7) | ((c >> 4) << 3);
        if (!b.next(L0 / G, u)) return false; u.fl = 2 | (((c >> 3) & 1) ? 16 : 0); return true; } };
struct OutOrder0 {
    StaticOrder S0; int G, c, split;
    __device__ __forceinline__ bool next(int i, Unit& u) const {
        const long L = (long)i * G + c; if (!split || L < 512) return S0.next(i, u);
        const int h = (int)L - 512; if (h >= 64) return false;
        u.pm = 64 + (h >> 4); u.pn = (h >> 1) & 7; u.pb = u.pn; u.e = 0; u.fl = (h & 1) ? 4 : 2; return true;
    }
    __device__ __forceinline__ void a_ready(const Unit&) const {}
    __device__ __forceinline__ void done(const Unit&) const {}
    __device__ __forceinline__ void after_unit(int, int) const {}
    __device__ __forceinline__ void finish(int, int) const {}
};

__device__ __forceinline__ int g8swz_(int k) { return (k & 1) | (((k >> 1) & 1) << 3) | (((k >> 3) & 1) << 4); }
struct ConvJob {
    const float* W0; const float* W1; size_t estride; int ncstep, ldb, nNt; bf16_t* img; int q0, q1, slot;
    __device__ __forceinline__ void run(int tid) const {
        const int kr = tid >> 5, c4 = tid & 31; const unsigned woff = (unsigned)(kr * 256 + 8 * (c4 ^ g8swz_(kr)));
        for (int q = q0; q < q1; q += 2) {
            f32x4 v[2][2][4];
#pragma unroll
            for (int u = 0; u < 2; ++u) { const int qq = (q + u < q1) ? q + u : q; const int pb = qq >> 5, kt = qq & 31, e = pb / nNt, nt = pb % nNt;
#pragma unroll
                for (int h = 0; h < 2; ++h) { const float* src = (h ? W1 : W0) + (size_t)e * estride + (size_t)nt * ncstep + (size_t)(kt * 64 + kr) * ldb + 4 * c4;
#pragma unroll
                    for (int j = 0; j < 4; ++j) v[u][h][j] = *(const f32x4*)(src + (size_t)(16 * j) * ldb); } }
#pragma unroll
            for (int u = 0; u < 2; ++u) { if (q + u >= q1) break; const int qq = q + u; const int pb = qq >> 5, kt = qq & 31;
                unsigned char* dst = (unsigned char*)img + (size_t)pb * 1048576 + (size_t)kt * 32768 + woff;
#pragma unroll
                for (int h = 0; h < 2; ++h)
#pragma unroll
                    for (int j = 0; j < 4; ++j) { u32x2 w; w.x = cvt_pk_bf16(v[u][h][j][0], v[u][h][j][1]); w.y = cvt_pk_bf16(v[u][h][j][2], v[u][h][j][3]); *(u32x2*)(dst + h * 16384 + j * 4096) = w; } }
        }
        asm volatile("s_waitcnt vmcnt(0)" ::: "memory");
    }
};
struct StaticOrderConv : StaticOrder { ConvJob job;
    __device__ __forceinline__ void after_unit(int ui, int tid) const { if (ui == job.slot) job.run(tid); }
    __device__ __forceinline__ void finish(int last, int tid) const { if (last < job.slot) job.run(tid); } };
struct GroupedOrderConv : GroupedOrder { ConvJob job;
    __device__ __forceinline__ void after_unit(int ui, int tid) const { if (ui == job.slot) job.run(tid); }
    __device__ __forceinline__ void finish(int last, int tid) const { if (last < job.slot) job.run(tid); } };
struct EpiProj {
    static constexpr bool PERM = true, AFTER_DRAIN = false;
    bf16_t* proj; bf16_t* su; const float* rope;
    __device__ __forceinline__ void operator()(const f32x4 (&acc)[2][2][4][2], const Unit& u, int wr, int wc, int fr, int fq) const {
        const int row0 = u.pm * BM + wr * 64 + fr; const int colt = u.pn * BM;
        const bool do_rope = (u.pn < 5) && (u.pm < 64);
        const bool is_su = (u.pn == 6) || (u.pn == 7);
#pragma unroll
        for (int ai = 0; ai < 2; ++ai)
#pragma unroll
            for (int m = 0; m < 4; ++m) {
                const int row = row0 + ai * HALF + m * 16;
#pragma unroll
                for (int bj = 0; bj < 2; ++bj) {
                    const int col = colt + bj * HALF + wc * 32 + 8 * fq;
                    f32x4 v0 = acc[ai][bj][m][0], v1 = acc[ai][bj][m][1];
                    if (do_rope) {
                        const int jj = col & 127, t = row & 4095; const int pos = (jj < 64) ? (t >> 6) : (t & 63); const int i0 = (jj & 63) >> 1;
                        const f32x4 cs0 = *(const f32x4*)(rope + (pos * 32 + i0) * 2), cs1 = *(const f32x4*)(rope + (pos * 32 + i0 + 2) * 2);
                        f32x4 o0, o1;
                        o0[0] = v0[0] * cs0[0] - v0[1] * cs0[1]; o0[1] = v0[1] * cs0[0] + v0[0] * cs0[1];
                        o0[2] = v0[2] * cs0[2] - v0[3] * cs0[3]; o0[3] = v0[3] * cs0[2] + v0[2] * cs0[3];
                        o1[0] = v1[0] * cs1[0] - v1[1] * cs1[1]; o1[1] = v1[1] * cs1[0] + v1[0] * cs1[1];
                        o1[2] = v1[2] * cs1[2] - v1[3] * cs1[3]; o1[3] = v1[3] * cs1[2] + v1[2] * cs1[3];
                        v0 = o0; v1 = o1;
                    }
                    u32x4 w; w.x = cvt_pk_bf16(v0[0], v0[1]); w.y = cvt_pk_bf16(v0[2], v0[3]); w.z = cvt_pk_bf16(v1[0], v1[1]); w.w = cvt_pk_bf16(v1[2], v1[3]);
                    if (is_su) { const int g = (col - C_SU) >> 4, h0 = col & 15; *(u32x4*)(su + ((size_t)g * MT + row) * 16 + h0) = w; }
                    else *(u32x4*)(proj + (size_t)row * NINP + col) = w;
                }
            }
    }
};
struct EpiGlu {
    static constexpr bool PERM = true, AFTER_DRAIN = false;
    const bf16_t* z; const float* bias; bf16_t* mix;
    __device__ __forceinline__ void operator()(const f32x4 (&acc)[2][2][4][2], const Unit& u, int wr, int wc, int fr, int fq) const {
        const int row0 = u.pm * BM + wr * 64 + fr; const int colt = u.pn * BM;
#pragma unroll
        for (int ai = 0; ai < 2; ++ai)
#pragma unroll
            for (int m = 0; m < 4; ++m) {
                const int row = row0 + ai * HALF + m * 16;
#pragma unroll
                for (int bj = 0; bj < 2; ++bj) {
                    const int col = colt + bj * HALF + wc * 32 + 8 * fq;
                    const f32x4 b0 = *(const f32x4*)(bias + col), b1 = *(const f32x4*)(bias + col + 4);
                    const u32x4 zz = *(const u32x4*)(z + ((size_t)(col >> 4) * MT + row) * 16 + (col & 15));
                    const f32x4 v0 = acc[ai][bj][m][0] + b0, v1 = acc[ai][bj][m][1] + b1;
                    float o[8];
                    o[0] = bflo(zz.x) * sigmoidf_(v0[0]); o[1] = bfhi(zz.x) * sigmoidf_(v0[1]); o[2] = bflo(zz.y) * sigmoidf_(v0[2]); o[3] = bfhi(zz.y) * sigmoidf_(v0[3]);
                    o[4] = bflo(zz.z) * sigmoidf_(v1[0]); o[5] = bfhi(zz.z) * sigmoidf_(v1[1]); o[6] = bflo(zz.w) * sigmoidf_(v1[2]); o[7] = bfhi(zz.w) * sigmoidf_(v1[3]);
                    u32x4 w; w.x = cvt_pk_bf16(o[0], o[1]); w.y = cvt_pk_bf16(o[2], o[3]); w.z = cvt_pk_bf16(o[4], o[5]); w.w = cvt_pk_bf16(o[6], o[7]);
                    *(u32x4*)(mix + (size_t)row * DM + 1024 + col) = w;
                }
            }
    }
};
struct EpiF32 {
    static constexpr bool PERM = false, AFTER_DRAIN = false;
    float* C; int ldc;
    __device__ __forceinline__ void operator()(const f32x4 (&acc)[2][2][4][2], const Unit& u, int wr, int wc, int fr, int fq) const {
        const int row0 = u.pm * BM + wr * 64 + fr, col0 = u.pn * BM + wc * 32 + 4 * fq;
#pragma unroll
        for (int ai = 0; ai < 2; ++ai)
#pragma unroll
            for (int m = 0; m < 4; ++m) { float* rowp = C + (size_t)(row0 + ai * HALF + m * 16) * ldc + col0;
#pragma unroll
                for (int bj = 0; bj < 2; ++bj)
#pragma unroll
                    for (int n = 0; n < 2; ++n) *(f32x4*)(rowp + bj * HALF + n * 16) = acc[ai][bj][m][n]; }
    }
};
struct EpiGateUp {
    static constexpr bool PERM = true, AFTER_DRAIN = false;
    bf16_t* hid;
    __device__ __forceinline__ void operator()(const f32x4 (&acc)[2][2][4][2], const Unit& u, int wr, int wc, int fr, int fq) const {
        const int row0 = u.pm * BM + wr * 64 + fr; const int col = u.pn * HALF + wc * 32 + 8 * fq;
#pragma unroll
        for (int ai = 0; ai < 2; ++ai) { if (ai == 1 && (u.fl & 1)) continue;
#pragma unroll
            for (int m = 0; m < 4; ++m) {
                const int row = row0 + ai * HALF + m * 16;
                const f32x4 g0 = acc[ai][0][m][0], g1 = acc[ai][0][m][1], u0 = acc[ai][1][m][0], u1 = acc[ai][1][m][1];
                u32x4 w; w.x = cvt_pk_bf16(siluf_(g0[0]) * u0[0], siluf_(g0[1]) * u0[1]); w.y = cvt_pk_bf16(siluf_(g0[2]) * u0[2], siluf_(g0[3]) * u0[3]);
                w.z = cvt_pk_bf16(siluf_(g1[0]) * u1[0], siluf_(g1[1]) * u1[1]); w.w = cvt_pk_bf16(siluf_(g1[2]) * u1[2], siluf_(g1[3]) * u1[3]);
                *(u32x4*)(hid + (size_t)row * DM + col) = w;
            } }
    }
};
struct EpiBf16 {
    static constexpr bool PERM = true, AFTER_DRAIN = false;
    bf16_t* O; int ldc;
    __device__ __forceinline__ void operator()(const f32x4 (&acc)[2][2][4][2], const Unit& u, int wr, int wc, int fr, int fq) const {
        const int row0 = u.pm * BM + wr * 64 + fr + ((u.fl & 8) ? HALF : 0); const int colt = u.pn * BM + ((u.fl & 16) ? HALF : 0);
#pragma unroll
        for (int ai = 0; ai < 2; ++ai) { if (ai == 1 && (u.fl & 1)) continue;
#pragma unroll
            for (int m = 0; m < 4; ++m) {
                bf16_t* rowp = O + (size_t)(row0 + ai * HALF + m * 16) * ldc + colt + wc * 32 + 8 * fq;
#pragma unroll
                for (int bj = 0; bj < 2; ++bj) { if ((bj == 1 && (u.fl & 2)) || (bj == 0 && (u.fl & 4))) continue; const f32x4 v0 = acc[ai][bj][m][0], v1 = acc[ai][bj][m][1];
                    u32x4 w; w.x = cvt_pk_bf16(v0[0], v0[1]); w.y = cvt_pk_bf16(v0[2], v0[3]); w.z = cvt_pk_bf16(v1[0], v1[1]); w.w = cvt_pk_bf16(v1[2], v1[3]);
                    *(u32x4*)(rowp + bj * HALF) = w; }
            } }
    }
};
}
struct Args { const float* in[30]; float* out; unsigned char* ws; int ph_lo, ph_hi; };
struct Frame {
    const float* const* in; float* out; unsigned char* ws; LAS unsigned char* lds; int tid, lane, wave, G, bid;
};
#define WSP(T, off) ((T*)(F.ws + (off)))

__device__ __forceinline__ int rope_perm(int o) { return (o < 64) ? (2 * (o & 31) + (o >> 5)) : (64 + 2 * ((o - 64) & 31) + ((o - 64) >> 5)); }
struct TileDesc { const float* src; bf16_t* dst; int ldn, nvalid, K, n0, k0, mode, ebase; };
__device__ __forceinline__ void tile_decode(const Frame& F, int q, TileDesc& d) {
    const int l = q / 752; q %= 752;
    if (q < 480) { d.src = F.in[6] + (size_t)l * DM * NIN; d.ldn = NIN; d.nvalid = NIN; d.K = DM; d.n0 = (q >> 3) * 64; d.k0 = (q & 7) * 256; d.dst = WSP(bf16_t, WS_WIN) + (size_t)l * NINP * DM; d.mode = 1; d.ebase = 0; }
    else if (q < 736) { q -= 480; d.src = F.in[21] + (size_t)l * DM * DM; d.ldn = DM; d.nvalid = DM; d.K = DM; d.n0 = (q >> 3) * 64; d.k0 = (q & 7) * 256; d.dst = WSP(bf16_t, WS_WOUT) + (size_t)l * DM * DM; d.mode = 0; d.ebase = 0; }
    else { q -= 736; d.src = F.in[16] + (size_t)l * 512 * 512; d.ldn = 512; d.nvalid = 512; d.K = 512; d.n0 = (q >> 1) * 64; d.k0 = (q & 1) * 256; d.dst = WSP(bf16_t, WS_WGLU) + (size_t)l * 512 * 512; d.mode = 0; d.ebase = 0; }
}
__device__ __forceinline__ void tile_load(const Frame& F, const TileDesc& d, f32x4 (&v)[8]) {
    const int kk = F.tid >> 4, n4 = (F.tid & 15) * 4;
#pragma unroll
    for (int i = 0; i < 8; ++i) { v[i] = (f32x4){0.f, 0.f, 0.f, 0.f}; if (d.n0 + n4 < d.nvalid) v[i] = *(const f32x4*)(d.src + (size_t)(d.k0 + kk + 32 * i) * d.ldn + d.n0 + n4); }
}
__device__ __forceinline__ void tile_to_lds(const Frame& F, const f32x4 (&v)[8]) {
    LAS float* tile = (LAS float*)F.lds; const int kk = F.tid >> 4, n4 = (F.tid & 15) * 4;
#pragma unroll
    for (int i = 0; i < 8; ++i) { const int k = kk + 32 * i; tile[k * 65 + n4 + 0] = v[i][0]; tile[k * 65 + n4 + 1] = v[i][1]; tile[k * 65 + n4 + 2] = v[i][2]; tile[k * 65 + n4 + 3] = v[i][3]; }
}
__device__ __forceinline__ void tile_store(const Frame& F, const TileDesc& d) {
    LAS float* tile = (LAS float*)F.lds; const int t = F.tid; const int n = t >> 3; const int ng = d.n0 + n; int drow;
    if (d.mode == 0) drow = ng;
    else if (d.mode == 1) { if (ng < 1280) drow = (ng & ~127) + rope_perm(ng & 127); else drow = ng; }
    else drow = d.ebase + (ng >> 7) * 256 + (ng & 127);
#pragma unroll
    for (int q = 0; q < 4; ++q) { const int k8 = (t & 7) * 8 + 64 * q; float v[8];
#pragma unroll
        for (int jj = 0; jj < 8; ++jj) v[jj] = tile[(k8 + jj) * 65 + n];
        u32x4 w; w.x = cvt_pk_bf16(v[0], v[1]); w.y = cvt_pk_bf16(v[2], v[3]); w.z = cvt_pk_bf16(v[4], v[5]); w.w = cvt_pk_bf16(v[6], v[7]);
        *(u32x4*)(d.dst + (size_t)drow * d.K + d.k0 + k8) = w; }
}
__device__ __forceinline__ void mod_partial(const Frame& F, int item) {
    const int l = item / 192, rem = item % 192, ks = rem / 6, cb = rem % 6;
    LAS float* sv = (LAS float*)F.lds;
    if (F.tid < 320) { const int r = F.tid >> 6, k = F.tid & 63; const float c = (r < 4) ? F.in[1][r * DM + ks * 64 + k] : F.in[3][ks * 64 + k]; sv[F.tid] = siluf_(c); }
    __syncthreads();
    const int col = cb * 2048 + F.tid * 4;
    const float* w = F.in[4] + (size_t)l * DM * 12288 + (size_t)(ks * 64) * 12288 + col;
    f32x4 a0 = {0, 0, 0, 0}, a1 = a0, a2 = a0, a3 = a0, a4 = a0;
#pragma unroll 4
    for (int k = 0; k < 64; ++k) { const f32x4 wv = *(const f32x4*)(w + (size_t)k * 12288);
        a0 += wv * sv[k]; a1 += wv * sv[64 + k]; a2 += wv * sv[128 + k]; a3 += wv * sv[192 + k]; a4 += wv * sv[256 + k]; }
    float* p = WSP(float, WS_MODP) + ((size_t)(l * 32 + ks) * 5) * 12288 + col;
    *(f32x4*)(p) = a0; *(f32x4*)(p + 12288) = a1; *(f32x4*)(p + 2 * 12288) = a2; *(f32x4*)(p + 3 * 12288) = a3; *(f32x4*)(p + 4 * 12288) = a4;
    __syncthreads();
}
__device__ __forceinline__ void rope_table(const Frame& F) {
    float* rp = WSP(float, WS_ROPE);
    for (int e = F.tid; e < 2048; e += NTHR) { const int pos = e >> 5, i = e & 31; const float inv = powf(10000.0f, -(float)i / 32.0f); const float ang = (float)pos * inv;
        rp[e * 2] = cosf(ang); rp[e * 2 + 1] = sinf(ang); }
}
__device__ __forceinline__ void s5_weights(const Frame& F, int l, int g, int hq) {
    LAS f32x2* pw = (LAS f32x2*)F.lds;
    LAS f32x2* bb = pw + 2 * 33 * 64;
    LAS f32x2* cc = bb + 2 * 64 * 16;
    LAS f32x2* cf = cc + 2 * 16 * 64;
    LAS float* Kt = (LAS float*)(cf + 128);
    const int t = F.tid;
    if (t < 128) { const int d = t >> 6, p = t & 63; const size_t ix = ((size_t)(l * 2 + d) * 32 + g) * 64 + p;
        const float lre = F.in[8][ix], lim = F.in[9][ix]; const float dt = expf(F.in[10][(l * 2 + d) * 32 + g]);
        const float ar = lre * dt, ai = lim * dt; const float mag = expf(ar); const float c = cosf(ai), s = sinf(ai); const f32x2 lb = {mag * c, mag * s};
        const float sh = sinf(0.5f * ai); const float nx = expm1f(ar) * c - 2.0f * sh * sh, ny = mag * s;
        const float den = lre * lre + lim * lim; cf[t] = (f32x2){(nx * lre + ny * lim) / den, (ny * lre - nx * lim) / den};
        f32x2 cur = {1.f, 0.f}; pw[(d * 33 + 0) * 64 + p] = cur;
        for (int k = 1; k <= 32; ++k) { const f32x2 nx2 = {cur.x * lb.x - cur.y * lb.y, cur.x * lb.y + cur.y * lb.x}; cur = nx2; pw[(d * 33 + k) * 64 + p] = cur; }
        if (hq == 0) WSP(f32x2, WS_LAMT)[((size_t)(l * 32 + g) * 2 + d) * 64 + p] = cur; }
    for (int e = t; e < 2048; e += NTHR) { const int d = e >> 10, h = (e >> 6) & 15, p = e & 63;
        const size_t ic = (((size_t)(l * 2 + d) * 32 + g) * 16 + h) * 64 + p; cc[(d * 16 + h) * 64 + p] = (f32x2){F.in[13][ic], F.in[14][ic]}; }
    __syncthreads();
    for (int e = t; e < 2048; e += NTHR) { const int d = e >> 10, p = (e >> 4) & 63, h = e & 15;
        const size_t ib = (((size_t)(l * 2 + d) * 32 + g) * 64 + p) * 16 + h; const float br = F.in[11][ib], bi = F.in[12][ib]; const f32x2 c = cf[d * 64 + p];
        bb[(d * 64 + p) * 16 + h] = (f32x2){c.x * br - c.y * bi, c.x * bi + c.y * br}; }
    __syncthreads();
    for (int e = t; e < 4096; e += NTHR) { const int d = e >> 11, j = (e >> 6) & 31, hp = 4 * hq + ((e >> 4) & 3), h = e & 15; float acc = 0.f;
#pragma unroll 4
        for (int p = 0; p < 64; ++p) { const f32x2 c = cc[(d * 16 + hp) * 64 + p], w = pw[(d * 33 + j) * 64 + p], b = bb[(d * 64 + p) * 16 + h];
            const float tx = c.x * w.x - c.y * w.y, ty = c.x * w.y + c.y * w.x; acc += tx * b.x - ty * b.y; }
        Kt[((d * 32 + j) * 16 + hp) * 16 + h] = acc; }
    __syncthreads();
    bf16_t* Wa = WSP(bf16_t, WS_S5A) + (size_t)(l * 32 + g) * 256 * 512;
    for (int e = hq * 16384 + t; e < (hq + 1) * 16384; e += NTHR) { const int p2 = e * 2, j = p2 & 7, lane = (p2 >> 3) & 63, f = p2 >> 9, ntile = f >> 4, ks = f & 15; const int n = ntile * 16 + (lane & 15), k2 = ks * 32 + (lane >> 4) * 8 + j;
        const int d = n >> 7, p = (n >> 1) & 63, c = n & 1; const int s = k2 >> 4, h = k2 & 15;
        const f32x2 w = pw[(d * 33 + (d == 0 ? 31 - s : s)) * 64 + p]; const f32x2 b0 = bb[(d * 64 + p) * 16 + h], b1 = bb[(d * 64 + p) * 16 + h + 1];
        const float v0 = c == 0 ? (w.x * b0.x - w.y * b0.y) : (w.x * b0.y + w.y * b0.x), v1 = c == 0 ? (w.x * b1.x - w.y * b1.y) : (w.x * b1.y + w.y * b1.x);
        *(unsigned*)(Wa + p2) = cvt_pk_bf16(v0, v1); }
    bf16_t* Wc = WSP(bf16_t, WS_S5C) + (size_t)(l * 32 + g) * 512 * 768;
    for (int e = t; e < 768 * 64; e += NTHR) { const int jp = e & 3, il = (e >> 2) & 3, g4 = (e >> 4) & 3, f = e >> 6; const int lane = g4 * 16 + 4 * hq + il, j = 2 * jp, p2 = (f * 64 + lane) * 8 + j, ntile = f / 24, ks = f % 24;
        const int n = ntile * 16 + (lane & 15), k2 = ks * 32 + g4 * 8 + j;
        const int tt = n >> 4, hp = n & 15; float v0, v1;
        if (k2 < 512) { const int s = k2 >> 4, h = k2 & 15; v0 = 0.f; v1 = 0.f;
            if (s <= tt) { v0 += Kt[((0 * 32 + (tt - s)) * 16 + hp) * 16 + h]; v1 += Kt[((0 * 32 + (tt - s)) * 16 + hp) * 16 + h + 1]; }
            if (s >= tt) { v0 += Kt[((1 * 32 + (s - tt)) * 16 + hp) * 16 + h]; v1 += Kt[((1 * 32 + (s - tt)) * 16 + hp) * 16 + h + 1]; } }
        else { const int d = (k2 - 512) >> 7, p = ((k2 - 512) >> 1) & 63; const f32x2 c = cc[(d * 16 + hp) * 64 + p], w = pw[(d * 33 + (d == 0 ? tt + 1 : 32 - tt)) * 64 + p];
            v0 = c.x * w.x - c.y * w.y; v1 = -(c.x * w.y + c.y * w.x); }
        *(unsigned*)(Wc + p2) = cvt_pk_bf16(v0, v1); }
    __syncthreads();
}
__device__ __forceinline__ void phase_prologue(const Frame& F) {
    int it = F.bid;
    for (; it < 256; it += F.G) s5_weights(F, it >> 7, (it >> 2) & 31, it & 3);
    for (; it < 256 + 384; it += F.G) mod_partial(F, it - 256);
    if (it == 640) { rope_table(F); it += F.G; }
    const int NT_ALL = 2 * 752;
    int q = it - 641;
    if (q < NT_ALL) {
        TileDesc d0, d1; f32x4 v0[8], v1[8];
        tile_decode(F, q, d0); tile_load(F, d0, v0);
        bool has1 = (q + F.G) < NT_ALL; d1 = d0; if (has1) { tile_decode(F, q + F.G, d1); tile_load(F, d1, v1); }
        for (;;) {
            tile_to_lds(F, v0); __syncthreads();
            const TileDesc c0 = d0; const bool has2 = (q + 2 * F.G) < NT_ALL;
            if (has2) { tile_decode(F, q + 2 * F.G, d0); tile_load(F, d0, v0); }
            tile_store(F, c0); __syncthreads();
            if (!has1) break;
            tile_to_lds(F, v1); __syncthreads();
            const TileDesc c1 = d1; const bool has3 = (q + 3 * F.G) < NT_ALL;
            if (has3) { tile_decode(F, q + 3 * F.G, d1); tile_load(F, d1, v1); }
            tile_store(F, c1); __syncthreads();
            if (!has2) break;
            q += 2 * F.G; has1 = has3;
        }
    }
}
__device__ __forceinline__ void phase_mod_reduce(const Frame& F) {
    for (int e = F.bid * NTHR + F.tid; e < 2 * 5 * 12288; e += F.G * NTHR) { const int l = e / 61440, rem = e % 61440, col = rem % 12288;
        float s = F.in[5][l * 12288 + col]; const float* p = WSP(float, WS_MODP) + (size_t)l * 32 * 61440 + rem;
        float pv[32];
#pragma unroll
        for (int ks = 0; ks < 32; ++ks) pv[ks] = p[(size_t)ks * 61440];
#pragma unroll
        for (int ks = 0; ks < 32; ++ks) s += pv[ks];
        WSP(float, WS_MOD)[e] = s; }
}
__device__ __forceinline__ void row_stats(const float (&v)[32], float& mu, float& rstd) {
    float s = 0.f;
#pragma unroll
    for (int i = 0; i < 32; ++i) s += v[i];
    mu = wave_sum(s) * (1.0f / 2048.0f); float q = 0.f;
#pragma unroll
    for (int i = 0; i < 32; ++i) { const float d = v[i] - mu; q += d * d; }
    rstd = rsqrtf(wave_sum(q) * (1.0f / 2048.0f) + LN_EPS);
}
__device__ __forceinline__ void load_row32(const float* p, int lane, float (&v)[32]) {
#pragma unroll
    for (int i = 0; i < 8; ++i) { const f32x4 t = *(const f32x4*)(p + (i * 64 + lane) * 4); v[i * 4] = t[0]; v[i * 4 + 1] = t[1]; v[i * 4 + 2] = t[2]; v[i * 4 + 3] = t[3]; }
}
__device__ __forceinline__ void mod_store_bf16(const float (&v)[32], float mu, float rstd, const float* sh, const float* sc, bf16_t* dst, int lane) {
#pragma unroll
    for (int i = 0; i < 8; ++i) { const int c = (i * 64 + lane) * 4; const f32x4 a = *(const f32x4*)(sc + c), b = *(const f32x4*)(sh + c);
        const float o0 = (v[i * 4] - mu) * rstd * (1.f + a[0]) + b[0], o1 = (v[i * 4 + 1] - mu) * rstd * (1.f + a[1]) + b[1], o2 = (v[i * 4 + 2] - mu) * rstd * (1.f + a[2]) + b[2], o3 = (v[i * 4 + 3] - mu) * rstd * (1.f + a[3]) + b[3];
        u32x2 w; w.x = cvt_pk_bf16(o0, o1); w.y = cvt_pk_bf16(o2, o3); *(u32x2*)(dst + c) = w; }
}
#define ROWMAP_NTRIP(nrows) (F.G == 256 ? ((nrows) > NLAT ? 9 : 8) : ((nrows) + F.G * 8 - 1) / (F.G * 8))
#define ROWMAP_ROW(k, nrows) (F.G == 256 ? ((k) < 8 ? F.bid * 64 + (k) * 8 + F.wave : (F.wave < 4 ? NLAT + F.bid * 4 + F.wave : -1)) : ((F.bid * 8 + F.wave + (k) * F.G * 8) < (nrows) ? (F.bid * 8 + F.wave + (k) * F.G * 8) : -1))
#define ROWMAP_BATCH(k) (F.G == 256 ? ((k) < 8 ? (F.bid >> 6) : 4) : ((F.bid * 8 + (k) * F.G * 8) < NLAT ? ((F.bid * 8 + (k) * F.G * 8) >> 12) : 4))
__device__ __forceinline__ void phase_ln1_first(const Frame& F) {
    const float* mod = WSP(float, WS_MOD);
    LAS float* Vsh = (LAS float*)F.lds; LAS float* Vsc = Vsh + 2048; int bcur = -1;
    const int ntrip = ROWMAP_NTRIP(MT);
    for (int k = 0; k < ntrip; ++k) { const int row = ROWMAP_ROW(k, MT), b = ROWMAP_BATCH(k); const bool rv = row >= 0; const int rowc = rv ? row : 0;
        const float* xr = rowc < NLAT ? F.in[0] + (size_t)rowc * DM : F.in[2] + (size_t)(rowc - NLAT) * DM;
        float v[32]; load_row32(xr, F.lane, v);
        if (b != bcur) { bcur = b; __syncthreads(); { const int c0 = F.tid * 4; *(LAS f32x4*)(Vsh + c0) = *(const f32x4*)(mod + (size_t)b * 12288 + c0); *(LAS f32x4*)(Vsc + c0) = *(const f32x4*)(mod + (size_t)b * 12288 + 2048 + c0); } __syncthreads(); }
        float mu, rstd; row_stats(v, mu, rstd);
        bf16_t* dst = WSP(bf16_t, WS_H) + (size_t)rowc * DM;
        if (rv)
#pragma unroll
        for (int i = 0; i < 8; ++i) { const int c = (i * 64 + F.lane) * 4; const f32x4 a = *(const LAS f32x4*)(Vsc + c), bq = *(const LAS f32x4*)(Vsh + c);
            const float o0 = (v[i * 4] - mu) * rstd * (1.f + a[0]) + bq[0], o1 = (v[i * 4 + 1] - mu) * rstd * (1.f + a[1]) + bq[1], o2 = (v[i * 4 + 2] - mu) * rstd * (1.f + a[2]) + bq[2], o3 = (v[i * 4 + 3] - mu) * rstd * (1.f + a[3]) + bq[3];
            u32x2 w; w.x = cvt_pk_bf16(o0, o1); w.y = cvt_pk_bf16(o2, o3); *(u32x2*)(dst + c) = w; }
    }
    __syncthreads();
}

template <int OFF0> __device__ __forceinline__ void tr_read16_attn(unsigned base, bf16x8 (&vf)[8]) {
    s16x4 r0, r1, r2, r3, r4, r5, r6, r7, r8, r9, r10, r11, r12, r13, r14, r15;
    asm volatile("ds_read_b64_tr_b16 %0, %16 offset:%c17+0\n\t"
        "ds_read_b64_tr_b16 %1, %16 offset:%c17+4352\n\t"
        "ds_read_b64_tr_b16 %2, %16 offset:%c17+32\n\t"
        "ds_read_b64_tr_b16 %3, %16 offset:%c17+4384\n\t"
        "ds_read_b64_tr_b16 %4, %16 offset:%c17+64\n\t"
        "ds_read_b64_tr_b16 %5, %16 offset:%c17+4416\n\t"
        "ds_read_b64_tr_b16 %6, %16 offset:%c17+96\n\t"
        "ds_read_b64_tr_b16 %7, %16 offset:%c17+4448\n\t"
        "ds_read_b64_tr_b16 %8, %16 offset:%c17+128\n\t"
        "ds_read_b64_tr_b16 %9, %16 offset:%c17+4480\n\t"
        "ds_read_b64_tr_b16 %10, %16 offset:%c17+160\n\t"
        "ds_read_b64_tr_b16 %11, %16 offset:%c17+4512\n\t"
        "ds_read_b64_tr_b16 %12, %16 offset:%c17+192\n\t"
        "ds_read_b64_tr_b16 %13, %16 offset:%c17+4544\n\t"
        "ds_read_b64_tr_b16 %14, %16 offset:%c17+224\n\t"
        "ds_read_b64_tr_b16 %15, %16 offset:%c17+4576\n\t"
        "s_waitcnt lgkmcnt(0)"
        : "=&v"(r0), "=&v"(r1), "=&v"(r2), "=&v"(r3), "=&v"(r4), "=&v"(r5), "=&v"(r6), "=&v"(r7), "=&v"(r8), "=&v"(r9), "=&v"(r10), "=&v"(r11), "=&v"(r12), "=&v"(r13), "=&v"(r14), "=&v"(r15) : "v"(base), "i"(OFF0) : "memory");
    vf[0] = (bf16x8){r0[0], r0[1], r0[2], r0[3], r1[0], r1[1], r1[2], r1[3]};
    vf[1] = (bf16x8){r2[0], r2[1], r2[2], r2[3], r3[0], r3[1], r3[2], r3[3]};
    vf[2] = (bf16x8){r4[0], r4[1], r4[2], r4[3], r5[0], r5[1], r5[2], r5[3]};
    vf[3] = (bf16x8){r6[0], r6[1], r6[2], r6[3], r7[0], r7[1], r7[2], r7[3]};
    vf[4] = (bf16x8){r8[0], r8[1], r8[2], r8[3], r9[0], r9[1], r9[2], r9[3]};
    vf[5] = (bf16x8){r10[0], r10[1], r10[2], r10[3], r11[0], r11[1], r11[2], r11[3]};
    vf[6] = (bf16x8){r12[0], r12[1], r12[2], r12[3], r13[0], r13[1], r13[2], r13[3]};
    vf[7] = (bf16x8){r14[0], r14[1], r14[2], r14[3], r15[0], r15[1], r15[2], r15[3]};
}
template <int OFF0> __device__ __forceinline__ void tr_read16_kdec(unsigned base, bf16x8 (&vf)[8]) {
    s16x4 r0, r1, r2, r3, r4, r5, r6, r7, r8, r9, r10, r11, r12, r13, r14, r15;
    asm volatile("ds_read_b64_tr_b16 %0, %16 offset:%c17+0\n\t"
        "ds_read_b64_tr_b16 %1, %16 offset:%c17+576\n\t"
        "ds_read_b64_tr_b16 %2, %16 offset:%c17+32\n\t"
        "ds_read_b64_tr_b16 %3, %16 offset:%c17+608\n\t"
        "ds_read_b64_tr_b16 %4, %16 offset:%c17+64\n\t"
        "ds_read_b64_tr_b16 %5, %16 offset:%c17+640\n\t"
        "ds_read_b64_tr_b16 %6, %16 offset:%c17+96\n\t"
        "ds_read_b64_tr_b16 %7, %16 offset:%c17+672\n\t"
        "ds_read_b64_tr_b16 %8, %16 offset:%c17+4608\n\t"
        "ds_read_b64_tr_b16 %9, %16 offset:%c17+5184\n\t"
        "ds_read_b64_tr_b16 %10, %16 offset:%c17+4640\n\t"
        "ds_read_b64_tr_b16 %11, %16 offset:%c17+5216\n\t"
        "ds_read_b64_tr_b16 %12, %16 offset:%c17+4672\n\t"
        "ds_read_b64_tr_b16 %13, %16 offset:%c17+5248\n\t"
        "ds_read_b64_tr_b16 %14, %16 offset:%c17+4704\n\t"
        "ds_read_b64_tr_b16 %15, %16 offset:%c17+5280\n\t"
        "s_waitcnt lgkmcnt(0)"
        : "=&v"(r0), "=&v"(r1), "=&v"(r2), "=&v"(r3), "=&v"(r4), "=&v"(r5), "=&v"(r6), "=&v"(r7), "=&v"(r8), "=&v"(r9), "=&v"(r10), "=&v"(r11), "=&v"(r12), "=&v"(r13), "=&v"(r14), "=&v"(r15) : "v"(base), "i"(OFF0) : "memory");
    vf[0] = (bf16x8){r0[0], r0[1], r0[2], r0[3], r1[0], r1[1], r1[2], r1[3]};
    vf[1] = (bf16x8){r2[0], r2[1], r2[2], r2[3], r3[0], r3[1], r3[2], r3[3]};
    vf[2] = (bf16x8){r4[0], r4[1], r4[2], r4[3], r5[0], r5[1], r5[2], r5[3]};
    vf[3] = (bf16x8){r6[0], r6[1], r6[2], r6[3], r7[0], r7[1], r7[2], r7[3]};
    vf[4] = (bf16x8){r8[0], r8[1], r8[2], r8[3], r9[0], r9[1], r9[2], r9[3]};
    vf[5] = (bf16x8){r10[0], r10[1], r10[2], r10[3], r11[0], r11[1], r11[2], r11[3]};
    vf[6] = (bf16x8){r12[0], r12[1], r12[2], r12[3], r13[0], r13[1], r13[2], r13[3]};
    vf[7] = (bf16x8){r14[0], r14[1], r14[2], r14[3], r15[0], r15[1], r15[2], r15[3]};
}
template <int OFF0> __device__ __forceinline__ void tr_read16_glav(unsigned base, bf16x8 (&vf)[8]) {
    s16x4 r0, r1, r2, r3, r4, r5, r6, r7, r8, r9, r10, r11, r12, r13, r14, r15;
    asm volatile("ds_read_b64_tr_b16 %0, %16 offset:%c17+0\n\t"
        "ds_read_b64_tr_b16 %1, %16 offset:%c17+4352\n\t"
        "ds_read_b64_tr_b16 %2, %16 offset:%c17+32\n\t"
        "ds_read_b64_tr_b16 %3, %16 offset:%c17+4384\n\t"
        "ds_read_b64_tr_b16 %4, %16 offset:%c17+64\n\t"
        "ds_read_b64_tr_b16 %5, %16 offset:%c17+4416\n\t"
        "ds_read_b64_tr_b16 %6, %16 offset:%c17+96\n\t"
        "ds_read_b64_tr_b16 %7, %16 offset:%c17+4448\n\t"
        "ds_read_b64_tr_b16 %8, %16 offset:%c17+8704\n\t"
        "ds_read_b64_tr_b16 %9, %16 offset:%c17+13056\n\t"
        "ds_read_b64_tr_b16 %10, %16 offset:%c17+8736\n\t"
        "ds_read_b64_tr_b16 %11, %16 offset:%c17+13088\n\t"
        "ds_read_b64_tr_b16 %12, %16 offset:%c17+8768\n\t"
        "ds_read_b64_tr_b16 %13, %16 offset:%c17+13120\n\t"
        "ds_read_b64_tr_b16 %14, %16 offset:%c17+8800\n\t"
        "ds_read_b64_tr_b16 %15, %16 offset:%c17+13152\n\t"
        "s_waitcnt lgkmcnt(0)"
        : "=&v"(r0), "=&v"(r1), "=&v"(r2), "=&v"(r3), "=&v"(r4), "=&v"(r5), "=&v"(r6), "=&v"(r7), "=&v"(r8), "=&v"(r9), "=&v"(r10), "=&v"(r11), "=&v"(r12), "=&v"(r13), "=&v"(r14), "=&v"(r15) : "v"(base), "i"(OFF0) : "memory");
    vf[0] = (bf16x8){r0[0], r0[1], r0[2], r0[3], r1[0], r1[1], r1[2], r1[3]};
    vf[1] = (bf16x8){r2[0], r2[1], r2[2], r2[3], r3[0], r3[1], r3[2], r3[3]};
    vf[2] = (bf16x8){r4[0], r4[1], r4[2], r4[3], r5[0], r5[1], r5[2], r5[3]};
    vf[3] = (bf16x8){r6[0], r6[1], r6[2], r6[3], r7[0], r7[1], r7[2], r7[3]};
    vf[4] = (bf16x8){r8[0], r8[1], r8[2], r8[3], r9[0], r9[1], r9[2], r9[3]};
    vf[5] = (bf16x8){r10[0], r10[1], r10[2], r10[3], r11[0], r11[1], r11[2], r11[3]};
    vf[6] = (bf16x8){r12[0], r12[1], r12[2], r12[3], r13[0], r13[1], r13[2], r13[3]};
    vf[7] = (bf16x8){r14[0], r14[1], r14[2], r14[3], r15[0], r15[1], r15[2], r15[3]};
}
template <int OFF0> __device__ __forceinline__ void tr_read8_attn(unsigned base, bf16x8 (&vf)[4]) {
    s16x4 r0, r1, r2, r3, r4, r5, r6, r7;
    asm volatile("ds_read_b64_tr_b16 %0, %8 offset:%c9+0\n\t"
        "ds_read_b64_tr_b16 %1, %8 offset:%c9+4352\n\t"
        "ds_read_b64_tr_b16 %2, %8 offset:%c9+32\n\t"
        "ds_read_b64_tr_b16 %3, %8 offset:%c9+4384\n\t"
        "ds_read_b64_tr_b16 %4, %8 offset:%c9+64\n\t"
        "ds_read_b64_tr_b16 %5, %8 offset:%c9+4416\n\t"
        "ds_read_b64_tr_b16 %6, %8 offset:%c9+96\n\t"
        "ds_read_b64_tr_b16 %7, %8 offset:%c9+4448\n\t"
        "s_waitcnt lgkmcnt(0)"
        : "=&v"(r0), "=&v"(r1), "=&v"(r2), "=&v"(r3), "=&v"(r4), "=&v"(r5), "=&v"(r6), "=&v"(r7) : "v"(base), "i"(OFF0) : "memory");
    vf[0] = (bf16x8){r0[0], r0[1], r0[2], r0[3], r1[0], r1[1], r1[2], r1[3]};
    vf[1] = (bf16x8){r2[0], r2[1], r2[2], r2[3], r3[0], r3[1], r3[2], r3[3]};
    vf[2] = (bf16x8){r4[0], r4[1], r4[2], r4[3], r5[0], r5[1], r5[2], r5[3]};
    vf[3] = (bf16x8){r6[0], r6[1], r6[2], r6[3], r7[0], r7[1], r7[2], r7[3]};
}
constexpr int AT_PITCH = 272;
constexpr int AT_TILE = 64 * AT_PITCH;
__device__ __forceinline__ void attn_item(const Frame& F, int l, int qrow0  , int qpos0  , int hp  , int b, int kc_lo, int nlat) {
    const bf16_t* __restrict__ proj = WSP(bf16_t, WS_R1); bf16_t* __restrict__ mix = WSP(bf16_t, WS_R3);
    const int lane = F.lane, i16 = lane & 15, g4 = lane >> 4, w = F.wave >> 1  , h = hp * 2 + (F.wave & 1), kvh = hp >> 1;
    LAS unsigned char* lds = F.lds;
    const int nchunk = nlat + 4;
    bf16x8 qf[2][4];
#pragma unroll
    for (int u = 0; u < 2; ++u) { const bf16_t* qp = proj + (size_t)(qrow0 + w * 32 + u * 16 + i16) * NINP + C_Q + h * 128 + 8 * g4;
#pragma unroll
        for (int ks = 0; ks < 4; ++ks) qf[u][ks] = *(const bf16x8*)(qp + ks * 32); }
    const float sink = F.in[7][l * 8 + h];
    const float SC = 0.08838834764831845f, C2 = SC * 1.4426950408889634f;
    float m_run[2] = {sink / SC, sink / SC}, l_run[2] = {(g4 == 0) ? 1.0f : 0.0f, (g4 == 0) ? 1.0f : 0.0f};
    f32x4 o[2][8];
#pragma unroll
    for (int u = 0; u < 2; ++u)
#pragma unroll
        for (int d = 0; d < 8; ++d) o[u][d] = (f32x4){0.f, 0.f, 0.f, 0.f};
    const int skey = F.tid >> 3, sseg = F.tid & 7;
    u32x4 rk0, rk1, rv0, rv1;
#define AT_CROW(c) (((c) < nlat) ? (b * SEQ + (kc_lo + (c)) * 64) : (NLAT + b * CTXL + ((c) - nlat) * 64))
#define AT_GLOAD(c) do { const bf16_t* kp_ = proj + (size_t)(AT_CROW(c) + skey) * NINP + C_K + kvh * 128 + sseg * 8; rk0 = *(const u32x4*)kp_; rk1 = *(const u32x4*)(kp_ + 64); rv0 = *(const u32x4*)(kp_ + 256); rv1 = *(const u32x4*)(kp_ + 256 + 64); } while (0)
#define AT_LSTORE(buf) do { LAS unsigned char* kb_ = lds + (buf) * 2 * AT_TILE + skey * AT_PITCH + sseg * 16; *(LAS u32x4*)kb_ = rk0; *(LAS u32x4*)(kb_ + 128) = rk1; *(LAS u32x4*)(kb_ + AT_TILE) = rv0; *(LAS u32x4*)(kb_ + AT_TILE + 128) = rv1; } while (0)
    AT_GLOAD(0); AT_LSTORE(0); __syncthreads();
    const int wq0 = qpos0 + w * 32;
    for (int c = 0; c < nchunk; ++c) {
        const int buf = c & 1;
        if (c + 1 < nchunk) AT_GLOAD(c + 1);
        const int k0 = (kc_lo + c) * 64; const bool lat = c < nlat;
        const bool skip = lat && (k0 > wq0 + 31 + 128 || k0 + 63 < wq0 - 128);
        const bool need_mask = lat && !(k0 >= wq0 + 31 - 128 && k0 + 63 <= wq0 + 128);
        if (!skip) {
        const LAS unsigned char* kb = lds + buf * 2 * AT_TILE; const LAS unsigned char* vb = kb + AT_TILE;
        f32x4 st[2][4];
#pragma unroll
        for (int kt = 0; kt < 4; ++kt) { st[0][kt] = (f32x4){0.f, 0.f, 0.f, 0.f}; st[1][kt] = (f32x4){0.f, 0.f, 0.f, 0.f};
#pragma unroll
            for (int ks = 0; ks < 4; ++ks) { const bf16x8 kf = *(const LAS bf16x8*)(kb + (kt * 16 + i16) * AT_PITCH + (ks * 32 + 8 * g4) * 2); st[0][kt] = MFMA16(kf, qf[0][ks], st[0][kt]); st[1][kt] = MFMA16(kf, qf[1][ks], st[1][kt]); } }
        if (need_mask) {
#pragma unroll
            for (int u = 0; u < 2; ++u) { const int qp = wq0 + u * 16 + i16; const int kp0 = k0 + 4 * g4;
#pragma unroll
                for (int kt = 0; kt < 4; ++kt)
#pragma unroll
                    for (int r = 0; r < 4; ++r) { const int dlt = qp - (kp0 + kt * 16 + r); if (dlt > 128 || dlt < -128) st[u][kt][r] = -1e30f; } } }
        bf16x8 pf[2][2];
#pragma unroll
        for (int u = 0; u < 2; ++u) {
            float mx = st[u][0][0];
#pragma unroll
            for (int kt = 0; kt < 4; ++kt)
#pragma unroll
                for (int r = 0; r < 4; ++r) mx = fmaxf(mx, st[u][kt][r]);
            mx = fmaxf(mx, shx<16>(mx)); mx = fmaxf(mx, shx<32>(mx));
            const float m_new = fmaxf(m_run[u], mx); const float alpha = __builtin_amdgcn_exp2f((m_run[u] - m_new) * C2); m_run[u] = m_new;
            const float mc = m_new * C2; float ps = 0.f;
#pragma unroll
            for (int kt = 0; kt < 4; ++kt)
#pragma unroll
                for (int r = 0; r < 4; ++r) { const float p = __builtin_amdgcn_exp2f(st[u][kt][r] * C2 - mc); st[u][kt][r] = p; ps += p; }
            l_run[u] = l_run[u] * alpha + ps;
            if (__any(alpha != 1.0f)) {
#pragma unroll
                for (int d = 0; d < 8; ++d) o[u][d] *= alpha; }
#pragma unroll
            for (int ks2 = 0; ks2 < 2; ++ks2) { u32x4 t4; t4.x = cvt_pk_bf16(st[u][2 * ks2][0], st[u][2 * ks2][1]); t4.y = cvt_pk_bf16(st[u][2 * ks2][2], st[u][2 * ks2][3]); t4.z = cvt_pk_bf16(st[u][2 * ks2 + 1][0], st[u][2 * ks2 + 1][1]); t4.w = cvt_pk_bf16(st[u][2 * ks2 + 1][2], st[u][2 * ks2 + 1][3]); pf[u][ks2] = __builtin_bit_cast(bf16x8, t4); }
        }
        const unsigned vaddr = lds_addr_of(vb) + (unsigned)((4 * g4 + (i16 >> 2)) * AT_PITCH + (4 * (i16 & 3)) * 2);
#pragma unroll
        for (int ks2 = 0; ks2 < 2; ++ks2) {
#pragma unroll
            for (int dh = 0; dh < 2; ++dh) { bf16x8 vf[4];
                if (ks2 == 0) { if (dh == 0) tr_read8_attn<0>(vaddr, vf); else tr_read8_attn<128>(vaddr, vf); } else { if (dh == 0) tr_read8_attn<32 * AT_PITCH>(vaddr, vf); else tr_read8_attn<32 * AT_PITCH + 128>(vaddr, vf); }
#pragma unroll
                for (int d = 0; d < 4; ++d) { o[0][dh * 4 + d] = MFMA16(vf[d], pf[0][ks2], o[0][dh * 4 + d]); o[1][dh * 4 + d] = MFMA16(vf[d], pf[1][ks2], o[1][dh * 4 + d]); } }
        }
        }
        if (c + 1 < nchunk) AT_LSTORE(buf ^ 1);
        __syncthreads();
    }
#undef AT_CROW
#undef AT_GLOAD
#undef AT_LSTORE
#pragma unroll
    for (int u = 0; u < 2; ++u) {
        float lr = l_run[u]; lr += shx<16>(lr); lr += shx<32>(lr);
        const float inv = 1.0f / lr;
        bf16_t* op = mix + (size_t)(qrow0 + w * 32 + u * 16 + i16) * DM + h * 128 + 4 * g4;
#pragma unroll
        for (int d = 0; d < 8; ++d) { u32x2 wv; wv.x = cvt_pk_bf16(o[u][d][0] * inv, o[u][d][1] * inv); wv.y = cvt_pk_bf16(o[u][d][2] * inv, o[u][d][3] * inv); *(u32x2*)(op + d * 16) = wv; } }
}
__device__ __forceinline__ void attn_items(const Frame& F, int l, int first, int stride) {
    const int nitem = 512 + (l == 0 ? 32 : 0);
    for (int it = first; it < nitem; it += stride) {
        if (it < 512) { const int hp = it & 3, qb = (it >> 2) & 31, b = it >> 7; const int kc_lo = qb > 0 ? qb * 2 - 2 : 0, kc_hi = qb < 31 ? qb * 2 + 3 : 63;
            attn_item(F, l, b * SEQ + qb * 128, qb * 128, hp, b, kc_lo, kc_hi - kc_lo + 1);
        } else { const int j = it - 512; const int hp = j & 3, half = (j >> 2) & 1, b = j >> 3;
            attn_item(F, l, NLAT + b * CTXL + half * 128, 0, hp, b, 0, 0); }
    }
}
constexpr int S5_APITCH = (768 + 8) * 2;
template <int NT, int KT, int MTL>
__device__ __forceinline__ void s5_mm(const LAS unsigned char* A, const bf16_t* __restrict__ Bt, int lane, int wave, f32x4 (&acc)[MTL][NT]) {
    const int i16 = lane & 15, g4 = lane >> 4;
#pragma unroll
    for (int m = 0; m < MTL; ++m)
#pragma unroll
        for (int n = 0; n < NT; ++n) acc[m][n] = (f32x4){0.f, 0.f, 0.f, 0.f};
    const bf16_t* bp = Bt + ((size_t)(wave * NT) * (KT / 32) * 64 + lane) * 8;
    const LAS unsigned char* ap = A + i16 * S5_APITCH + 16 * g4;
    constexpr int KB = (MTL >= 4 && NT >= 4) ? 1 : 4;
    for (int ks0 = 0; ks0 < KT / 32; ks0 += KB) {
        bf16x8 bf[KB][NT];
#pragma unroll
        for (int q = 0; q < KB; ++q)
#pragma unroll
            for (int n = 0; n < NT; ++n) bf[q][n] = *(const bf16x8*)(bp + (size_t)(n * (KT / 32) + ks0 + q) * 512);
#pragma unroll
        for (int q = 0; q < KB; ++q) {
#pragma unroll
            for (int m = 0; m < MTL; ++m) { const bf16x8 am = *(const LAS bf16x8*)(ap + m * 16 * S5_APITCH + (ks0 + q) * 64);
#pragma unroll
                for (int n = 0; n < NT; ++n) acc[m][n] = MFMA16(am, bf[q][n], acc[m][n]); } }
    }
}
__device__ __forceinline__ void s5a_items(const Frame& F, int l, int xcd, int first, int stride) {
    const bf16_t* __restrict__ su = WSP(bf16_t, WS_SU); float* __restrict__ S = WSP(float, WS_S5S);
    for (int li = first; li < (xcd < 0 ? 256 : 32); li += stride) { const int g = (xcd < 0) ? (li >> 3) : (xcd + 8 * (li >> 3)), rb = li & 7;
        __syncthreads();
        { u32x4 ta[10];
#pragma unroll
          for (int q = 0; q < 10; ++q) { const int e = F.tid + q * NTHR, r = e >> 6, sg = e & 63; ta[q] = *(const u32x4*)(su + ((size_t)g * MT + (size_t)(rb * 68 + r) * 32) * 16 + sg * 8); }
#pragma unroll
          for (int q = 0; q < 10; ++q) { const int e = F.tid + q * NTHR, r = e >> 6, sg = e & 63; *(LAS u32x4*)(F.lds + r * S5_APITCH + sg * 16) = ta[q]; } }
        __syncthreads();
        f32x4 acc[5][2]; s5_mm<2, 512, 5>(F.lds, WSP(bf16_t, WS_S5A) + (size_t)(l * 32 + g) * 256 * 512, F.lane, F.wave, acc);
        const int i16 = F.lane & 15, g4 = F.lane >> 4;
#pragma unroll
        for (int m = 0; m < 5; ++m)
#pragma unroll
            for (int r = 0; r < 4; ++r) { const int lr = m * 16 + 4 * g4 + r, cr = rb * 68 + lr; if (lr < 68) {
#pragma unroll
                for (int n = 0; n < 2; ++n) S[((size_t)cr * 32 + g) * 256 + F.wave * 32 + n * 16 + i16] = acc[m][n][r]; } }
    }
}
__device__ __forceinline__ void s5_scan(const Frame& F, int l, int first_thread, int nthreads) {
    const float* S = WSP(float, WS_S5S); bf16_t* SI = WSP(bf16_t, WS_S5IN);
    for (int e = first_thread; e < 4 * 32 * 128; e += nthreads) { const int p = e & 63, d = (e >> 6) & 1, g = (e >> 7) & 31, b = e >> 12;
        const f32x2 lt = WSP(f32x2, WS_LAMT)[((size_t)(l * 32 + g) * 2 + d) * 64 + p];
        float sx = 0.f, sy = 0.f; const size_t co = (size_t)g * 256 + d * 128 + p * 2;
#pragma unroll 8
        for (int i = 0; i < 136; ++i) { int r; if (i < 8) r = 512 + b * 8 + (d == 0 ? i : 7 - i); else r = b * 128 + (d == 0 ? (i - 8) : 127 - (i - 8));
            const f32x2 sv = *(const f32x2*)(S + (size_t)r * 8192 + co);
            *(unsigned*)(SI + (size_t)r * 8192 + co) = cvt_pk_bf16(sx, sy);
            const float nx = lt.x * sx - lt.y * sy + sv.x, ny = lt.x * sy + lt.y * sx + sv.y; sx = nx; sy = ny; }
    }
}
__device__ __forceinline__ void s5c_items(const Frame& F, int l, int xcd, int first, int stride) {
    const bf16_t* __restrict__ su = WSP(bf16_t, WS_SU); const bf16_t* __restrict__ SI = WSP(bf16_t, WS_S5IN); bf16_t* __restrict__ zb = WSP(bf16_t, WS_R3 + (size_t)MT * DM * 2);
    for (int li = first; li < (xcd < 0 ? 256 : 32); li += stride) { const int g = (xcd < 0) ? (li >> 3) : (xcd + 8 * (li >> 3)), rb = li & 7;
        __syncthreads();
#pragma unroll
        for (int hq = 0; hq < 2; ++hq) { u32x4 ta[5];
#pragma unroll
          for (int q = 0; q < 5; ++q) { const int e = F.tid + (hq * 5 + q) * NTHR, r = e >> 6, sg = e & 63; ta[q] = *(const u32x4*)(su + ((size_t)g * MT + (size_t)(rb * 68 + r) * 32) * 16 + sg * 8); }
#pragma unroll
          for (int q = 0; q < 5; ++q) { const int e = F.tid + (hq * 5 + q) * NTHR, r = e >> 6, sg = e & 63; *(LAS u32x4*)(F.lds + r * S5_APITCH + sg * 16) = ta[q]; } }
        { u32x4 tb[5];
#pragma unroll
          for (int q = 0; q < 5; ++q) { const int e = F.tid + q * NTHR, r = e >> 5, sg = e & 31; tb[q] = *(const u32x4*)(SI + ((size_t)(rb * 68 + r) * 32 + g) * 256 + sg * 8); }
#pragma unroll
          for (int q = 0; q < 5; ++q) { const int e = F.tid + q * NTHR, r = e >> 5, sg = e & 31; *(LAS u32x4*)(F.lds + r * S5_APITCH + 1024 + sg * 16) = tb[q]; } }
        __syncthreads();
        f32x4 acc[5][4]; s5_mm<4, 768, 5>(F.lds, WSP(bf16_t, WS_S5C) + (size_t)(l * 32 + g) * 512 * 768, F.lane, F.wave, acc);
        const int i16 = F.lane & 15, g4 = F.lane >> 4; const float dd = F.in[15][l * 512 + g * 16 + i16];
        __syncthreads();
#pragma unroll
        for (int m = 0; m < 5; ++m)
#pragma unroll
            for (int n = 0; n < 4; ++n)
#pragma unroll
                for (int r = 0; r < 4; ++r) { LAS bf16_t* up = (LAS bf16_t*)(F.lds + (m * 16 + 4 * g4 + r) * S5_APITCH) + (F.wave * 4 + n) * 16 + i16; *up = f2bf(gelu_tanh(acc[m][n][r] + dd * bf2f(*up))); }
        __syncthreads();
#pragma unroll
        for (int hq = 0; hq < 3; ++hq) { u32x4 tz[3];
#pragma unroll
          for (int q = 0; q < 3; ++q) { const int e = F.tid + (hq * 3 + q) * NTHR, r = e >> 6, sg = e & 63; tz[q] = *(const LAS u32x4*)(F.lds + r * S5_APITCH + sg * 16); }
#pragma unroll
          for (int q = 0; q < 3; ++q) { const int e = F.tid + (hq * 3 + q) * NTHR, r = e >> 6, sg = e & 63; if (r < 68) *(u32x4*)(zb + ((size_t)g * MT + (size_t)(rb * 68 + r) * 32) * 16 + sg * 8) = tz[q]; } }
    }
}
constexpr int GL_GB = 0  , GL_KD = 32768  , GL_VT = 51200  , GL_GZ = 68608  , GL_WG = 76800  ,
              GL_BL = 84992  , GL_TOT = 85504  ;
constexpr int G3_Q = 0  , G3_K = 18432, G3_V = 36864  , G3_S = 54272  , G3_SSQ = 91136  ;
constexpr int GL_P64 = 144, GL_P128 = 272;
__device__ __forceinline__ int gla_row0(int b, int j) { return j < 4 ? NLAT + b * CTXL + j * 64 : b * SEQ + (j - 4) * 64; }
__device__ __forceinline__ void gla1_items(const Frame& F, int l, int first, int stride) {
    const bf16_t* __restrict__ proj = WSP(bf16_t, WS_R1); float* __restrict__ upd = WSP(float, WS_R3 + (size_t)MT * DM * 2 + (size_t)MT * 512 * 2); float* __restrict__ dec = WSP(float, WS_GDEC);
    bf16_t* __restrict__ gqin = WSP(bf16_t, WS_GQIN); bf16_t* __restrict__ gkp = WSP(bf16_t, WS_GKP);
    LAS float* gb = (LAS float*)(F.lds + GL_GB); LAS float* gz = (LAS float*)(F.lds + GL_GZ); LAS float* wg = (LAS float*)(F.lds + GL_WG); LAS float* bl = (LAS float*)(F.lds + GL_BL); LAS float* tot = (LAS float*)(F.lds + GL_TOT);
    const int t = F.tid, tk = t >> 3, k0 = (t & 7) * 8;
    u32x2 gzr; u32x4 qv, kv, vv0, vv1; f32x4 wgr; f32x4 bg[2][2];
#define GL1_LOAD_A(IT) do { const int j_ = (IT) % 68, bh_ = (IT) / 68, h_ = bh_ & 3, b_ = bh_ >> 2; const bf16_t* rp_ = proj + (size_t)(gla_row0(b_, j_) + tk) * NINP; \
        gzr = *(const u32x2*)(rp_ + C_GZ + (t & 7) * 4); vv0 = *(const u32x4*)(rp_ + C_GV + h_ * 128 + (t & 7) * 8); vv1 = *(const u32x4*)(rp_ + C_GV + h_ * 128 + 64 + (t & 7) * 8); \
        { const int e4 = t * 4, d = e4 >> 10, r = (e4 >> 6) & 15, k = e4 & 63; wgr = *(const f32x4*)(F.in[18] + ((size_t)(l * 2 + d) * 16 + r) * 256 + h_ * 64 + k); } } while (0)
#define GL1_LOAD_B(IT) do { const int h_ = ((IT) / 68) & 3; _Pragma("unroll") for (int d = 0; d < 2; ++d) { bg[d][0] = *(const f32x4*)(F.in[19] + (l * 2 + d) * 256 + h_ * 64 + k0); bg[d][1] = *(const f32x4*)(F.in[19] + (l * 2 + d) * 256 + h_ * 64 + k0 + 4); } } while (0)
#define GL1_LOAD_C(IT) do { const int j_ = (IT) % 68, bh_ = (IT) / 68, h_ = bh_ & 3, b_ = bh_ >> 2; const bf16_t* rp_ = proj + (size_t)(gla_row0(b_, j_) + tk) * NINP; \
        qv = *(const u32x4*)(rp_ + C_GQ + h_ * 64 + k0); kv = *(const u32x4*)(rp_ + C_GK + h_ * 64 + k0); } while (0)
    if (first < 16 * 68) { GL1_LOAD_A(first); GL1_LOAD_B(first); GL1_LOAD_C(first); }
    for (int it = first; it < 16 * 68; it += stride) { const int j = it % 68, bh = it / 68, h = bh & 3, b = bh >> 2; const bool more = it + stride < 16 * 68;
        __syncthreads();
        { const int c0 = (t & 7) * 4; gz[tk * 32 + c0] = bflo(gzr.x); gz[tk * 32 + c0 + 1] = bfhi(gzr.x); gz[tk * 32 + c0 + 2] = bflo(gzr.y); gz[tk * 32 + c0 + 3] = bfhi(gzr.y); *(LAS f32x4*)(wg + t * 4) = wgr;
          *(LAS u32x4*)(F.lds + GL_VT + tk * GL_P128 + (t & 7) * 16) = vv0; *(LAS u32x4*)(F.lds + GL_VT + tk * GL_P128 + 128 + (t & 7) * 16) = vv1; }
        __syncthreads();
        if (more) GL1_LOAD_A(it + stride);
#pragma unroll
        for (int d = 0; d < 2; ++d) { float a[8] = {bg[d][0][0], bg[d][0][1], bg[d][0][2], bg[d][0][3], bg[d][1][0], bg[d][1][1], bg[d][1][2], bg[d][1][3]};
#pragma unroll
            for (int r = 0; r < 16; ++r) { const float zv = gz[tk * 32 + d * 16 + r]; const f32x4 w0 = *(const LAS f32x4*)(wg + (d * 16 + r) * 64 + k0), w1 = *(const LAS f32x4*)(wg + (d * 16 + r) * 64 + k0 + 4);
                a[0] += zv * w0[0]; a[1] += zv * w0[1]; a[2] += zv * w0[2]; a[3] += zv * w0[3]; a[4] += zv * w1[0]; a[5] += zv * w1[1]; a[6] += zv * w1[2]; a[7] += zv * w1[3]; }
#pragma unroll
            for (int q = 0; q < 8; ++q) gb[(d * 64 + tk) * 64 + k0 + q] = logsigmoidf_(a[q]) * (1.0f / 16.0f); }
        if (more) GL1_LOAD_B(it + stride);
        __syncthreads();
        { const int k = t & 63, seg = t >> 6; float vf[8], vb[8]; float rf = 0.f, rb = 0.f;
#pragma unroll
          for (int q = 0; q < 8; ++q) { rf += gb[(seg * 8 + q) * 64 + k]; vf[q] = rf; }
#pragma unroll
          for (int q = 7; q >= 0; --q) { rb += gb[(64 + seg * 8 + q) * 64 + k]; vb[q] = rb; }
          tot[seg * 64 + k] = rf; tot[512 + seg * 64 + k] = rb;
          __syncthreads();
          float pf = 0.f, pb = 0.f, af = 0.f, ab = 0.f;
#pragma unroll
          for (int s2 = 0; s2 < 8; ++s2) { const float x = tot[s2 * 64 + k], y = tot[512 + s2 * 64 + k]; af += x; ab += y; if (s2 < seg) pf += x; if (s2 > seg) pb += y; }
#pragma unroll
          for (int q = 0; q < 8; ++q) { gb[(seg * 8 + q) * 64 + k] = vf[q] + pf; gb[(64 + seg * 8 + q) * 64 + k] = vb[q] + pb; }
          if (seg == 0) { bl[k] = af; bl[64 + k] = ab; } }
        __syncthreads();
        { const float qq[8] = {bflo(qv.x), bfhi(qv.x), bflo(qv.y), bfhi(qv.y), bflo(qv.z), bfhi(qv.z), bflo(qv.w), bfhi(qv.w)}, kk[8] = {bflo(kv.x), bfhi(kv.x), bflo(kv.y), bfhi(kv.y), bflo(kv.z), bfhi(kv.z), bflo(kv.w), bfhi(kv.w)};
#pragma unroll
          for (int d = 0; d < 2; ++d) { float qo[8], ko[8], kd[8];
#pragma unroll
              for (int q = 0; q < 8; ++q) { const float bv = gb[(d * 64 + tk) * 64 + k0 + q]; qo[q] = qq[q] * 0.125f * __expf(bv); ko[q] = kk[q] * __expf(-bv); kd[q] = kk[q] * __expf(bl[d * 64 + k0 + q] - bv); }
              const size_t go = ((size_t)(((b * 4 + h) * 2 + d) * 68 + j) * 64 + tk) * 64 + k0; u32x4 w;
              w.x = cvt_pk_bf16(qo[0], qo[1]); w.y = cvt_pk_bf16(qo[2], qo[3]); w.z = cvt_pk_bf16(qo[4], qo[5]); w.w = cvt_pk_bf16(qo[6], qo[7]); *(u32x4*)(gqin + go) = w;
              w.x = cvt_pk_bf16(ko[0], ko[1]); w.y = cvt_pk_bf16(ko[2], ko[3]); w.z = cvt_pk_bf16(ko[4], ko[5]); w.w = cvt_pk_bf16(ko[6], ko[7]); *(u32x4*)(gkp + go) = w;
              w.x = cvt_pk_bf16(kd[0], kd[1]); w.y = cvt_pk_bf16(kd[2], kd[3]); w.z = cvt_pk_bf16(kd[4], kd[5]); w.w = cvt_pk_bf16(kd[6], kd[7]); *(LAS u32x4*)(F.lds + GL_KD + (d * 64 + tk) * GL_P64 + k0 * 2) = w; }
          if (t < 128) dec[(size_t)((((b * 4 + h) * 2 + (t >> 6)) * 68) + j) * 64 + (t & 63)] = __expf(bl[t]); }
        if (more) GL1_LOAD_C(it + stride);
        __syncthreads();
        const int i16 = F.lane & 15, g4 = F.lane >> 4, w = F.wave;
        const unsigned va = lds_addr_of(F.lds + GL_VT) + (unsigned)((8 * g4 + (i16 >> 2)) * GL_P128 + (w * 16 + 4 * (i16 & 3)) * 2);
        const unsigned ka = lds_addr_of(F.lds + GL_KD) + (unsigned)((8 * g4 + (i16 >> 2)) * GL_P64 + (4 * (i16 & 3)) * 2);
        const bf16x8 af0 = tr_read2(va, va + 4 * GL_P128), af1 = tr_read2(va + 32 * GL_P128, va + 32 * GL_P128 + 4 * GL_P128);
#pragma unroll
        for (int d = 0; d < 2; ++d) { bf16x8 kf[8]; if (d == 0) tr_read16_kdec<0>(ka, kf); else tr_read16_kdec<64 * GL_P64>(ka, kf);
            float* up = upd + (size_t)((((b * 4 + h) * 2 + d) * 68) + j) * 8192;
#pragma unroll
            for (int kt = 0; kt < 4; ++kt) { f32x4 acc = (f32x4){0.f, 0.f, 0.f, 0.f}; acc = MFMA16(af0, kf[kt], acc); acc = MFMA16(af1, kf[4 + kt], acc);
#pragma unroll
                for (int r = 0; r < 4; ++r) up[(w * 16 + 4 * g4 + r) * 64 + kt * 16 + i16] = acc[r]; } }
    }
#undef GL1_LOAD_A
#undef GL1_LOAD_B
#undef GL1_LOAD_C
}
__device__ __forceinline__ void gla3_items(const Frame& F, int l, int first, int stride) {
    const bf16_t* __restrict__ proj = WSP(bf16_t, WS_R1); const bf16_t* __restrict__ gst = WSP(bf16_t, WS_GST); bf16_t* __restrict__ mix = WSP(bf16_t, WS_R3);
    const bf16_t* __restrict__ gqin = WSP(bf16_t, WS_GQIN); const bf16_t* __restrict__ gkp = WSP(bf16_t, WS_GKP);
    const int jlo = (l == 0) ? 0 : 4;
    const int nj = 68 - jlo; const int t = F.tid, tk = t >> 3, sg8 = t & 7;
    const int i16 = F.lane & 15, g4 = F.lane >> 4, w = F.wave, tt = w & 3, vh = w >> 2;
    u32x4 rq[2], rk[2], rs[2][2], rv[2];
#define GL3_LOAD(IT) do { const int j_ = jlo + (IT) % nj, bh_ = (IT) / nj, h_ = bh_ & 3, b_ = bh_ >> 2; const int row0_ = gla_row0(b_, j_); \
        _Pragma("unroll") for (int d = 0; d < 2; ++d) { const size_t cj = (size_t)(((b_ * 4 + h_) * 2 + d) * 68 + j_); rq[d] = *(const u32x4*)(gqin + (cj * 64 + tk) * 64 + sg8 * 8); rk[d] = *(const u32x4*)(gkp + (cj * 64 + tk) * 64 + sg8 * 8); \
            _Pragma("unroll") for (int q = 0; q < 2; ++q) { const int e = t + q * NTHR; rs[d][q] = *(const u32x4*)(gst + cj * 8192 + (size_t)(e >> 3) * 64 + (e & 7) * 8); } } \
        _Pragma("unroll") for (int q = 0; q < 2; ++q) rv[q] = *(const u32x4*)(proj + (size_t)(row0_ + tk) * NINP + C_GV + h_ * 128 + (sg8 + 8 * q) * 8); } while (0)
    if (first < 16 * nj) GL3_LOAD(first);
    for (int it = first; it < 16 * nj; it += stride) { const int j = jlo + it % nj, bh = it / nj, h = bh & 3, b = bh >> 2; const int row0 = gla_row0(b, j);
        const size_t orow = (size_t)(row0 + tt * 16 + i16);
        u32x2 rr[4]; f32x4 ng[4];
#pragma unroll
        for (int v4 = 0; v4 < 4; ++v4) { const int v = (vh * 4 + v4) * 16 + 4 * g4; rr[v4] = *(const u32x2*)(proj + orow * NINP + C_GR + h * 128 + v); ng[v4] = *(const f32x4*)(F.in[20] + l * 128 + v); }
        __syncthreads();
#pragma unroll
        for (int d = 0; d < 2; ++d) { *(LAS u32x4*)(F.lds + G3_Q + (d * 64 + tk) * GL_P64 + sg8 * 16) = rq[d]; *(LAS u32x4*)(F.lds + G3_K + (d * 64 + tk) * GL_P64 + sg8 * 16) = rk[d];
#pragma unroll
            for (int q = 0; q < 2; ++q) { const int e = t + q * NTHR; *(LAS u32x4*)(F.lds + G3_S + (d * 128 + (e >> 3)) * GL_P64 + (e & 7) * 16) = rs[d][q]; } }
#pragma unroll
        for (int q = 0; q < 2; ++q) *(LAS u32x4*)(F.lds + G3_V + tk * GL_P128 + (sg8 + 8 * q) * 16) = rv[q];
        __syncthreads();
        if (it + stride < 16 * nj) GL3_LOAD(it + stride);
        f32x4 o[4];
#pragma unroll
        for (int v4 = 0; v4 < 4; ++v4) o[v4] = (f32x4){0.f, 0.f, 0.f, 0.f};
        bf16x8 vf[8];
        tr_read16_glav<0>(lds_addr_of(F.lds + G3_V) + (unsigned)((4 * g4 + (i16 >> 2)) * GL_P128 + (vh * 64 + 4 * (i16 & 3)) * 2), vf);
#pragma unroll
        for (int d = 0; d < 2; ++d) {
            const LAS unsigned char* qb_ = F.lds + G3_Q + d * 64 * GL_P64; const LAS unsigned char* kb_ = F.lds + G3_K + d * 64 * GL_P64; const LAS unsigned char* sb_ = F.lds + G3_S + d * 128 * GL_P64;
            bf16x8 qf[2];
#pragma unroll
            for (int ks = 0; ks < 2; ++ks) qf[ks] = *(const LAS bf16x8*)(qb_ + (tt * 16 + i16) * GL_P64 + (ks * 32 + 8 * g4) * 2);
            f32x4 st[4];
#pragma unroll
            for (int s4 = 0; s4 < 4; ++s4) { st[s4] = (f32x4){0.f, 0.f, 0.f, 0.f};
#pragma unroll
                for (int ks = 0; ks < 2; ++ks) { const bf16x8 kf = *(const LAS bf16x8*)(kb_ + (s4 * 16 + i16) * GL_P64 + (ks * 32 + 8 * g4) * 2); st[s4] = MFMA16(kf, qf[ks], st[s4]); }
#pragma unroll
                for (int r = 0; r < 4; ++r) { const int s = s4 * 16 + 4 * g4 + r, tq = tt * 16 + i16; if (d == 0 ? (s > tq) : (s < tq)) st[s4][r] = 0.f; } }
#pragma unroll
            for (int ks2 = 0; ks2 < 2; ++ks2) {
                bf16x8 pf; { u32x4 t4; t4.x = cvt_pk_bf16(st[2 * ks2][0], st[2 * ks2][1]); t4.y = cvt_pk_bf16(st[2 * ks2][2], st[2 * ks2][3]); t4.z = cvt_pk_bf16(st[2 * ks2 + 1][0], st[2 * ks2 + 1][1]); t4.w = cvt_pk_bf16(st[2 * ks2 + 1][2], st[2 * ks2 + 1][3]); pf = __builtin_bit_cast(bf16x8, t4); }
#pragma unroll
                for (int v4 = 0; v4 < 4; ++v4) o[v4] = MFMA16(vf[ks2 * 4 + v4], pf, o[v4]);
            }
#pragma unroll
            for (int v4 = 0; v4 < 4; ++v4)
#pragma unroll
                for (int ks = 0; ks < 2; ++ks) { const bf16x8 sf = *(const LAS bf16x8*)(sb_ + ((vh * 4 + v4) * 16 + i16) * GL_P64 + (ks * 32 + 8 * g4) * 2); o[v4] = MFMA16(sf, qf[ks], o[v4]); }
        }
        float ss = 0.f;
#pragma unroll
        for (int v4 = 0; v4 < 4; ++v4)
#pragma unroll
            for (int r = 0; r < 4; ++r) ss += o[v4][r] * o[v4][r];
        ss += shx<16>(ss); ss += shx<32>(ss);
        LAS float* ssq = (LAS float*)(F.lds + G3_SSQ);
        if (g4 == 0) ssq[vh * 64 + tt * 16 + i16] = ss;
        __syncthreads();
        const float rinv = rsqrtf((ssq[tt * 16 + i16] + ssq[64 + tt * 16 + i16]) * (1.0f / 128.0f) + LN_EPS);
#pragma unroll
        for (int v4 = 0; v4 < 4; ++v4) { const int v = (vh * 4 + v4) * 16 + 4 * g4; const float r0 = bflo(rr[v4].x), r1 = bfhi(rr[v4].x), r2 = bflo(rr[v4].y), r3 = bfhi(rr[v4].y);
            u32x2 wv; wv.x = cvt_pk_bf16(o[v4][0] * rinv * ng[v4][0] * siluf_(r0), o[v4][1] * rinv * ng[v4][1] * siluf_(r1)); wv.y = cvt_pk_bf16(o[v4][2] * rinv * ng[v4][2] * siluf_(r2), o[v4][3] * rinv * ng[v4][3] * siluf_(r3));
            *(u32x2*)(mix + orow * DM + 1536 + h * 128 + v) = wv; }
    }
#undef GL3_LOAD
}
__device__ __forceinline__ void row_stats1(const float (&v)[32], float& mu, float& rstd) {
    float s = 0.f, q = 0.f;
#pragma unroll
    for (int i = 0; i < 32; ++i) { s += v[i]; q += v[i] * v[i]; }
    s = wave_sum_dpp(s); q = wave_sum_dpp(q);
    mu = s * (1.0f / 2048.0f); const float var = fmaxf(q * (1.0f / 2048.0f) - mu * mu, 0.f); rstd = rsqrtf(var + LN_EPS);
}
__device__ __forceinline__ void phase_ln_mid(const Frame& F, int l) {
    float alpha_ = ALPHA; asm volatile("" : "+v"(alpha_));
    const int nrows = (l == 0) ? MT : NLAT;
    const float* __restrict__ mod = WSP(float, WS_MOD) + (size_t)l * 5 * 12288; const bf16_t* __restrict__ Y = WSP(bf16_t, WS_R2);
    LAS float* Rt = (LAS float*)F.lds;
    { const float* __restrict__ rp = F.in[26] + (size_t)l * 2048 * 16; f32x4 rv[16];
#pragma unroll
      for (int q = 0; q < 16; ++q) rv[q] = *(const f32x4*)(rp + (size_t)(F.tid + NTHR * q) * 4);
#pragma unroll
      for (int q = 0; q < 16; ++q) { const int e4 = F.tid + NTHR * q, c = e4 >> 2, x4 = (e4 & 3) * 4; Rt[(x4 + 0) * 2048 + c] = rv[q][0]; Rt[(x4 + 1) * 2048 + c] = rv[q][1]; Rt[(x4 + 2) * 2048 + c] = rv[q][2]; Rt[(x4 + 3) * 2048 + c] = rv[q][3]; } }
    __syncthreads();
    const float* __restrict__ g1 = F.in[22] + l * DM; const float* __restrict__ b1 = F.in[23] + l * DM;
    bf16_t* __restrict__ X1 = WSP(bf16_t, WS_X1); bf16_t* __restrict__ H = WSP(bf16_t, WS_H);
#define LNM_XIN(r) ((r) < NLAT ? F.in[0] + (size_t)(r) * DM : F.in[2] + (size_t)((r) - NLAT) * DM)
#define LNM_XLOAD(r) do { if (l == 0) { const float* __restrict__ xin = LNM_XIN(r); _Pragma("unroll") for (int i = 0; i < 8; ++i) xa[i] = *(const f32x4*)(xin + (i * 64 + F.lane) * 4); } \
        else { const bf16_t* __restrict__ xin = WSP(bf16_t, WS_X2B) + (size_t)(r) * DM; _Pragma("unroll") for (int i = 0; i < 8; ++i) { const u32x2 t_ = *(const u32x2*)(xin + (i * 64 + F.lane) * 4); xa[i][0] = __uint_as_float(t_.x); xa[i][1] = __uint_as_float(t_.y); } } \
        _Pragma("unroll") for (int i = 0; i < 8; ++i) ya[i] = *(const u32x2*)(Y + (size_t)(r) * DM + (i * 64 + F.lane) * 4); } while (0)
    f32x4 xa[8]; u32x2 ya[8];
#pragma unroll
    for (int i = 0; i < 8; ++i) xa[i] = (f32x4){0.f, 0.f, 0.f, 0.f};
    const int ntrip = ROWMAP_NTRIP(nrows);
    { const int row = ROWMAP_ROW(0, nrows); if (row >= 0) LNM_XLOAD(row); }
    LAS float* Vgt1 = (LAS float*)(F.lds + 131072); LAS float* Vsc2 = Vgt1 + 2048; LAS float* Vsh2 = Vsc2 + 2048;
    int bcur = -1;
    for (int k = 0; k < ntrip; ++k) {
        const int row = ROWMAP_ROW(k, nrows), b = ROWMAP_BATCH(k);
        if (b != bcur) { bcur = b; __syncthreads();
            { const float* mb = mod + (size_t)b * 12288; const int c0 = F.tid * 4; *(LAS f32x4*)(Vgt1 + c0) = *(const f32x4*)(mb + 4096 + c0); *(LAS f32x4*)(Vsc2 + c0) = *(const f32x4*)(mb + 8192 + c0); *(LAS f32x4*)(Vsh2 + c0) = *(const f32x4*)(mb + 6144 + c0); }
            __syncthreads(); }
        float v[32];
        { f32x4 ga[8];
#pragma unroll
          for (int i = 0; i < 8; ++i) ga[i] = *(const LAS f32x4*)(Vgt1 + (i * 64 + F.lane) * 4);
#pragma unroll
          for (int i = 0; i < 8; ++i) { float x0 = xa[i][0], x1 = xa[i][1], x2 = xa[i][2], x3 = xa[i][3];
              if (l != 0) { const unsigned p0 = __float_as_uint(xa[i][0]), p1 = __float_as_uint(xa[i][1]); x0 = bflo(p0); x1 = bfhi(p0); x2 = bflo(p1); x3 = bfhi(p1); }
              v[i * 4] = alpha_ * x0 + ga[i][0] * bflo(ya[i].x); v[i * 4 + 1] = alpha_ * x1 + ga[i][1] * bfhi(ya[i].x); v[i * 4 + 2] = alpha_ * x2 + ga[i][2] * bflo(ya[i].y); v[i * 4 + 3] = alpha_ * x3 + ga[i][3] * bfhi(ya[i].y); } }
        { const int nrow = (k + 1 < ntrip) ? ROWMAP_ROW(k + 1, nrows) : -1; if (nrow >= 0) LNM_XLOAD(nrow); }
        if (row < 0) continue;
        f32x4 gg[8], bb[8];
#pragma unroll
        for (int i = 0; i < 8; ++i) { const int c0 = (i * 64 + F.lane) * 4; gg[i] = *(const f32x4*)(g1 + c0); bb[i] = *(const f32x4*)(b1 + c0); }
        float mu, rstd; row_stats1(v, mu, rstd);
#pragma unroll
        for (int i = 0; i < 8; ++i) { const int c0 = (i * 64 + F.lane) * 4; f32x4 o;
#pragma unroll
            for (int c = 0; c < 4; ++c) { o[c] = (v[i * 4 + c] - mu) * rstd * gg[i][c] + bb[i][c]; v[i * 4 + c] = o[c]; }
            u32x2 w1; w1.x = cvt_pk_bf16(o[0], o[1]); w1.y = cvt_pk_bf16(o[2], o[3]); *(u32x2*)(X1 + (size_t)row * DM + c0) = w1; }
#pragma unroll
        for (int i = 0; i < 8; ++i) { const int c0 = (i * 64 + F.lane) * 4; gg[i] = *(const LAS f32x4*)(Vsc2 + c0); bb[i] = *(const LAS f32x4*)(Vsh2 + c0); }
        row_stats1(v, mu, rstd);
#pragma unroll
        for (int i = 0; i < 8; ++i) { const int c0 = (i * 64 + F.lane) * 4;
#pragma unroll
            for (int c = 0; c < 4; ++c) v[i * 4 + c] = (v[i * 4 + c] - mu) * rstd * (1.f + gg[i][c]) + bb[i][c];
            u32x2 w; w.x = cvt_pk_bf16(v[i * 4], v[i * 4 + 1]); w.y = cvt_pk_bf16(v[i * 4 + 2], v[i * 4 + 3]); *(u32x2*)(H + (size_t)row * DM + c0) = w; }
        float s16[16];
#pragma unroll
        for (int x = 0; x < 16; ++x) { float s = 0.f;
#pragma unroll
            for (int i = 0; i < 8; ++i) { const f32x4 r = *(const LAS f32x4*)(Rt + x * 2048 + (i * 64 + F.lane) * 4); s += v[i * 4] * r[0] + v[i * 4 + 1] * r[1] + v[i * 4 + 2] * r[2] + v[i * 4 + 3] * r[3]; }
            s16[x] = s; if ((x & 3) == 3) __builtin_amdgcn_sched_barrier(0); }
        float t8[8], t4[4], t2[2], t1;
        { const bool hi = (F.lane & 32) != 0;
#pragma unroll
          for (int j = 0; j < 8; ++j) { const float send = hi ? s16[j] : s16[8 + j], keep = hi ? s16[8 + j] : s16[j]; t8[j] = keep + shx<32>(send); } }
        { const bool hi = (F.lane & 16) != 0;
#pragma unroll
          for (int j = 0; j < 4; ++j) { const float send = hi ? t8[j] : t8[4 + j], keep = hi ? t8[4 + j] : t8[j]; t4[j] = keep + shx<16>(send); } }
        { const bool hi = (F.lane & 8) != 0;
#pragma unroll
          for (int j = 0; j < 2; ++j) { const float send = hi ? t4[j] : t4[2 + j], keep = hi ? t4[2 + j] : t4[j]; t2[j] = keep + shx<8>(send); } }
        { const bool hi = (F.lane & 4) != 0; const float send = hi ? t2[0] : t2[1], keep = hi ? t2[1] : t2[0]; t1 = keep + shx<4>(send); }
        t1 += shx<2>(t1); t1 += shx<1>(t1);
        const int xid = ((F.lane >> 5) & 1) * 8 + ((F.lane >> 4) & 1) * 4 + ((F.lane >> 3) & 1) * 2 + ((F.lane >> 2) & 1);
        float mx = t1; mx = fmaxf(mx, shx<4>(mx)); mx = fmaxf(mx, shx<8>(mx)); mx = fmaxf(mx, shx<16>(mx)); mx = fmaxf(mx, shx<32>(mx));
        const float ex = __expf(t1 - mx); float sm = ex; sm += shx<4>(sm); sm += shx<8>(sm); sm += shx<16>(sm); sm += shx<32>(sm);
        if ((F.lane & 3) == 0) WSP(float, WS_AFF)[(size_t)row * 16 + xid] = ex / sm;
    }
#undef LNM_XIN
#undef LNM_XLOAD
    __syncthreads();
}
__device__ __forceinline__ void phase_topk(const Frame& F, int l) {
    LAS unsigned* keys = (LAS unsigned*)F.lds;
    LAS unsigned* hist = keys + 4096;
    LAS unsigned* misc = hist + 256;
    const float* aff = WSP(float, WS_AFF); int* tokslot = WSP(int, WS_TOKSLOT); int* seltok = WSP(int, WS_SELTOK); unsigned short* vt16 = WSP(unsigned short, WS_VT);
    const int nitem = (l == 0) ? 128 : 64;
    if (l == 0 && F.bid >= F.G - NE) { const int e = F.bid - (F.G - NE), kr2 = F.tid >> 5, c42 = F.tid & 31; *(unsigned*)(vt16 + ((e * 9 + 8) * 4096 + kr2 * 256 + 8 * (c42 ^ pg8::g8swz_(kr2))) / 2 + 2) = 0u; }
    for (int it = F.bid; it < nitem; it += F.G) { const int set = it >> 6, b = (it >> 4) & 3, e = it & 15;
        const int n = set == 0 ? SEQ : CTXL, cap = set == 0 ? 512 : 32, base = set == 0 ? b * SEQ : NLAT + b * CTXL;
        __syncthreads();
        for (int i = F.tid; i < n; i += NTHR) keys[i] = __float_as_uint(aff[(size_t)(base + i) * 16 + e]);
        if (F.tid == 0) { misc[0] = 0u; misc[1] = (unsigned)cap; }
        __syncthreads();
        for (int pass = 0; pass < 4; ++pass) { const int shift = 24 - 8 * pass; const unsigned himask = pass == 0 ? 0u : (0xffffffffu << (shift + 8));
            if (F.tid < 256) hist[F.tid] = 0u;
            __syncthreads();
            const unsigned prefix = misc[0];
            for (int i = F.tid; i < n; i += NTHR) { const unsigned k = keys[i]; if ((k & himask) == prefix) __hip_atomic_fetch_add(&hist[(k >> shift) & 255u], 1u, __ATOMIC_RELAXED, __HIP_MEMORY_SCOPE_WORKGROUP); }
            __syncthreads();
            { const unsigned rem = misc[1];
              unsigned hc = (F.tid < 256) ? hist[255 - F.tid] : 0u, inc = hc;
              for (int o = 1; o < 64; o <<= 1) { const unsigned a = __shfl_up(inc, o); if (F.lane >= o) inc += a; }
              if (F.lane == 63) misc[40 + F.wave] = inc;
              __syncthreads();
              unsigned off = 0; for (int w2 = 0; w2 < F.wave; ++w2) off += misc[40 + w2];
              inc += off;
              if (F.tid < 256 && inc >= rem && inc - hc < rem) { misc[0] = prefix | ((unsigned)(255 - F.tid) << shift); misc[1] = rem - (inc - hc); } }
            __syncthreads();
        }
        const unsigned thr = misc[0], take_eq = misc[1];
        const int per = n / NTHR; unsigned cg = 0, ce = 0;
        const int i0 = per ? F.tid * per : F.tid, cnt = per ? per : (F.tid < n ? 1 : 0);
        for (int q = 0; q < cnt; ++q) { const unsigned k = keys[i0 + q]; cg += (k > thr); ce += (k == thr); }
        unsigned sg = cg, se = ce;
        for (int o = 1; o < 64; o <<= 1) { const unsigned a = __shfl_up(sg, o), c2 = __shfl_up(se, o); if (F.lane >= o) { sg += a; se += c2; } }
        if (F.lane == 63) { misc[8 + F.wave] = sg; misc[24 + F.wave] = se; }
        __syncthreads();
        unsigned og = 0, oe = 0; for (int w2 = 0; w2 < F.wave; ++w2) { og += misc[8 + w2]; oe += misc[24 + w2]; }
        unsigned pg = og + sg - cg, pe = oe + se - ce;
        for (int q = 0; q < cnt; ++q) { const int i = i0 + q; const unsigned k = keys[i]; const bool sel = (k > thr) || (k == thr && pe < take_eq);
            const unsigned slot = pg + (pe < take_eq ? pe : take_eq);
            const int erow = set == 0 ? b * 512 + (int)slot : 2048 + b * 32 + (int)slot;
            tokslot[(size_t)(base + i) * 16 + e] = sel ? erow : -1;
            if (sel) { seltok[e * ER + erow] = base + i;
                const int pm = e * 9 + (erow >> 8), rr = erow & 255, R = rr & 63, sl = (rr >> 7) * 2 + ((rr >> 6) & 1);
#pragma unroll
                for (int q8 = 0; q8 < 8; ++q8) { const int t2 = ((R >> 4) * 2 + (q8 >> 2)) * 64 + (R & 15) * 4 + (q8 & 3), kr2 = t2 >> 5, c42 = t2 & 31;
                    vt16[(pm * 4096 + kr2 * 256 + 8 * (c42 ^ pg8::g8swz_(kr2))) / 2 + sl] = (unsigned short)(base + i); } }
            pg += (k > thr); pe += (k == thr); }
    }
    __syncthreads();
}
__device__ __forceinline__ void phase_gather(const Frame& F, int l) {
    const int valid = (l == 0) ? 2176 : 2048, rows = (l == 0) ? ER : 2048;
    const int* __restrict__ seltok = WSP(int, WS_SELTOK); const bf16_t* __restrict__ H = WSP(bf16_t, WS_H); bf16_t* __restrict__ xe = WSP(bf16_t, WS_R2);
    const int n = NE * rows, step = F.G * 8;
    for (int it = F.bid * 8 + F.wave; it < n; it += 4 * step) {
        int tok[4]; bf16_t* dst[4];
#pragma unroll
        for (int u = 0; u < 4; ++u) { const int i = it + u * step; tok[u] = -1; dst[u] = xe;
            if (i < n) { const int e = i / rows, r = i % rows; dst[u] = xe + (size_t)(e * ER + r) * DM; tok[u] = (r < valid) ? seltok[e * ER + r] : -2; } }
        u32x4 v[4][4];
#pragma unroll
        for (int u = 0; u < 4; ++u) { const bf16_t* src = H + (size_t)(tok[u] >= 0 ? tok[u] : 0) * DM;
#pragma unroll
            for (int q = 0; q < 4; ++q) v[u][q] = *(const u32x4*)(src + (q * 64 + F.lane) * 8); }
#pragma unroll
        for (int u = 0; u < 4; ++u) if (tok[u] != -1) {
#pragma unroll
            for (int q = 0; q < 4; ++q) *(u32x4*)(dst[u] + (q * 64 + F.lane) * 8) = (tok[u] >= 0) ? v[u][q] : (u32x4){0u, 0u, 0u, 0u}; }
    }
}
__device__ __forceinline__ void phase_combine(const Frame& F, int l) {
    float alpha_ = ALPHA; asm volatile("" : "+v"(alpha_));
    const int nrows = (l == 0) ? MT : NLAT;
    const float* mod = WSP(float, WS_MOD) + (size_t)l * 5 * 12288; const float* modn = WSP(float, WS_MOD) + (size_t)5 * 12288;
    const float* aff = WSP(float, WS_AFF); const int* tokslot = WSP(int, WS_TOKSLOT); const bf16_t* ye = WSP(bf16_t, WS_R3);
    const float* g2 = F.in[24] + l * DM; const float* b2 = F.in[25] + l * DM;
    LAS float* Vg2 = (LAS float*)F.lds; LAS float* Vb2 = Vg2 + 2048; LAS float* Vgt2 = Vb2 + 2048; LAS float* Vsh = Vgt2 + 2048; LAS float* Vsc = Vsh + 2048;
    __syncthreads();
    { const int c0 = F.tid * 4; *(LAS f32x4*)(Vg2 + c0) = *(const f32x4*)(g2 + c0); *(LAS f32x4*)(Vb2 + c0) = *(const f32x4*)(b2 + c0); }
    int bcur = -1;
    int myslot = -1; float myg = 0.f; u32x4 xv[4];
    const int ntrip = ROWMAP_NTRIP(nrows);
    { const int row = ROWMAP_ROW(0, nrows); if (row >= 0) { if (F.lane < 16) { myslot = tokslot[(size_t)row * 16 + F.lane]; myg = aff[(size_t)row * 16 + F.lane]; }
        const bf16_t* xp = WSP(bf16_t, WS_X1) + (size_t)row * DM;
#pragma unroll
        for (int i = 0; i < 4; ++i) xv[i] = *(const u32x4*)(xp + (i * 64 + F.lane) * 8); } }
    for (int k = 0; k < ntrip; ++k) {
        const int row = ROWMAP_ROW(k, nrows), b = ROWMAP_BATCH(k);
        if (b != bcur) { bcur = b; __syncthreads();
            { const int c0 = F.tid * 4; *(LAS f32x4*)(Vgt2 + c0) = *(const f32x4*)(mod + (size_t)b * 12288 + 10240 + c0);
              if (l == 0) { *(LAS f32x4*)(Vsh + c0) = *(const f32x4*)(modn + (size_t)b * 12288 + c0); *(LAS f32x4*)(Vsc + c0) = *(const f32x4*)(modn + (size_t)b * 12288 + 2048 + c0); } }
            __syncthreads(); }
        float v[32];
#pragma unroll
        for (int i = 0; i < 4; ++i) { v[i * 8] = bflo(xv[i].x); v[i * 8 + 1] = bfhi(xv[i].x); v[i * 8 + 2] = bflo(xv[i].y); v[i * 8 + 3] = bfhi(xv[i].y); v[i * 8 + 4] = bflo(xv[i].z); v[i * 8 + 5] = bfhi(xv[i].z); v[i * 8 + 6] = bflo(xv[i].w); v[i * 8 + 7] = bfhi(xv[i].w); }
        const int cslot = myslot; const float cg = myg;
        { const int nrow = (k + 1 < ntrip) ? ROWMAP_ROW(k + 1, nrows) : -1; if (nrow >= 0) {
            if (F.lane < 16) { myslot = tokslot[(size_t)nrow * 16 + F.lane]; myg = aff[(size_t)nrow * 16 + F.lane]; }
            const bf16_t* xp = WSP(bf16_t, WS_X1) + (size_t)nrow * DM;
#pragma unroll
            for (int i = 0; i < 4; ++i) xv[i] = *(const u32x4*)(xp + (i * 64 + F.lane) * 8); } }
        if (row < 0) continue;
        float f[32];
#pragma unroll
        for (int i = 0; i < 32; ++i) f[i] = 0.f;
        unsigned long long msk = __ballot(cslot >= 0);
        while (msk) {
            const int e0 = __builtin_ctzll(msk); msk &= msk - 1; const int e1 = msk ? __builtin_ctzll(msk) : e0; const bool two = msk != 0; msk &= msk - 1;
            const int s0 = __builtin_amdgcn_readlane(cslot, e0), s1 = __builtin_amdgcn_readlane(cslot, e1);
            const float w0 = __int_as_float(__builtin_amdgcn_readlane(__float_as_int(cg), e0)), w1 = two ? __int_as_float(__builtin_amdgcn_readlane(__float_as_int(cg), e1)) : 0.f;
            const bf16_t* y0 = ye + (size_t)(e0 * ER + s0) * DM; const bf16_t* y1 = ye + (size_t)(e1 * ER + s1) * DM;
            u32x4 a[4], c[4];
#pragma unroll
            for (int i = 0; i < 4; ++i) { a[i] = *(const u32x4*)(y0 + (i * 64 + F.lane) * 8); c[i] = *(const u32x4*)(y1 + (i * 64 + F.lane) * 8); }
#pragma unroll
            for (int i = 0; i < 4; ++i) {
                f[i * 8 + 0] += w0 * bflo(a[i].x) + w1 * bflo(c[i].x); f[i * 8 + 1] += w0 * bfhi(a[i].x) + w1 * bfhi(c[i].x);
                f[i * 8 + 2] += w0 * bflo(a[i].y) + w1 * bflo(c[i].y); f[i * 8 + 3] += w0 * bfhi(a[i].y) + w1 * bfhi(c[i].y);
                f[i * 8 + 4] += w0 * bflo(a[i].z) + w1 * bflo(c[i].z); f[i * 8 + 5] += w0 * bfhi(a[i].z) + w1 * bfhi(c[i].z);
                f[i * 8 + 6] += w0 * bflo(a[i].w) + w1 * bflo(c[i].w); f[i * 8 + 7] += w0 * bfhi(a[i].w) + w1 * bfhi(c[i].w); }
        }
#pragma unroll
        for (int i = 0; i < 4; ++i) { const f32x4 ga = *(const LAS f32x4*)(Vgt2 + (i * 64 + F.lane) * 8), gc = *(const LAS f32x4*)(Vgt2 + (i * 64 + F.lane) * 8 + 4);
#pragma unroll
            for (int c = 0; c < 4; ++c) { v[i * 8 + c] = alpha_ * v[i * 8 + c] + ga[c] * f[i * 8 + c]; v[i * 8 + 4 + c] = alpha_ * v[i * 8 + 4 + c] + gc[c] * f[i * 8 + 4 + c]; } }
        float mu, rstd; row_stats1(v, mu, rstd);
        float* xo = F.out + (size_t)row * DM; bf16_t* xb = WSP(bf16_t, WS_X2B) + (size_t)row * DM;
#pragma unroll
        for (int i = 0; i < 4; ++i) { const int c0 = (i * 64 + F.lane) * 8;
#pragma unroll
            for (int hh = 0; hh < 2; ++hh) { const f32x4 gg = *(const LAS f32x4*)(Vg2 + c0 + hh * 4), bb = *(const LAS f32x4*)(Vb2 + c0 + hh * 4); f32x4 o;
#pragma unroll
                for (int c = 0; c < 4; ++c) { o[c] = (v[i * 8 + hh * 4 + c] - mu) * rstd * gg[c] + bb[c]; v[i * 8 + hh * 4 + c] = o[c]; }
                if (l != 0) *(f32x4*)(xo + c0 + hh * 4) = o; }
            if (l == 0 && row < NLAT) { u32x4 w; w.x = cvt_pk_bf16(v[i * 8], v[i * 8 + 1]); w.y = cvt_pk_bf16(v[i * 8 + 2], v[i * 8 + 3]); w.z = cvt_pk_bf16(v[i * 8 + 4], v[i * 8 + 5]); w.w = cvt_pk_bf16(v[i * 8 + 6], v[i * 8 + 7]); *(u32x4*)(xb + c0) = w; } }
        if (l == 0) { row_stats1(v, mu, rstd); bf16_t* hd = WSP(bf16_t, WS_H) + (size_t)row * DM;
#pragma unroll
            for (int i = 0; i < 4; ++i) { const int c0 = (i * 64 + F.lane) * 8; float o[8];
#pragma unroll
                for (int hh = 0; hh < 2; ++hh) { const f32x4 a = *(const LAS f32x4*)(Vsc + c0 + hh * 4), bq = *(const LAS f32x4*)(Vsh + c0 + hh * 4);
#pragma unroll
                    for (int c = 0; c < 4; ++c) o[hh * 4 + c] = (v[i * 8 + hh * 4 + c] - mu) * rstd * (1.f + a[c]) + bq[c]; }
                u32x4 w; w.x = cvt_pk_bf16(o[0], o[1]); w.y = cvt_pk_bf16(o[2], o[3]); w.z = cvt_pk_bf16(o[4], o[5]); w.w = cvt_pk_bf16(o[6], o[7]); *(u32x4*)(hd + c0) = w; } }
    }
    __syncthreads();
}
#ifndef PROBE_SUB
#define PROBE_SUB 0
#endif
__device__ __forceinline__ void s5_scan2(const Frame& F, int l, int first_thread, int nthreads) {
    const float* __restrict__ S = WSP(float, WS_S5S); bf16_t* __restrict__ SI = WSP(bf16_t, WS_S5IN);
    for (int e = first_thread; e < 4 * 32 * 128; e += nthreads) { const int p = e & 63, d = (e >> 6) & 1, g = (e >> 7) & 31, b = e >> 12;
        const f32x2 lt = WSP(f32x2, WS_LAMT)[((size_t)(l * 32 + g) * 2 + d) * 64 + p];
        float sx = 0.f, sy = 0.f; const size_t co = (size_t)g * 256 + d * 128 + p * 2;
#define S5S_ROW(i) (((i) < 8) ? (512 + b * 8 + (d == 0 ? (i) : 7 - (i))) : (b * 128 + (d == 0 ? ((i) - 8) : 127 - ((i) - 8))))
        for (int i0 = 0; i0 < 136; i0 += 34) { f32x2 sv[34];
#pragma unroll
            for (int q = 0; q < 34; ++q) { const int r = S5S_ROW(i0 + q); sv[q] = *(const f32x2*)(S + ((unsigned)r * 8192u + (unsigned)co)); }
#pragma unroll
            for (int q = 0; q < 34; ++q) { const int r = S5S_ROW(i0 + q); *(unsigned*)(SI + ((unsigned)r * 8192u + (unsigned)co)) = cvt_pk_bf16(sx, sy);
                const float nx = lt.x * sx - lt.y * sy + sv[q].x, ny = lt.x * sy + lt.y * sx + sv[q].y; sx = nx; sy = ny; } }
#undef S5S_ROW
    }
}
template <int NEL>
__device__ __forceinline__ void gla_scan_n(const float* __restrict__ upd, const float* __restrict__ dec, bf16_t* __restrict__ st, int e0, int es) {
    int el[NEL], bhd[NEL], d[NEL], k[NEL]; float s[NEL];
#pragma unroll
    for (int a = 0; a < NEL; ++a) { const int e = e0 + a * es; el[a] = e & 8191; bhd[a] = e >> 13; d[a] = bhd[a] & 1; k[a] = el[a] & 63; s[a] = 0.f; }
    for (int p0 = 0; p0 < 68; p0 += 17) { float u[NEL][17], dc[NEL][17];
#pragma unroll
        for (int q = 0; q < 17; ++q)
#pragma unroll
            for (int a = 0; a < NEL; ++a) { const int pos = p0 + q; const int j = d[a] == 0 ? pos : (pos < 4 ? 3 - pos : 71 - pos); const unsigned base = (unsigned)(bhd[a] * 68 + j); u[a][q] = upd[base * 8192u + (unsigned)el[a]]; dc[a][q] = dec[base * 64u + (unsigned)k[a]]; }
#pragma unroll
        for (int q = 0; q < 17; ++q)
#pragma unroll
            for (int a = 0; a < NEL; ++a) { const int pos = p0 + q; const int j = d[a] == 0 ? pos : (pos < 4 ? 3 - pos : 71 - pos); const unsigned base = (unsigned)(bhd[a] * 68 + j); st[base * 8192u + (unsigned)el[a]] = f2bf(s[a]); s[a] = dc[a][q] * s[a] + u[a][q]; } }
}
__device__ __forceinline__ void gla_scan2(const Frame& F, int first_thread, int nthreads) {
    const float* __restrict__ upd = WSP(float, WS_R3 + (size_t)MT * DM * 2 + (size_t)MT * 512 * 2); const float* __restrict__ dec = WSP(float, WS_GDEC); bf16_t* __restrict__ st = WSP(bf16_t, WS_GST);
    const int N = 32 * 8192;
    for (int e = first_thread; e < N; e += 3 * nthreads) {
        if (e + 2 * nthreads < N) gla_scan_n<3>(upd, dec, st, e, nthreads);
        else if (e + nthreads < N) gla_scan_n<2>(upd, dec, st, e, nthreads);
        else gla_scan_n<1>(upd, dec, st, e, nthreads); }
}

#define XB_TMO      128
#define XB_XCNT(j)  (256  + 64 * (j))
#define XB_XSUB(j)  (1280 + 64 * (j))
#define XB_XGEN(j)  (2304 + 64 * (j))
#define XB_TOP      3328
#define XB_TOPGEN   3392
#define XCD_BAR_WORDS 3456
#define XB_SPIN_CAP (1u << 18)

__device__ __forceinline__ unsigned xb_ld(unsigned* p)              { return __hip_atomic_load(p, __ATOMIC_RELAXED, __HIP_MEMORY_SCOPE_AGENT); }
__device__ __forceinline__ unsigned xb_add(unsigned* p, unsigned v) { return __hip_atomic_fetch_add(p, v, __ATOMIC_RELAXED, __HIP_MEMORY_SCOPE_AGENT); }
__device__ __forceinline__ unsigned xb_xcc_id() { return (unsigned)__builtin_amdgcn_s_getreg((3 << 11) | 20) & 0xFu; }
#define XB_SPIN(cond, bar) do { unsigned _sp = 0; while (cond) { __builtin_amdgcn_s_sleep(1); \
    if ((++_sp & 255u) == 0u) { if (xb_ld(&(bar)[XB_TMO])) break; if (_sp > XB_SPIN_CAP) { atomicAdd(&(bar)[XB_TMO], 1u); break; } } } } while (0)

struct XcdBarrier {
    unsigned* bar; unsigned x;
    volatile LAS unsigned* st;
};

__device__ __forceinline__ XcdBarrier xcd_barrier_post(unsigned* bar, volatile LAS unsigned* st) {
    XcdBarrier b; b.bar = bar; b.x = xb_xcc_id(); b.st = st;
    if (threadIdx.x == 0) (void)xb_add(&bar[XB_XCNT(b.x)], 1u);
    return b;
}
__device__ __forceinline__ void xcd_barrier_complete(unsigned* bar, unsigned x, unsigned& nloc, unsigned& nx) {
    const unsigned G = gridDim.x * gridDim.y * gridDim.z;
    unsigned sum, cnt, mine, sp = 0u;
    for (;;) {
        sum = 0u; cnt = 0u; mine = 0u;
#pragma unroll
        for (unsigned j = 0; j < 16; ++j) { const unsigned c = xb_ld(&bar[XB_XCNT(j)]); sum += c; cnt += (c > 0u) ? 1u : 0u; mine = (j == x) ? c : mine; }
        if (sum == G) break;
        __builtin_amdgcn_s_sleep(1);
        if ((++sp & 255u) == 0u) { if (xb_ld(&bar[XB_TMO])) break; if (sp > XB_SPIN_CAP) { atomicAdd(&bar[XB_TMO], 1u); break; } }
    }
    nloc = mine > 0u ? mine : 1u; nx = cnt > 0u ? cnt : 1u;
}

__device__ __forceinline__ void xcd_barrier(const XcdBarrier& b) {
    asm volatile("s_waitcnt vmcnt(0)" ::: "memory");
    __syncthreads();
    if (threadIdx.x == 0) {
        unsigned* bar = b.bar;
        __builtin_amdgcn_s_waitcnt(0);
        unsigned nloc = b.st[0], nx = b.st[1];
        if (nloc == 0u) { xcd_barrier_complete(bar, b.x, nloc, nx); b.st[0] = nloc; b.st[1] = nx; }
        const unsigned old = xb_add(&bar[XB_XSUB(b.x)], 1u);
        const unsigned gen = old / nloc;
        if (old + 1u == (gen + 1u) * nloc) {
            __builtin_amdgcn_fence(__ATOMIC_RELEASE, "agent");
            asm volatile("s_waitcnt vmcnt(0)" ::: "memory");
            const unsigned og = xb_add(&bar[XB_TOP], 1u);
            const unsigned tg = og / nx;
            if (og + 1u == (tg + 1u) * nx) xb_add(&bar[XB_TOPGEN], 1u);
            else XB_SPIN(xb_ld(&bar[XB_TOPGEN]) == tg, bar);
            __builtin_amdgcn_fence(__ATOMIC_ACQUIRE, "agent");
            xb_add(&bar[XB_XGEN(b.x)], 1u);
            asm volatile("s_waitcnt vmcnt(0)" ::: "memory");
        } else {
            XB_SPIN(xb_ld(&bar[XB_XGEN(b.x)]) == gen, bar);
            __builtin_amdgcn_fence(__ATOMIC_ACQUIRE, "agent");
            asm volatile("s_waitcnt vmcnt(0)" ::: "memory");
        }
    }
    __syncthreads();
}


__device__ __forceinline__ int wrapadd(int a, int b, int n) { int x = a + (b < n ? b : 0); return x >= n ? x - n : x; }
__device__ __forceinline__ void conv_share(int c, int G, int NU, int& q0, int& q1) { int g_; asm volatile("v_mov_b32 %0, %1" : "=v"(g_) : "s"(G)); q0 = __builtin_amdgcn_readfirstlane((int)((long)c * NU / g_)); q1 = __builtin_amdgcn_readfirstlane((int)((long)(c + 1) * NU / g_)); }
constexpr int N_PHASES = 27;
__global__ void __launch_bounds__(NTHR, 2) mega_fwd(Args args) {
    extern __shared__ __attribute__((aligned(16))) unsigned char lds_raw[];
    Frame F; F.in = args.in; F.out = args.out; F.ws = args.ws; F.lds = (LAS unsigned char*)lds_raw;
    F.tid = threadIdx.x; F.lane = F.tid & 63; F.wave = __builtin_amdgcn_readfirstlane(F.tid >> 6); F.G = gridDim.x; F.bid = blockIdx.x;
    const int wave0_ = __builtin_amdgcn_readfirstlane((int)threadIdx.x >> 6);
#define FRESH() do { int t_; asm volatile("v_mbcnt_lo_u32_b32 %0, -1, 0\n\tv_mbcnt_hi_u32_b32 %0, -1, %0" : "=v"(t_)); t_ |= (wave0_ << 6); F.tid = t_; F.lane = t_ & 63; F.wave = __builtin_amdgcn_readfirstlane(t_ >> 6); { const void* ka_ = (const void*)__builtin_amdgcn_kernarg_segment_ptr(); unsigned char* w_; float* o_; asm volatile("s_load_dwordx2 %0, %2, 0xf8\n\ts_load_dwordx2 %1, %2, 0xf0\n\ts_waitcnt lgkmcnt(0)" : "=&s"(w_), "=&s"(o_) : "s"(ka_) : "memory"); F.ws = w_; F.out = o_; F.bid = blockIdx.x; } } while (0)
    const int lo = args.ph_lo, hi = args.ph_hi;
    const bool fused = (hi - lo) > 1;
    if (F.tid == 0) *(LAS u32x4*)(F.lds + LDS_BAR_OFF) = (u32x4){0u, 0u, 0u, 0u};
    __syncthreads();
    XcdBarrier bar; bar.bar = (unsigned*)(F.ws + WS_CTL); bar.x = 0; bar.st = nullptr;
    if (fused) bar = xcd_barrier_post((unsigned*)(F.ws + WS_CTL), (volatile LAS unsigned*)(F.lds + LDS_BAR_OFF));
#ifdef ONLY_PHASE
#define IN(k) (((k) == ONLY_PHASE || (k) == ONLY_PHASE + 12) && lo <= (k) && (k) < hi)
#else
#define IN(k) (lo <= (k) && (k) < hi)
#endif
#define SEAM(k) do { if (IN((k) + 1)) xcd_barrier(bar); } while (0)
#ifndef PROBE_REP
#define PROBE_REP 0
#endif
#define NREP(bit) (((PROBE_REP >> (bit)) & 1) ? 2 : 1)
    if (IN(0)) { FRESH(); phase_prologue(F); SEAM(0); }
    if (IN(1)) { FRESH(); phase_mod_reduce(F); SEAM(1); }
    if (IN(2)) { FRESH(); phase_ln1_first(F); SEAM(2); }
    for (int l = 0; l < 2; ++l) {
        const int pb = 3 + l * 12;
        if (IN(pb + 0)) { FRESH();
            pg8::Gemm g{WSP(bf16_t, WS_H), WSP(bf16_t, WS_WIN) + (size_t)l * NINP * DM, MT, NINP, DM}; pg8::StaticOrder S; S.init(MT, NINP, F.G, F.bid);
            pg8::EpiProj E{WSP(bf16_t, WS_R1), WSP(bf16_t, WS_SU), WSP(float, WS_ROPE)};
            pg8::gemm_phase<pg8::EpiProj, pg8::StaticOrder>(F.lds, g, S, E, F.tid); SEAM(pb + 0); }
        if (IN(pb + 1)) { FRESH(); for (int r_ = 0; r_ < (PROBE_SUB == 1 ? 2 : 1); ++r_) attn_items(F, l, F.bid, F.G); for (int r_ = 0; r_ < (PROBE_SUB == 2 ? 2 : 1); ++r_) if ((F.G & 7) == 0) s5a_items(F, l, F.bid & 7, wrapadd(F.bid >> 3, F.G >> 4, F.G >> 3), F.G >> 3); else s5a_items(F, l, -1, F.bid, F.G); for (int r_ = 0; r_ < (PROBE_SUB == 3 ? 2 : 1); ++r_) gla1_items(F, l, wrapadd(F.bid, 96, F.G), F.G); SEAM(pb + 1); }
        if (IN(pb + 2)) { FRESH(); if (F.bid < 32) s5_scan2(F, l, F.bid * NTHR + F.tid, 32 * NTHR); else gla_scan2(F, (F.bid - 32) * NTHR + F.tid, (F.G - 32) * NTHR); SEAM(pb + 2); }
        if (IN(pb + 3)) { FRESH(); for (int r_ = 0; r_ < (PROBE_SUB == 4 ? 2 : 1); ++r_) if ((F.G & 7) == 0) s5c_items(F, l, F.bid & 7, F.bid >> 3, F.G >> 3); else s5c_items(F, l, -1, F.bid, F.G); for (int r_ = 0; r_ < (PROBE_SUB == 5 ? 2 : 1); ++r_) gla3_items(F, l, wrapadd(F.bid, 32, F.G), F.G); SEAM(pb + 3); }
        if (IN(pb + 4)) { FRESH();
            pg8::Gemm g{WSP(bf16_t, WS_R3 + (size_t)MT * DM * 2), WSP(bf16_t, WS_WGLU) + (size_t)l * 512 * 512, MT, 512, 512}; pg8::StaticOrder S; S.init(MT, 512, F.G, F.bid);
            pg8::EpiGlu E{WSP(bf16_t, WS_R3 + (size_t)MT * DM * 2), F.in[17] + l * 512, WSP(bf16_t, WS_R3)};
            pg8::gemm_phase<pg8::EpiGlu, pg8::StaticOrder, MT>(F.lds, g, S, E, F.tid); SEAM(pb + 4); }
        if (IN(pb + 5)) { FRESH();
            pg8::Gemm g{WSP(bf16_t, WS_R3), WSP(bf16_t, WS_WOUT) + (size_t)l * DM * DM, NLAT, DM, DM};
            pg8::EpiBf16 E{WSP(bf16_t, WS_R2), DM};
            const bool qtail = (F.G >= 128);
            { const int split = 0;     pg8::OutOrder0 S; S.S0.init((l == 0 && !split && !qtail) ? MT : NLAT, DM, F.G, F.bid); S.G = F.G; S.c = F.bid; S.split = split; pg8::gemm_phase<pg8::EpiBf16, pg8::OutOrder0>(F.lds, g, S, E, F.tid); }
            if (l == 0 && qtail) { FRESH(); if (F.bid < 128) pg8::gemm_quarter<pg8::EpiBf16>(F.lds, g, 64 + (F.bid >> 5), (F.bid >> 2) & 7, (F.bid >> 1) & 1, F.bid & 1, E, F.tid); }
            SEAM(pb + 5); }
        if (IN(pb + 6)) { FRESH(); phase_ln_mid(F, l); SEAM(pb + 6); }
        if (IN(pb + 7)) { FRESH(); phase_topk(F, l); SEAM(pb + 7); }
        if (IN(pb + 9)) { FRESH();
            pg8::GemmF g{WSP(bf16_t, WS_H), F.in[27] + (size_t)l * NE * DM * DM, F.in[28] + (size_t)l * NE * DM * DM, (size_t)DM * DM, 128, DM, DM, nullptr, WSP(unsigned, WS_VT)};
            pg8::GroupedOrder S{NE, (l == 0) ? 9 : 8, 16, 9, F.G, F.bid, 0};
            pg8::EpiGateUp E{WSP(bf16_t, WS_R1)};
            pg8::gemm_phase_fb<pg8::EpiGateUp, pg8::GroupedOrder, 0, false, true>(F.lds, g, S, E, F.tid); SEAM(pb + 9); }
        if (IN(pb + 10)) { FRESH();
            pg8::GemmF g{WSP(bf16_t, WS_R1), F.in[29] + (size_t)l * NE * DM * DM, F.in[29] + (size_t)l * NE * DM * DM + 128, (size_t)DM * DM, 256, DM, DM, nullptr};
            pg8::EpiBf16 E{WSP(bf16_t, WS_R3), DM};
            if (l == 0 && F.G == 256) {
                pg8::GroupedOrderHead S1{{NE, 9, 8, 9, F.G, F.bid, 0}, 1024};
                pg8::gemm_phase_fb<pg8::EpiBf16, pg8::GroupedOrderHead>(F.lds, g, S1, E, F.tid);
                FRESH();
                pg8::GroupedOrderTailHN S2{{NE, 9, 8, 9, F.G, F.bid, 0}, 1024};
                pg8::gemm_phase_fb<pg8::EpiBf16, pg8::GroupedOrderTailHN, 0, false, false, true>(F.lds, g, S2, E, F.tid);
            } else { pg8::GroupedOrder S{NE, (l == 0) ? 9 : 8, 8, 9, F.G, F.bid, 0};
                pg8::gemm_phase_fb<pg8::EpiBf16, pg8::GroupedOrder>(F.lds, g, S, E, F.tid); }
            SEAM(pb + 10); }
        if (IN(pb + 11)) { FRESH(); phase_combine(F, l); SEAM(pb + 11); }
    }
#undef IN
#undef SEAM
}

#ifndef PROBE_NREP
#define PROBE_NREP 2
#endif
#ifndef PROBE_REP_MASK
#define PROBE_REP_MASK 0ull
#endif
#ifndef MK_MULTI
#define MK_MULTI 0
#endif
extern "C" void kernel_launch(void* const* d_in, const int* in_sizes, int n_in, void* d_out, int out_size, void* d_ws, size_t ws_size, hipStream_t stream) {
    static int grid = 0;
    if (grid == 0) {
        if (n_in != 30 || out_size != NLAT * DM || ws_size < WS_END) { fprintf(stderr, "kernel_launch: unexpected shapes (n_in %d, out %d, ws %zu, need %zu)\n", n_in, out_size, ws_size, (size_t)WS_END); grid = -1; return; }
        int dev = 0, cus = 0, per_cu = 0;
        if (hipGetDevice(&dev) != hipSuccess || hipDeviceGetAttribute(&cus, hipDeviceAttributeMultiprocessorCount, dev) != hipSuccess) { grid = -1; return; }
        if (hipFuncSetAttribute((const void*)mega_fwd, hipFuncAttributeMaxDynamicSharedMemorySize, LDS_BYTES) != hipSuccess) { fprintf(stderr, "kernel_launch: hipFuncSetAttribute failed\n"); grid = -1; return; }
        if (hipOccupancyMaxActiveBlocksPerMultiprocessor(&per_cu, (const void*)mega_fwd, NTHR, LDS_BYTES) != hipSuccess || per_cu < 1) fprintf(stderr, "kernel_launch: occupancy query says %d\n", per_cu);
        (void)hipGetLastError();
        grid = cus;
    }
    if (grid < 0) return;
    (void)hipMemsetAsync((char*)d_ws + WS_CTL, 0, CTL_BYTES, stream);
    Args a{};
    for (int i = 0; i < 30; ++i) a.in[i] = (const float*)d_in[i];
    a.out = (float*)d_out; a.ws = (unsigned char*)d_ws;
#if MK_MULTI
    for (int p = 0; p < N_PHASES; ++p) { const int nrep = ((PROBE_REP_MASK >> p) & 1ull) ? PROBE_NREP : 1; for (int r = 0; r < nrep; ++r) { a.ph_lo = p; a.ph_hi = p + 1; hipLaunchKernelGGL(mega_fwd, dim3(grid), dim3(NTHR), LDS_BYTES, stream, a); } }
#else
    a.ph_lo = 0; a.ph_hi = N_PHASES; hipLaunchKernelGGL(mega_fwd, dim3(grid), dim3(NTHR), LDS_BYTES, stream, a);
#endif
}
```
